# Optimizing an MI355X kernel written in HIP

```python
import math
import jax
import jax.numpy as jnp
from jax import lax
import numpy as np

D_MODEL = 1024
BATCH = 16
SEQ = 2048
DEPTH = 1

CTX_LEN = 256
GRID_W = 64
ROPE_BASE = 10000.0
NORM_EPS = 1e-6

DA_HEADS = 4
DA_QK_DIM = 64
DA_V_DIM = 2 * DA_QK_DIM
DA_WIDTH = DA_HEADS * DA_V_DIM
Q_BLOCK = 128

GLA_HEADS = 4
GLA_K_DIM = 64
GLA_V_DIM = 128
GLA_WIDTH = GLA_HEADS * GLA_V_DIM
GLA_GATE_RANK = 16
GLA_GATE_TAU = 16.0
GLA_CHUNK = 64

MIX_WIDTH = DA_WIDTH + GLA_WIDTH
IN_PROJ_SIZES = (DA_HEADS * 2 * DA_QK_DIM, DA_HEADS * 2 * DA_QK_DIM, DA_WIDTH,
                 GLA_HEADS * GLA_K_DIM, GLA_HEADS * GLA_K_DIM, GLA_WIDTH, GLA_WIDTH,
                 GLA_GATE_RANK, GLA_GATE_RANK)
IN_PROJ_DIM = sum(IN_PROJ_SIZES)

N_GROUPS = 4
EXPERTS_PER_GROUP = 8
N_EXPERTS = N_GROUPS * EXPERTS_PER_GROUP
TOP_K = 2
EXPERT_HIDDEN = 512
DISPATCH_BLOCK = 128

kernel_name = "hymba_diffattn_gla_hiermoe_dit_block"


def rms_norm(x, gain):
    xf = x.astype(jnp.float32)
    y = xf * lax.rsqrt(jnp.mean(xf * xf, axis=-1, keepdims=True) + NORM_EPS)
    return (y * gain.astype(jnp.float32)).astype(x.dtype)


def modulate(h, shift, scale):
    return h * (1 + scale) + shift


def split_in_proj(p):
    parts, start = [], 0
    for size in IN_PROJ_SIZES:
        parts.append(p[..., start:start + size])
        start += size
    return parts


def axial_rope_tables(rows, rot_dim):
    n_freq = rot_dim // 4
    r, col = jnp.meshgrid(jnp.arange(rows, dtype=jnp.float32),
                          jnp.arange(GRID_W, dtype=jnp.float32), indexing="ij")
    pos = jnp.stack([r.reshape(-1), col.reshape(-1)], axis=-1)
    inv_freq = jnp.power(ROPE_BASE, -jnp.arange(n_freq, dtype=jnp.float32) / n_freq)
    ang = pos[:, :, None] * inv_freq
    return jnp.cos(ang), jnp.sin(ang)


def apply_axial_rope(x, cos, sin):
    n_freq = cos.shape[-1]
    xr = x.reshape(x.shape[:-1] + (2, 2, n_freq))
    x1, x2 = xr[..., 0, :], xr[..., 1, :]
    cs, sn = cos.astype(x.dtype), sin.astype(x.dtype)
    out = jnp.stack([x1 * cs - x2 * sn, x2 * cs + x1 * sn], axis=-2)
    return out.reshape(x.shape)


def diff_attend(q, k, v, lam):
    s = jnp.einsum("bqhmd,bkhmd->bhmqk", q, k).astype(jnp.float32) * (DA_QK_DIM ** -0.5)
    p = jax.nn.softmax(s, axis=-1)
    a = p[:, :, 0] - lam * p[:, :, 1]
    return jnp.einsum("bhqk,bkhe->bqhe", a.astype(v.dtype), v)


def gla_chunked(q, k, v, log_a, s0):
    B, T, H, dk = q.shape
    dv = v.shape[-1]
    n_chunks = T // GLA_CHUNK

    def chunks(t):
        return jnp.moveaxis(t.reshape(B, n_chunks, GLA_CHUNK, H, t.shape[-1]), 1, 0)

    mask = jnp.tril(jnp.ones((GLA_CHUNK, GLA_CHUNK), dtype=bool))

    def step(state, inp):
        qi, ki, vi, gi = inp
        b = jnp.cumsum(gi.astype(jnp.float32), axis=1)
        b_last = b[:, -1]
        q_dec = qi * jnp.exp(b)
        k_inv = ki * jnp.exp(-b)
        scores = jnp.einsum("bihk,bjhk->bhij", q_dec, k_inv)
        scores = jnp.where(mask, scores, 0.0)
        o = (jnp.einsum("bhij,bjhv->bihv", scores, vi)
             + jnp.einsum("bihk,bhkv->bihv", q_dec, state))
        k_to_end = ki * jnp.exp(b_last[:, None] - b)
        new_state = (state * jnp.exp(b_last)[..., None]
                     + jnp.einsum("bjhk,bjhv->bhkv", k_to_end, vi))
        return new_state, o

    s_final, o = lax.scan(step, s0, (chunks(q), chunks(k), chunks(v), chunks(log_a)))
    o = jnp.moveaxis(o, 0, 1).reshape(B, T, H, dv)
    return o, s_final


def log_gate(lowrank, w2, b):
    return jax.nn.log_sigmoid((lowrank @ w2 + b).astype(jnp.float32)) / GLA_GATE_TAU


def token_mixer(h_lat, h_ctx, cos, sin, lambda_init, w_in, da_lambda, da_subln_g,
                gla_gate_w2, gla_gate_b, gla_norm_g, w_out, with_ctx_out):
    B, S, _ = h_lat.shape
    L = h_ctx.shape[1]
    dt = h_lat.dtype
    dq_l, dk_l, dv_l, gq_l, gk_l, gv_l, gr_l, lrf_l, lrb_l = split_in_proj(h_lat @ w_in)
    dq_c, dk_c, dv_c, gq_c, gk_c, gv_c, gr_c, lrf_c, lrb_c = split_in_proj(h_ctx @ w_in)

    cos_b, sin_b = cos[:, None, None], sin[:, None, None]
    q_l = apply_axial_rope(dq_l.reshape(B, S, DA_HEADS, 2, DA_QK_DIM), cos_b, sin_b)
    k_l = apply_axial_rope(dk_l.reshape(B, S, DA_HEADS, 2, DA_QK_DIM), cos_b, sin_b)
    v_l = dv_l.reshape(B, S, DA_HEADS, DA_V_DIM)
    k_c = dk_c.reshape(B, L, DA_HEADS, 2, DA_QK_DIM)
    v_c = dv_c.reshape(B, L, DA_HEADS, DA_V_DIM)
    lam_p = da_lambda.astype(jnp.float32)
    lam = (jnp.exp(jnp.sum(lam_p[0] * lam_p[1])) - jnp.exp(jnp.sum(lam_p[2] * lam_p[3]))
           + lambda_init)
    k_all = jnp.concatenate([k_c, k_l], axis=1)
    v_all = jnp.concatenate([v_c, v_l], axis=1)
    qb = jnp.moveaxis(q_l.reshape(B, S // Q_BLOCK, Q_BLOCK, DA_HEADS, 2, DA_QK_DIM), 1, 0)
    a_l = lax.map(lambda qi: diff_attend(qi, k_all, v_all, lam), qb)
    a_l = jnp.moveaxis(a_l, 0, 1).reshape(B, S, DA_HEADS, DA_V_DIM)
    a_l = rms_norm(a_l, da_subln_g) * (1.0 - lambda_init)

    def gla_inputs(gq, gk, gv, lrf, lrb, n):
        q = gq.reshape(B, n, GLA_HEADS, GLA_K_DIM) * (GLA_K_DIM ** -0.5)
        k = gk.reshape(B, n, GLA_HEADS, GLA_K_DIM)
        v = gv.reshape(B, n, GLA_HEADS, GLA_V_DIM)
        g_f = log_gate(lrf, gla_gate_w2[0], gla_gate_b[0]).reshape(B, n, GLA_HEADS, GLA_K_DIM)
        g_b = log_gate(lrb, gla_gate_w2[1], gla_gate_b[1]).reshape(B, n, GLA_HEADS, GLA_K_DIM)
        return q, k, v, g_f, g_b

    gql, gkl, gvl, gfl, gbl = gla_inputs(gq_l, gk_l, gv_l, lrf_l, lrb_l, S)
    gqc, gkc, gvc, gfc, gbc = gla_inputs(gq_c, gk_c, gv_c, lrf_c, lrb_c, L)
    flip = lambda t: jnp.flip(t, axis=1)
    s0 = jnp.zeros((B, GLA_HEADS, GLA_K_DIM, GLA_V_DIM), jnp.float32)
    o_cf, s_cf = gla_chunked(gqc, gkc, gvc, gfc, s0)
    o_cb, s_cb = gla_chunked(flip(gqc), flip(gkc), flip(gvc), flip(gbc), s0)
    o_lf, _ = gla_chunked(gql, gkl, gvl, gfl, s_cf)
    o_lb, _ = gla_chunked(flip(gql), flip(gkl), flip(gvl), flip(gbl), s_cb)
    o_l = (o_lf + flip(o_lb)).astype(dt)
    g_l = rms_norm(o_l, gla_norm_g) * jax.nn.silu(gr_l.reshape(B, S, GLA_HEADS, GLA_V_DIM))

    y_lat = jnp.concatenate([a_l.reshape(B, S, DA_WIDTH), g_l.reshape(B, S, GLA_WIDTH)], -1) @ w_out
    if not with_ctx_out:
        return y_lat, None

    q_c = dq_c.reshape(B, L, DA_HEADS, 2, DA_QK_DIM)
    a_c = rms_norm(diff_attend(q_c, k_c, v_c, lam), da_subln_g) * (1.0 - lambda_init)
    o_c = (o_cf + flip(o_cb)).astype(dt)
    g_c = rms_norm(o_c, gla_norm_g) * jax.nn.silu(gr_c.reshape(B, L, GLA_HEADS, GLA_V_DIM))
    y_ctx = jnp.concatenate([a_c.reshape(B, L, DA_WIDTH), g_c.reshape(B, L, GLA_WIDTH)], -1) @ w_out
    return y_lat, y_ctx


def hier_moe(h, w_rg, b_rg, w_re, b_re, w_gate, w_up, w_down):
    T, D = h.shape
    hf = h.astype(jnp.float32)
    g_logits = hf @ w_rg.astype(jnp.float32) + b_rg.astype(jnp.float32)
    g_prob = jax.nn.softmax(g_logits, axis=-1)
    g_sel = jnp.argmax(g_logits, axis=-1)
    g_w = jnp.take_along_axis(g_prob, g_sel[:, None], axis=-1)
    e_logits = (hf @ w_re.astype(jnp.float32) + b_re.astype(jnp.float32)).reshape(
        T, N_GROUPS, EXPERTS_PER_GROUP)
    e_in_group = jnp.take_along_axis(e_logits, g_sel[:, None, None], axis=1)[:, 0]
    top_v, top_i = lax.top_k(e_in_group, TOP_K)
    weights = jax.nn.softmax(top_v, axis=-1) * g_w
    expert_id = (g_sel[:, None] * EXPERTS_PER_GROUP + top_i).astype(jnp.int32)

    tk = T * TOP_K
    n_blocks = -(-(tk + N_EXPERTS * (DISPATCH_BLOCK - 1)) // DISPATCH_BLOCK)
    n_rows = n_blocks * DISPATCH_BLOCK
    flat_e = expert_id.reshape(-1)
    flat_t = jnp.repeat(jnp.arange(T, dtype=jnp.int32), TOP_K)
    flat_w = weights.reshape(-1)
    order = jnp.argsort(flat_e)
    e_sorted = flat_e[order]
    counts = jnp.bincount(flat_e, length=N_EXPERTS)
    starts = jnp.cumsum(counts) - counts
    padded = ((counts + DISPATCH_BLOCK - 1) // DISPATCH_BLOCK) * DISPATCH_BLOCK
    pad_ends = jnp.cumsum(padded)
    pad_starts = pad_ends - padded
    dest = pad_starts[e_sorted] + (jnp.arange(tk) - starts[e_sorted])
    row_tok = jnp.full((n_rows,), T, jnp.int32).at[dest].set(flat_t[order])
    row_w = jnp.zeros((n_rows,), jnp.float32).at[dest].set(flat_w[order])
    block_start = jnp.arange(n_blocks, dtype=jnp.int32) * DISPATCH_BLOCK
    block_e = jnp.minimum(jnp.searchsorted(pad_ends, block_start, side="right"), N_EXPERTS - 1)
    h_pad = jnp.concatenate([h, jnp.zeros((1, D), h.dtype)], axis=0)
    xb = h_pad[row_tok].reshape(n_blocks, DISPATCH_BLOCK, D)

    def expert_block(args):
        xi, e = args
        return (jax.nn.silu(xi @ w_gate[e]) * (xi @ w_up[e])) @ w_down[e]

    yb = lax.map(expert_block, (xb, block_e)).reshape(n_rows, D)
    y = jax.ops.segment_sum(yb * row_w[:, None].astype(yb.dtype), row_tok, num_segments=T + 1)
    return y[:T]


def setup_inputs(seed: int = 0) -> dict:
    key = jax.random.key(seed)
    ks = jax.random.split(key, 24)
    f32 = jnp.float32
    D = D_MODEL
    nrm = lambda k, shape, s: jax.random.normal(k, shape, f32) * s
    gain = lambda k, shape: 1.0 + 0.02 * jax.random.normal(k, shape, f32)
    return {
        "x": nrm(ks[0], (BATCH, SEQ, D), 1.0),
        "c": nrm(ks[1], (BATCH, D), 1.0),
        "ctx": nrm(ks[2], (BATCH, CTX_LEN, D), 1.0),
        "c_ctx": nrm(ks[3], (D,), 1.0),
        "w_ada": nrm(ks[4], (DEPTH, D, 6 * D), 0.5 * D ** -0.5),
        "b_ada": nrm(ks[5], (DEPTH, 6 * D), 0.02),
        "norm_mix_g": gain(ks[6], (DEPTH, D)),
        "norm_ffn_g": gain(ks[7], (DEPTH, D)),
        "w_in": nrm(ks[8], (DEPTH, D, IN_PROJ_DIM), D ** -0.5),
        "da_lambda": nrm(ks[9], (DEPTH, 4, DA_QK_DIM), 0.1),
        "da_subln_g": gain(ks[10], (DEPTH, DA_V_DIM)),
        "gla_gate_w2": nrm(ks[11], (DEPTH, 2, GLA_GATE_RANK, GLA_HEADS * GLA_K_DIM), GLA_GATE_RANK ** -0.5),
        "gla_gate_b": nrm(ks[12], (DEPTH, 2, GLA_HEADS * GLA_K_DIM), 0.1),
        "gla_norm_g": gain(ks[13], (DEPTH, GLA_V_DIM)),
        "w_out": nrm(ks[14], (DEPTH, MIX_WIDTH, D), MIX_WIDTH ** -0.5),
        "router_group_w": nrm(ks[15], (DEPTH, D, N_GROUPS), D ** -0.5),
        "router_group_b": nrm(ks[16], (DEPTH, N_GROUPS), 0.01),
        "router_expert_w": nrm(ks[17], (DEPTH, D, N_EXPERTS), D ** -0.5),
        "router_expert_b": nrm(ks[18], (DEPTH, N_EXPERTS), 0.01),
        "expert_w_gate": nrm(ks[19], (DEPTH, N_EXPERTS, D, EXPERT_HIDDEN), D ** -0.5),
        "expert_w_up": nrm(ks[20], (DEPTH, N_EXPERTS, D, EXPERT_HIDDEN), D ** -0.5),
        "expert_w_down": nrm(ks[21], (DEPTH, N_EXPERTS, EXPERT_HIDDEN, D), EXPERT_HIDDEN ** -0.5),
        "final_norm_g": gain(ks[22], (D,)),
    }


def reference(x, c, ctx, c_ctx, w_ada, b_ada, norm_mix_g, norm_ffn_g, w_in, da_lambda,
              da_subln_g, gla_gate_w2, gla_gate_b, gla_norm_g, w_out, router_group_w,
              router_group_b, router_expert_w, router_expert_b, expert_w_gate, expert_w_up,
              expert_w_down, final_norm_g):
    B, S, D = x.shape
    L = ctx.shape[1]
    rows = S // GRID_W
    cos, sin = axial_rope_tables(rows, DA_QK_DIM)
    for layer in range(DEPTH):
        last = layer == DEPTH - 1
        lambda_init = 0.8 - 0.6 * math.exp(-0.3 * layer)
        mod_lat = (jax.nn.silu(c) @ w_ada[layer] + b_ada[layer])[:, None, :]
        mod_ctx = jax.nn.silu(c_ctx) @ w_ada[layer] + b_ada[layer]
        sh1, sc1, gt1, sh2, sc2, gt2 = jnp.split(mod_lat, 6, axis=-1)
        csh1, csc1, cgt1, csh2, csc2, cgt2 = jnp.split(mod_ctx, 6, axis=-1)

        h_lat = modulate(rms_norm(x, norm_mix_g[layer]), sh1, sc1)
        h_ctx = modulate(rms_norm(ctx, norm_mix_g[layer]), csh1, csc1)
        y_lat, y_ctx = token_mixer(h_lat, h_ctx, cos, sin, lambda_init, w_in[layer],
                                   da_lambda[layer], da_subln_g[layer], gla_gate_w2[layer],
                                   gla_gate_b[layer], gla_norm_g[layer], w_out[layer],
                                   with_ctx_out=not last)
        x = x + gt1 * y_lat

        moe_args = (router_group_w[layer], router_group_b[layer], router_expert_w[layer],
                    router_expert_b[layer], expert_w_gate[layer], expert_w_up[layer],
                    expert_w_down[layer])
        h2 = modulate(rms_norm(x, norm_ffn_g[layer]), sh2, sc2)
        x = x + gt2 * hier_moe(h2.reshape(B * S, D), *moe_args).reshape(B, S, D)
        if not last:
            ctx = ctx + cgt1 * y_ctx
            hc2 = modulate(rms_norm(ctx, norm_ffn_g[layer]), csh2, csc2)
            ctx = ctx + cgt2 * hier_moe(hc2.reshape(B * L, D), *moe_args).reshape(B, L, D)
    return rms_norm(x, final_norm_g)
```

```cpp
#include <hip/hip_runtime.h>
#include <cstdint>
#include <cstdio>

#define GAS __attribute__((address_space(1)))
#define LAS __attribute__((address_space(3)))
typedef unsigned short bf16;
typedef float f32x4 __attribute__((ext_vector_type(4)));
typedef float f32x2 __attribute__((ext_vector_type(2)));
typedef unsigned u32x4 __attribute__((ext_vector_type(4)));
typedef unsigned u32x2 __attribute__((ext_vector_type(2)));

constexpr int NB = 16, SEQ = 2048, DM = 1024, CTXL = 256, KVL = CTXL + SEQ;
constexpr int NTOK = NB * SEQ;
constexpr int NROW = NB * KVL;
constexpr int NPROJ = 3104, NPROJ_PAD = 3328;
constexpr int NEXP = 32, EHID = 512;
constexpr int MOE_ROWS_MAX = 73728;
constexpr float NORM_EPS = 1e-6f;
constexpr float LAMBDA_INIT = 0.2f;
constexpr float QSCALE = 0.125f * 1.4426950408889634f;

constexpr int C_DAQ = 0, C_DAK = 512, C_DAV = 1024, C_GQ = 1536, C_GK = 1792, C_GV = 2048, C_GR = 2560, C_LR = 3072;

constexpr size_t MiB = 1u << 20;
constexpr size_t WS_CTL = 0, CTL_ZERO_BYTES = 1 * MiB;
constexpr size_t WS_MOD = 1 * MiB;
constexpr size_t WS_ROPE = 1 * MiB + 512 * 1024;
constexpr size_t WS_ROUTE = 2 * MiB;
constexpr size_t WS_LIST = 3 * MiB;
constexpr size_t WS_WIN_T = 7 * MiB;
constexpr size_t WS_WOUT_T = 14 * MiB;
constexpr size_t WS_WGU_T = 16 * MiB;
constexpr size_t WS_WD_T = 80 * MiB;
constexpr size_t WS_H = 112 * MiB;
constexpr size_t WS_HMID = 112 * MiB;
constexpr size_t WS_QDA = 184 * MiB;
constexpr size_t WS_KDA = 216 * MiB;
constexpr size_t WS_VDA = 252 * MiB;
constexpr size_t WS_GQ = 288 * MiB;
constexpr size_t WS_GK = 304 * MiB;
constexpr size_t WS_GV = 322 * MiB;
constexpr size_t WS_GR = 358 * MiB;
constexpr size_t WS_LR = 390 * MiB;
constexpr size_t WS_X1 = 184 * MiB;
constexpr size_t WS_H2 = 312 * MiB;
constexpr size_t WS_YB = 312 * MiB;
constexpr size_t WS_MIX = 395 * MiB;
constexpr size_t WS_OF = 184 * MiB;
constexpr size_t WS_OB = 112 * MiB;
constexpr size_t WS_END = 459 * MiB;

constexpr int CW_BAR = 4096;
constexpr int CW_CNT = 16384;

struct Ctx {
    const float *x, *c, *ctx, *c_ctx, *w_ada, *b_ada, *g_mix, *g_ffn, *w_in, *da_lambda, *da_subln_g, *gate_w2, *gate_b, *gla_norm_g, *w_out,
        *w_rg, *b_rg, *w_re, *b_re, *w_gate, *w_up, *w_down, *g_final;
    float* out; unsigned char* ws;
};

__device__ __forceinline__ unsigned f2bf(float f) { unsigned u = __builtin_bit_cast(unsigned, f); return (u + 0x7fffu + ((u >> 16) & 1u)) >> 16; }
__device__ __forceinline__ unsigned pk2(float lo, float hi) { return f2bf(lo) | (f2bf(hi) << 16); }
__device__ __forceinline__ float bf2f(unsigned b) { return __builtin_bit_cast(float, b << 16); }
__device__ __forceinline__ float bflo(unsigned w) { return __builtin_bit_cast(float, w << 16); }
__device__ __forceinline__ float bfhi(unsigned w) { return __builtin_bit_cast(float, w & 0xffff0000u); }
__device__ __forceinline__ float wave_sum(float v) {
#pragma unroll
    for (int o = 1; o < 64; o <<= 1) v += __shfl_xor(v, o);
    return v;
}
__device__ __forceinline__ float silu_f(float v) { return v / (1.0f + __expf(-v)); }
#define LDS_WAIT() asm volatile("s_waitcnt lgkmcnt(0)" ::: "memory")

template <class RowMap>
__device__ __forceinline__ void transpose_item(const float* W, int ldw, int k0, int n0, bf16* WT, int KT, const RowMap& rm, LAS float* scr, int lane) {
#pragma unroll 8
    for (int i = 0; i < 32; ++i) { const int kk = 2 * i + (lane >> 5); scr[kk * 33 + (lane & 31)] = W[(size_t)(k0 + kk) * ldw + n0 + (lane & 31)]; }
    LDS_WAIT(); asm volatile("" ::: "memory");
    const int c = lane & 7;
#pragma unroll
    for (int j = 0; j < 4; ++j) { const int n = (lane >> 3) + 8 * j; const LAS float* s = scr + (8 * c) * 33 + n;
        u32x4 o; o.x = pk2(s[0 * 33], s[1 * 33]); o.y = pk2(s[2 * 33], s[3 * 33]); o.z = pk2(s[4 * 33], s[5 * 33]); o.w = pk2(s[6 * 33], s[7 * 33]);
        *(u32x4*)(WT + (size_t)rm(n0 + n) * KT + k0 + 8 * c) = o; }
    LDS_WAIT(); asm volatile("" ::: "memory");
}
struct RowId { int off; __device__ __forceinline__ int operator()(int n) const { return off + n; } };
struct RowRope { __device__ __forceinline__ int operator()(int n) const { const int l = n & 31; return (n & ~31) + ((l & 15) << 1) + (l >> 4); } };
struct RowGU { int up; __device__ __forceinline__ int operator()(int n) const { return 8 * (n >> 2) + (n & 3) + 4 * up; } };

__device__ __forceinline__ void ph_prologue(const Ctx& c, LAS unsigned char* lds) {
    const int tid = threadIdx.x, lane = tid & 63, wave = tid >> 6, nw = blockDim.x >> 6;
    unsigned char* ws = c.ws;
    if (blockIdx.x < 96 && nw == 8) {
        LAS float* sv = (LAS float*)lds;
        LAS float* red = sv + 17 * 1024;
        for (int i = tid; i < 17 * 1024; i += 512) { const int r = i >> 10, k = i & 1023; const float v = r < 16 ? c.c[r * 1024 + k] : c.c_ctx[k]; sv[i] = v / (1.0f + expf(-v)); }
        __syncthreads();
        const int col = blockIdx.x * 64 + lane;
        float acc[17];
#pragma unroll
        for (int r = 0; r < 17; ++r) acc[r] = 0.f;
        for (int k = wave * 128; k < wave * 128 + 128; ++k) { const float w = c.w_ada[(size_t)k * 6144 + col];
#pragma unroll
            for (int r = 0; r < 17; ++r) acc[r] += sv[r * 1024 + k] * w; }
#pragma unroll
        for (int r = 0; r < 17; ++r) red[(wave * 17 + r) * 64 + lane] = acc[r];
        __syncthreads();
        float* MOD = (float*)(ws + WS_MOD);
        for (int i = tid; i < 17 * 64; i += 512) { const int r = i >> 6, l = i & 63; float s = 0.f;
            for (int w = 0; w < 8; ++w) s += red[(w * 17 + r) * 64 + l];
            MOD[r * 6144 + blockIdx.x * 64 + l] = s + c.b_ada[blockIdx.x * 64 + l]; }
        __syncthreads();
    }
    { f32x2* ROPE = (f32x2*)(ws + WS_ROPE);
      for (int i = blockIdx.x * blockDim.x + tid; i < 2048 * 32; i += gridDim.x * blockDim.x) {
          const int t = i >> 5, a = (i >> 4) & 1, f = i & 15; const float pos = (float)(a == 0 ? (t >> 6) : (t & 63));
          const float inv = exp2f(-(float)f * (13.287712379549449f / 16.0f));
          const float ang = pos * inv; f32x2 cs; cs.x = __cosf(ang); cs.y = __sinf(ang); ROPE[i] = cs; } }
    { u32x4* z = (u32x4*)(ws + WS_WIN_T + (size_t)NPROJ * 1024 * 2); const int n16 = (NPROJ_PAD - NPROJ) * 1024 * 2 / 16;
      for (int i = blockIdx.x * blockDim.x + tid; i < n16; i += gridDim.x * blockDim.x) z[i] = (u32x4){0u, 0u, 0u, 0u}; }
    LAS float* scr = (LAS float*)(lds + wave * 8704);
    const int gw = blockIdx.x * nw + wave, NGW = gridDim.x * nw;
    constexpr int I_IN = 16 * 97, I_OUT = 16 * 32, I_G = 32 * 16 * 16, I_U = I_G, I_D = 32 * 8 * 32;
    constexpr int NITEMS = I_IN + I_OUT + I_G + I_U + I_D;
    bf16* WIN_T = (bf16*)(ws + WS_WIN_T); bf16* WOUT_T = (bf16*)(ws + WS_WOUT_T); bf16* WGU_T = (bf16*)(ws + WS_WGU_T); bf16* WD_T = (bf16*)(ws + WS_WD_T);
    for (int it = gw; it < NITEMS; it += NGW) {
        int r = it;
        if (r < I_IN) { const int kb = r / 97, nb = r % 97, n0 = nb * 32;
            if (n0 < 1024) transpose_item(c.w_in, NPROJ, kb * 64, n0, WIN_T, 1024, RowRope{}, scr, lane);
            else transpose_item(c.w_in, NPROJ, kb * 64, n0, WIN_T, 1024, RowId{0}, scr, lane);
            continue; }
        r -= I_IN;
        if (r < I_OUT) { const int kb = r / 32, nb = r % 32; transpose_item(c.w_out, 1024, kb * 64, nb * 32, WOUT_T, 1024, RowId{0}, scr, lane); continue; }
        r -= I_OUT;
        if (r < I_G) { const int e = r / 256, q = r % 256, kb = q / 16, nb = q % 16;
            transpose_item(c.w_gate + (size_t)e * 1024 * 512, 512, kb * 64, nb * 32, WGU_T + (size_t)e * 1024 * 1024, 1024, RowGU{0}, scr, lane); continue; }
        r -= I_G;
        if (r < I_U) { const int e = r / 256, q = r % 256, kb = q / 16, nb = q % 16;
            transpose_item(c.w_up + (size_t)e * 1024 * 512, 512, kb * 64, nb * 32, WGU_T + (size_t)e * 1024 * 1024, 1024, RowGU{1}, scr, lane); continue; }
        r -= I_U;
        { const int e = r / 256, q = r % 256, kb = q / 32, nb = q % 32;
            transpose_item(c.w_down + (size_t)e * 512 * 1024, 1024, kb * 64, nb * 32, WD_T + (size_t)e * 1024 * 512, 512, RowId{0}, scr, lane); }
    }
}

__device__ __forceinline__ void ph_norm1(const Ctx& c) {
    const int tid = threadIdx.x, lane = tid & 63, wave = tid >> 6, nw = blockDim.x >> 6;
    const int gw = blockIdx.x * nw + wave, NGW = gridDim.x * nw;
    const float* MOD = (const float*)(c.ws + WS_MOD); bf16* H = (bf16*)(c.ws + WS_H);
    f32x4 g[4];
#pragma unroll
    for (int j = 0; j < 4; ++j) g[j] = *(const f32x4*)(c.g_mix + 4 * lane + 256 * j);
    for (int r = gw; r < NROW; r += NGW) {
        const int b = r / KVL, j = r % KVL; const bool isctx = j < CTXL;
        const float* src = isctx ? c.ctx + ((size_t)b * CTXL + j) * DM : c.x + ((size_t)b * SEQ + (j - CTXL)) * DM;
        const float* mod = MOD + (isctx ? 16 : b) * 6144;
        f32x4 v[4]; float ss = 0.f;
#pragma unroll
        for (int q = 0; q < 4; ++q) { v[q] = *(const f32x4*)(src + 4 * lane + 256 * q); ss += (v[q].x * v[q].x + v[q].y * v[q].y) + (v[q].z * v[q].z + v[q].w * v[q].w); }
        const float rstd = rsqrtf(wave_sum(ss) * (1.0f / DM) + NORM_EPS);
#pragma unroll
        for (int q = 0; q < 4; ++q) { const f32x4 sh = *(const f32x4*)(mod + 4 * lane + 256 * q), sc = *(const f32x4*)(mod + 1024 + 4 * lane + 256 * q);
            const f32x4 o = (v[q] * rstd * g[q]) * (sc + 1.0f) + sh;
            u32x2 w; w.x = pk2(o.x, o.y); w.y = pk2(o.z, o.w); *(u32x2*)(H + (size_t)r * DM + 4 * lane + 256 * q) = w; }
    }
}

__device__ __forceinline__ u32x4 pack8(const f32x4& a, const f32x4& b) { u32x4 w; w.x = pk2(a.x, a.y); w.y = pk2(a.z, a.w); w.z = pk2(b.x, b.y); w.w = pk2(b.z, b.w); return w; }
struct EpiInProj {
    unsigned char* ws;
    __device__ __forceinline__ void rope8(int t, int i8, f32x4& a, f32x4& b, float scale) const {
        const f32x2* R = (const f32x2*)(ws + WS_ROPE) + (size_t)t * 32 + (i8 >> 5) * 16 + ((i8 & 31) >> 1);
        const f32x4 c0 = *(const f32x4*)R, c1 = *(const f32x4*)(R + 2);
        f32x4 oa, ob;
        oa.x = (a.x * c0.x - a.y * c0.y) * scale; oa.y = (a.y * c0.x + a.x * c0.y) * scale;
        oa.z = (a.z * c0.z - a.w * c0.w) * scale; oa.w = (a.w * c0.z + a.z * c0.w) * scale;
        ob.x = (b.x * c1.x - b.y * c1.y) * scale; ob.y = (b.y * c1.x + b.x * c1.y) * scale;
        ob.z = (b.z * c1.z - b.w * c1.w) * scale; ob.w = (b.w * c1.z + b.z * c1.w) * scale;
        a = oa; b = ob;
    }
    __device__ __forceinline__ void emit8(int row, int col, f32x4 a, f32x4 b) const {
        const int bb = row / KVL, j = row % KVL; const bool lat = j >= CTXL; const int t = j - CTXL; const size_t tl = (size_t)bb * SEQ + t;
        if (col < C_DAK) { if (!lat) return; rope8(t, col & 63, a, b, QSCALE); *(u32x4*)((bf16*)(ws + WS_QDA) + tl * 512 + col) = pack8(a, b); }
        else if (col < C_DAV) { if (lat) rope8(t, col & 63, a, b, 1.0f); *(u32x4*)((bf16*)(ws + WS_KDA) + (size_t)row * 512 + (col - C_DAK)) = pack8(a, b); }
        else if (col < C_GQ) { *(u32x4*)((bf16*)(ws + WS_VDA) + (size_t)row * 512 + (col - C_DAV)) = pack8(a, b); }
        else if (col < C_GK) { if (!lat) return; *(u32x4*)((bf16*)(ws + WS_GQ) + tl * 256 + (col - C_GQ)) = pack8(a * 0.125f, b * 0.125f); }
        else if (col < C_GV) { *(u32x4*)((bf16*)(ws + WS_GK) + (size_t)row * 256 + (col - C_GK)) = pack8(a, b); }
        else if (col < C_GR) { *(u32x4*)((bf16*)(ws + WS_GV) + (size_t)row * 512 + (col - C_GV)) = pack8(a, b); }
        else if (col < C_LR) { if (!lat) return; *(u32x4*)((bf16*)(ws + WS_GR) + tl * 512 + (col - C_GR)) = pack8(a, b); }
        else if (col < NPROJ) { float* p = (float*)(ws + WS_LR) + (size_t)row * 32 + (col - C_LR); *(f32x4*)p = a; *(f32x4*)(p + 4) = b; }
    }
};
struct EpiOutProj {
    const float* x; const float* MOD; float* X1;
    __device__ __forceinline__ void emit8(int row, int col, f32x4 a, f32x4 b) const {
        const int bb = row / SEQ; const float* g = MOD + bb * 6144 + 2048 + col; const size_t o = (size_t)row * DM + col;
        const f32x4 g0 = *(const f32x4*)g, g1 = *(const f32x4*)(g + 4), x0 = *(const f32x4*)(x + o), x1 = *(const f32x4*)(x + o + 4);
        *(f32x4*)(X1 + o) = x0 + g0 * a; *(f32x4*)(X1 + o + 4) = x1 + g1 * b;
    }
};
struct EpiGateUp {
    bf16* HMID;
    __device__ __forceinline__ void emit8(int row, int col, f32x4 a, f32x4 b) const {
        f32x4 h; h.x = silu_f(a.x) * b.x; h.y = silu_f(a.y) * b.y; h.z = silu_f(a.z) * b.z; h.w = silu_f(a.w) * b.w;
        u32x2 w; w.x = pk2(h.x, h.y); w.y = pk2(h.z, h.w); *(u32x2*)(HMID + (size_t)row * EHID + (col >> 1)) = w;
    }
};
struct EpiDown {
    bf16* YB;
    __device__ __forceinline__ void emit8(int row, int col, f32x4 a, f32x4 b) const { *(u32x4*)(YB + (size_t)row * DM + col) = pack8(a, b); }
};

__device__ __forceinline__ void moe_build(LAS int* mm, const unsigned* ctl) {
    if (threadIdx.x == 0) { int acc = 0;
        for (int e = 0; e < NEXP; ++e) { const int cnt = (int)__hip_atomic_load(ctl + CW_CNT + 64 * e, __ATOMIC_RELAXED, __HIP_MEMORY_SCOPE_AGENT); mm[e] = cnt; mm[32 + e] = acc; acc += (cnt + 255) >> 8; }
        mm[64] = acc; }
    __syncthreads();
}
__device__ __forceinline__ int moe_tile_expert(const LAS int* mm, int tile) { int e = 0;
#pragma unroll 1
    for (int i = 1; i < NEXP; ++i) if (mm[32 + i] <= tile) e = i;
    return e; }

struct ProbInProj { const bf16* H; const bf16* W; EpiInProj epi; static constexpr int K = 1024;
    __device__ __forceinline__ bool tile_ok(int, LAS int*) const { return true; }
    __device__ __forceinline__ const bf16* a_row(int m, const LAS int*) const { return H + (size_t)m * 1024; }
    __device__ __forceinline__ const bf16* b_row(int, int n, const LAS int*) const { return W + (size_t)n * 1024; } };
struct ProbOutProj { const bf16* A; const bf16* W; EpiOutProj epi; static constexpr int K = 1024;
    __device__ __forceinline__ bool tile_ok(int, LAS int*) const { return true; }
    __device__ __forceinline__ const bf16* a_row(int m, const LAS int*) const { return A + (size_t)m * 1024; }
    __device__ __forceinline__ const bf16* b_row(int, int n, const LAS int*) const { return W + (size_t)n * 1024; } };
struct ProbGateUp { const bf16* H2; const bf16* W; const int* LIST; const unsigned* ctl; EpiGateUp epi; static constexpr int K = 1024;
    __device__ __forceinline__ bool tile_ok(int mt, LAS int* mm) const { moe_build(mm, ctl); return (mt * 64) / 256 < mm[64]; }
    __device__ __forceinline__ const bf16* a_row(int m, const LAS int* mm) const { const int e = moe_tile_expert(mm, m >> 8); const int pos = m - (mm[32 + e] << 8);
        const int tok = LIST[e * NTOK + (pos < mm[e] ? pos : 0)]; return H2 + (size_t)tok * 1024; }
    __device__ __forceinline__ const bf16* b_row(int mt, int n, const LAS int* mm) const { const int e = moe_tile_expert(mm, (mt * 64) >> 8); return W + ((size_t)e * 1024 + n) * 1024; } };
struct ProbDown { const bf16* HM; const bf16* W; const unsigned* ctl; EpiDown epi; static constexpr int K = 512;
    __device__ __forceinline__ bool tile_ok(int mt, LAS int* mm) const { moe_build(mm, ctl); return (mt * 64) / 256 < mm[64]; }
    __device__ __forceinline__ const bf16* a_row(int m, const LAS int*) const { return HM + (size_t)m * 512; }
    __device__ __forceinline__ const bf16* b_row(int mt, int n, const LAS int* mm) const { const int e = moe_tile_expert(mm, (mt * 64) >> 8); return W + ((size_t)e * 1024 + n) * 512; } };

template <class P> __global__ void __launch_bounds__(256) naive_gemm(P p) {
    __shared__ float As[64][33]; __shared__ float Bs[64][33]; __shared__ int mm[72];
    const int tid = threadIdx.x, nt = blockIdx.x, mt = blockIdx.y;
    if (!p.tile_ok(mt, (LAS int*)mm)) return;
    const int lr = tid >> 2, lk = (tid & 3) * 8;
    const bf16* ap = p.a_row(mt * 64 + lr, (const LAS int*)mm) + lk; const bf16* bp = p.b_row(mt, nt * 64 + lr, (const LAS int*)mm) + lk;
    const int ty = tid >> 3, tx = tid & 7;
    float acc[2][8];
#pragma unroll
    for (int i = 0; i < 2; ++i)
#pragma unroll
        for (int j = 0; j < 8; ++j) acc[i][j] = 0.f;
    for (int k0 = 0; k0 < P::K; k0 += 32) {
        const u32x4 av = *(const u32x4*)(ap + k0), bv = *(const u32x4*)(bp + k0);
        __syncthreads();
        As[lr][lk + 0] = bflo(av.x); As[lr][lk + 1] = bfhi(av.x); As[lr][lk + 2] = bflo(av.y); As[lr][lk + 3] = bfhi(av.y);
        As[lr][lk + 4] = bflo(av.z); As[lr][lk + 5] = bfhi(av.z); As[lr][lk + 6] = bflo(av.w); As[lr][lk + 7] = bfhi(av.w);
        Bs[lr][lk + 0] = bflo(bv.x); Bs[lr][lk + 1] = bfhi(bv.x); Bs[lr][lk + 2] = bflo(bv.y); Bs[lr][lk + 3] = bfhi(bv.y);
        Bs[lr][lk + 4] = bflo(bv.z); Bs[lr][lk + 5] = bfhi(bv.z); Bs[lr][lk + 6] = bflo(bv.w); Bs[lr][lk + 7] = bfhi(bv.w);
        __syncthreads();
#pragma unroll 8
        for (int kk = 0; kk < 32; ++kk) { const float a0 = As[ty * 2][kk], a1 = As[ty * 2 + 1][kk];
#pragma unroll
            for (int j = 0; j < 8; ++j) { const float bq = Bs[tx * 8 + j][kk]; acc[0][j] += a0 * bq; acc[1][j] += a1 * bq; } }
    }
#pragma unroll
    for (int i = 0; i < 2; ++i) p.epi.emit8(mt * 64 + ty * 2 + i, nt * 64 + tx * 8, (f32x4){acc[i][0], acc[i][1], acc[i][2], acc[i][3]}, (f32x4){acc[i][4], acc[i][5], acc[i][6], acc[i][7]});
}

__device__ __forceinline__ float da_lambda_full(const float* lp) {
    float s0 = 0.f, s1 = 0.f;
    for (int i = 0; i < 64; ++i) { s0 += lp[i] * lp[64 + i]; s1 += lp[128 + i] * lp[192 + i]; }
    return expf(s0) - expf(s1) + LAMBDA_INIT;
}
__global__ void __launch_bounds__(256, 1) naive_attn(Ctx c) {
    __shared__ float ks[64][128]; __shared__ float vs[64][128];
    const bf16* Q = (const bf16*)(c.ws + WS_QDA); const bf16* K = (const bf16*)(c.ws + WS_KDA); const bf16* V = (const bf16*)(c.ws + WS_VDA); bf16* MIX = (bf16*)(c.ws + WS_MIX);
    const int tid = threadIdx.x, bh = blockIdx.x >> 3, qb = blockIdx.x & 7, b = bh >> 2, h = bh & 3;
    const size_t tl = (size_t)b * SEQ + qb * 256 + tid;
    float q1[64], q2[64], o1[128], o2[128];
    { const u32x4* qp = (const u32x4*)(Q + tl * 512 + h * 128);
#pragma unroll
      for (int i = 0; i < 8; ++i) { const u32x4 w = qp[i]; q1[8 * i] = bflo(w.x); q1[8 * i + 1] = bfhi(w.x); q1[8 * i + 2] = bflo(w.y); q1[8 * i + 3] = bfhi(w.y); q1[8 * i + 4] = bflo(w.z); q1[8 * i + 5] = bfhi(w.z); q1[8 * i + 6] = bflo(w.w); q1[8 * i + 7] = bfhi(w.w); }
#pragma unroll
      for (int i = 0; i < 8; ++i) { const u32x4 w = qp[8 + i]; q2[8 * i] = bflo(w.x); q2[8 * i + 1] = bfhi(w.x); q2[8 * i + 2] = bflo(w.y); q2[8 * i + 3] = bfhi(w.y); q2[8 * i + 4] = bflo(w.z); q2[8 * i + 5] = bfhi(w.z); q2[8 * i + 6] = bflo(w.w); q2[8 * i + 7] = bfhi(w.w); } }
#pragma unroll
    for (int e = 0; e < 128; ++e) { o1[e] = 0.f; o2[e] = 0.f; }
    float m1 = -1e30f, m2 = -1e30f, l1 = 0.f, l2 = 0.f;
    const int lrow = tid >> 2, lcol = (tid & 3) * 32;
    for (int t0 = 0; t0 < KVL; t0 += 64) {
        __syncthreads();
        { const size_t r = (size_t)b * KVL + t0 + lrow; const u32x4* kp = (const u32x4*)(K + r * 512 + h * 128 + lcol); const u32x4* vp = (const u32x4*)(V + r * 512 + h * 128 + lcol);
#pragma unroll
          for (int i = 0; i < 4; ++i) { const u32x4 w = kp[i], u = vp[i]; float* kd = &ks[lrow][lcol + 8 * i]; float* vd = &vs[lrow][lcol + 8 * i];
              kd[0] = bflo(w.x); kd[1] = bfhi(w.x); kd[2] = bflo(w.y); kd[3] = bfhi(w.y); kd[4] = bflo(w.z); kd[5] = bfhi(w.z); kd[6] = bflo(w.w); kd[7] = bfhi(w.w);
              vd[0] = bflo(u.x); vd[1] = bfhi(u.x); vd[2] = bflo(u.y); vd[3] = bfhi(u.y); vd[4] = bflo(u.z); vd[5] = bfhi(u.z); vd[6] = bflo(u.w); vd[7] = bfhi(u.w); } }
        __syncthreads();
#pragma unroll 1
        for (int j = 0; j < 64; ++j) {
            float s1 = 0.f, s2 = 0.f;
#pragma unroll
            for (int d = 0; d < 64; ++d) { s1 += q1[d] * ks[j][d]; s2 += q2[d] * ks[j][64 + d]; }
            if (s1 > m1) { const float cf = exp2f(m1 - s1); l1 *= cf;
#pragma unroll
                for (int e = 0; e < 128; ++e) o1[e] *= cf;
                m1 = s1; }
            if (s2 > m2) { const float cf = exp2f(m2 - s2); l2 *= cf;
#pragma unroll
                for (int e = 0; e < 128; ++e) o2[e] *= cf;
                m2 = s2; }
            const float p1 = exp2f(s1 - m1), p2 = exp2f(s2 - m2); l1 += p1; l2 += p2;
#pragma unroll
            for (int e = 0; e < 128; ++e) { const float v = vs[j][e]; o1[e] += p1 * v; o2[e] += p2 * v; }
        }
    }
    const float lam = da_lambda_full(c.da_lambda); const float i1 = 1.0f / l1, i2 = lam / l2; float ss = 0.f;
#pragma unroll
    for (int e = 0; e < 128; ++e) { o1[e] = o1[e] * i1 - o2[e] * i2; ss += o1[e] * o1[e]; }
    const float rstd = rsqrtf(ss * (1.0f / 128.0f) + NORM_EPS) * (1.0f - LAMBDA_INIT);
    u32x4* op = (u32x4*)(MIX + tl * 1024 + h * 128);
#pragma unroll
    for (int i = 0; i < 16; ++i) { const float* g = c.da_subln_g + 8 * i; u32x4 w;
        w.x = pk2(o1[8 * i] * rstd * g[0], o1[8 * i + 1] * rstd * g[1]); w.y = pk2(o1[8 * i + 2] * rstd * g[2], o1[8 * i + 3] * rstd * g[3]);
        w.z = pk2(o1[8 * i + 4] * rstd * g[4], o1[8 * i + 5] * rstd * g[5]); w.w = pk2(o1[8 * i + 6] * rstd * g[6], o1[8 * i + 7] * rstd * g[7]); op[i] = w; }
}

__device__ __forceinline__ int gla_jrow(int dir, int s) { return dir == 0 ? s : (s < CTXL ? CTXL - 1 - s : KVL + CTXL - 1 - s); }
__device__ __forceinline__ float log_sigmoid_f(float z) { return fminf(z, 0.f) - log1pf(expf(-fabsf(z))); }
__global__ void __launch_bounds__(128) naive_gla(Ctx c) {
    __shared__ float dec[64][64]; __shared__ float kk[64][64]; __shared__ float qq[64][64];
    const bf16* GQ = (const bf16*)(c.ws + WS_GQ); const bf16* GK = (const bf16*)(c.ws + WS_GK); const bf16* GV = (const bf16*)(c.ws + WS_GV); const float* LR = (const float*)(c.ws + WS_LR);
    const int dir = blockIdx.x & 1, h = (blockIdx.x >> 1) & 3, b = blockIdx.x >> 3, e = threadIdx.x;
    float* O = (float*)(c.ws + (dir ? WS_OB : WS_OF));
    const float* w2d = c.gate_w2 + dir * 16 * 256 + h * 64; const float* gbd = c.gate_b + dir * 256 + h * 64;
    float S[64];
#pragma unroll
    for (int d = 0; d < 64; ++d) S[d] = 0.f;
    for (int s0 = 0; s0 < KVL; s0 += 64) {
        __syncthreads();
        for (int i = threadIdx.x; i < 4096; i += 128) { const int s = i >> 6, d = i & 63; const int j = gla_jrow(dir, s0 + s); const size_t row = (size_t)b * KVL + j;
            float z = gbd[d];
            for (int r = 0; r < 16; ++r) z += LR[row * 32 + dir * 16 + r] * w2d[r * 256 + d];
            dec[s][d] = expf(log_sigmoid_f(z) * (1.0f / 16.0f));
            kk[s][d] = bf2f(GK[row * 256 + h * 64 + d]);
            qq[s][d] = j >= CTXL ? bf2f(GQ[((size_t)b * SEQ + (j - CTXL)) * 256 + h * 64 + d]) : 0.f; }
        __syncthreads();
#pragma unroll 1
        for (int s = 0; s < 64; ++s) { const int j = gla_jrow(dir, s0 + s); const size_t row = (size_t)b * KVL + j; const float v = bf2f(GV[row * 512 + h * 128 + e]);
            float o = 0.f;
#pragma unroll
            for (int d = 0; d < 64; ++d) { S[d] = S[d] * dec[s][d] + kk[s][d] * v; o += qq[s][d] * S[d]; }
            if (j >= CTXL) O[((size_t)b * SEQ + (j - CTXL)) * 512 + h * 128 + e] = o; }
    }
}
__global__ void __launch_bounds__(256) naive_gla_post(Ctx c) {
    const float* OF = (const float*)(c.ws + WS_OF); const float* OB = (const float*)(c.ws + WS_OB); const bf16* GR = (const bf16*)(c.ws + WS_GR); bf16* MIX = (bf16*)(c.ws + WS_MIX);
    const int lane = threadIdx.x & 63; const int gw = blockIdx.x * 4 + (threadIdx.x >> 6), NGW = gridDim.x * 4;
    for (int it = gw; it < NTOK * 4; it += NGW) { const size_t tl = it >> 2; const int h = it & 3; const size_t o = tl * 512 + h * 128 + 2 * lane;
        const f32x2 a = *(const f32x2*)(OF + o), bq = *(const f32x2*)(OB + o); const float v0 = a.x + bq.x, v1 = a.y + bq.y;
        const float rstd = rsqrtf(wave_sum(v0 * v0 + v1 * v1) * (1.0f / 128.0f) + NORM_EPS);
        const unsigned gr = *(const unsigned*)(GR + o); const float g0 = c.gla_norm_g[2 * lane], g1 = c.gla_norm_g[2 * lane + 1];
        *(unsigned*)(MIX + tl * 1024 + 512 + h * 128 + 2 * lane) = pk2(v0 * rstd * g0 * silu_f(bflo(gr)), v1 * rstd * g1 * silu_f(bfhi(gr))); }
}

__device__ __forceinline__ void ph_router(const Ctx& c, LAS unsigned char* lds) {
    const int tid = threadIdx.x, lane = tid & 63, wave = tid >> 6;
    const float* MOD = (const float*)(c.ws + WS_MOD); const float* X1 = (const float*)(c.ws + WS_X1); bf16* H2 = (bf16*)(c.ws + WS_H2);
    int* ROUTE = (int*)(c.ws + WS_ROUTE); int* LIST = (int*)(c.ws + WS_LIST); unsigned* ctl = (unsigned*)(c.ws + WS_CTL);
    LAS int* bcnt = (LAS int*)lds;
    LAS int* rt = bcnt + 64;
    f32x4 g[4];
#pragma unroll
    for (int q = 0; q < 4; ++q) g[q] = *(const f32x4*)(c.g_ffn + 4 * lane + 256 * q);
    for (int base = blockIdx.x * 128; base < NTOK; base += gridDim.x * 128) {
        if (tid < 32) bcnt[tid] = 0;
        __syncthreads();
        for (int i = 0; i < 16; ++i) {
            const int lt = wave * 16 + i, tok = base + lt, bb = tok / SEQ; const float* mod = MOD + bb * 6144;
            f32x4 v[4]; float ss = 0.f;
#pragma unroll
            for (int q = 0; q < 4; ++q) { v[q] = *(const f32x4*)(X1 + (size_t)tok * DM + 4 * lane + 256 * q); ss += (v[q].x * v[q].x + v[q].y * v[q].y) + (v[q].z * v[q].z + v[q].w * v[q].w); }
            const float rstd = rsqrtf(wave_sum(ss) * (1.0f / DM) + NORM_EPS);
#pragma unroll
            for (int q = 0; q < 4; ++q) { const f32x4 sh = *(const f32x4*)(mod + 3072 + 4 * lane + 256 * q), sc = *(const f32x4*)(mod + 4096 + 4 * lane + 256 * q);
                v[q] = (v[q] * rstd * g[q]) * (sc + 1.0f) + sh;
                u32x2 w; w.x = pk2(v[q].x, v[q].y); w.y = pk2(v[q].z, v[q].w); *(u32x2*)(H2 + (size_t)tok * DM + 4 * lane + 256 * q) = w; }
            float gl[4];
#pragma unroll
            for (int n = 0; n < 4; ++n) { float p = 0.f;
#pragma unroll
                for (int q = 0; q < 4; ++q) { const int k = 4 * lane + 256 * q; p += v[q].x * c.w_rg[(k + 0) * 4 + n] + v[q].y * c.w_rg[(k + 1) * 4 + n] + v[q].z * c.w_rg[(k + 2) * 4 + n] + v[q].w * c.w_rg[(k + 3) * 4 + n]; }
                gl[n] = wave_sum(p) + c.b_rg[n]; }
            int gs = 0; float gm = gl[0];
#pragma unroll
            for (int n = 1; n < 4; ++n) if (gl[n] > gm) { gm = gl[n]; gs = n; }
            float gden = 0.f;
#pragma unroll
            for (int n = 0; n < 4; ++n) gden += expf(gl[n] - gm);
            const float gw_ = 1.0f / gden;
            float el[8];
#pragma unroll
            for (int n = 0; n < 8; ++n) { float p = 0.f; const int col = gs * 8 + n;
#pragma unroll
                for (int q = 0; q < 4; ++q) { const int k = 4 * lane + 256 * q; p += v[q].x * c.w_re[(k + 0) * 32 + col] + v[q].y * c.w_re[(k + 1) * 32 + col] + v[q].z * c.w_re[(k + 2) * 32 + col] + v[q].w * c.w_re[(k + 3) * 32 + col]; }
                el[n] = wave_sum(p) + c.b_re[col]; }
            int i0 = 0; float v0 = el[0];
#pragma unroll
            for (int n = 1; n < 8; ++n) if (el[n] > v0) { v0 = el[n]; i0 = n; }
            int i1 = -1; float v1 = -3.0e38f;
#pragma unroll
            for (int n = 0; n < 8; ++n) if (n != i0 && el[n] > v1) { v1 = el[n]; i1 = n; }
            const float e1 = expf(v1 - v0), den = 1.0f + e1; const float w0 = gw_ / den, w1 = gw_ * e1 / den;
            if (lane == 0) { const int e0g = gs * 8 + i0, e1g = gs * 8 + i1; const int r0 = atomicAdd((int*)&bcnt[e0g], 1), r1 = atomicAdd((int*)&bcnt[e1g], 1);
                LAS int* r = rt + lt * 6; r[0] = e0g; r[1] = e1g; r[2] = r0; r[3] = r1; r[4] = __builtin_bit_cast(int, w0); r[5] = __builtin_bit_cast(int, w1); }
        }
        __syncthreads();
        if (tid < 32) bcnt[32 + tid] = (int)__hip_atomic_fetch_add(ctl + CW_CNT + 64 * tid, (unsigned)bcnt[tid], __ATOMIC_RELAXED, __HIP_MEMORY_SCOPE_AGENT);
        __syncthreads();
        if (tid < 128) { const LAS int* r = rt + tid * 6; const int tok = base + tid; const int e0g = r[0], e1g = r[1], p0 = bcnt[32 + e0g] + r[2], p1 = bcnt[32 + e1g] + r[3];
            int* ro = ROUTE + (size_t)tok * 8; ro[0] = e0g; ro[1] = e1g; ro[2] = p0; ro[3] = p1; ro[4] = r[4]; ro[5] = r[5];
            LIST[e0g * NTOK + p0] = tok; LIST[e1g * NTOK + p1] = tok; }
        __syncthreads();
    }
}

__device__ __forceinline__ void ph_final(const Ctx& c, LAS unsigned char* lds) {
    const int tid = threadIdx.x, lane = tid & 63, wave = tid >> 6, nw = blockDim.x >> 6;
    const float* MOD = (const float*)(c.ws + WS_MOD); const float* X1 = (const float*)(c.ws + WS_X1); const bf16* YB = (const bf16*)(c.ws + WS_YB);
    const int* ROUTE = (const int*)(c.ws + WS_ROUTE);
    LAS int* mm = (LAS int*)lds; moe_build(mm, (const unsigned*)(c.ws + WS_CTL));
    f32x4 g[4];
#pragma unroll
    for (int q = 0; q < 4; ++q) g[q] = *(const f32x4*)(c.g_final + 4 * lane + 256 * q);
    for (int tok = blockIdx.x * nw + wave; tok < NTOK; tok += gridDim.x * nw) {
        const int bb = tok / SEQ; const float* gt = MOD + bb * 6144 + 5120; const int* ro = ROUTE + (size_t)tok * 8;
        const int e0 = ro[0], e1 = ro[1]; const size_t r0 = ((size_t)mm[32 + e0] << 8) + ro[2], r1 = ((size_t)mm[32 + e1] << 8) + ro[3];
        const float w0 = __builtin_bit_cast(float, ro[4]), w1 = __builtin_bit_cast(float, ro[5]);
        f32x4 v[4]; float ss = 0.f;
#pragma unroll
        for (int q = 0; q < 4; ++q) { const int col = 4 * lane + 256 * q; const f32x4 xv = *(const f32x4*)(X1 + (size_t)tok * DM + col), gv = *(const f32x4*)(gt + col);
            const u32x2 ya = *(const u32x2*)(YB + r0 * DM + col), yb = *(const u32x2*)(YB + r1 * DM + col);
            f32x4 y; y.x = w0 * bflo(ya.x) + w1 * bflo(yb.x); y.y = w0 * bfhi(ya.x) + w1 * bfhi(yb.x); y.z = w0 * bflo(ya.y) + w1 * bflo(yb.y); y.w = w0 * bfhi(ya.y) + w1 * bfhi(yb.y);
            v[q] = xv + gv * y; ss += (v[q].x * v[q].x + v[q].y * v[q].y) + (v[q].z * v[q].z + v[q].w * v[q].w); }
        const float rstd = rsqrtf(wave_sum(ss) * (1.0f / DM) + NORM_EPS);
#pragma unroll
        for (int q = 0; q < 4; ++q) *(f32x4*)(c.out + (size_t)tok * DM + 4 * lane + 256 * q) = v[q] * rstd * g[q];
    }
}

constexpr int THIN_LDS = 17 * 1024 * 4 + 8 * 17 * 64 * 4;
template <int PH> __global__ void __launch_bounds__(512, 2) k_thin(Ctx c) {
    extern __shared__ __attribute__((aligned(16))) unsigned char lds[];
    if (PH == 0) ph_prologue(c, (LAS unsigned char*)lds);
    if (PH == 1) ph_norm1(c);
    if (PH == 6) ph_router(c, (LAS unsigned char*)lds);
    if (PH == 10) ph_final(c, (LAS unsigned char*)lds);
}

extern "C" void kernel_launch(void* const* d_in, const int* in_sizes, int n_in, void* d_out, int out_size, void* d_ws, size_t ws_size, hipStream_t stream) {
    static int ready = 0;
    if (!ready) {
        if (n_in != 23 || in_sizes[0] != NTOK * DM || out_size != NTOK * DM || ws_size < WS_END) { fprintf(stderr, "kernel_launch: unexpected problem shape (n_in %d, in0 %d, out %d, ws %zu)\n", n_in, n_in > 0 ? in_sizes[0] : -1, out_size, ws_size); ready = -1; return; }
        hipFuncSetAttribute((const void*)k_thin<0>, hipFuncAttributeMaxDynamicSharedMemorySize, THIN_LDS);
        hipFuncSetAttribute((const void*)k_thin<6>, hipFuncAttributeMaxDynamicSharedMemorySize, THIN_LDS);
        hipFuncSetAttribute((const void*)k_thin<10>, hipFuncAttributeMaxDynamicSharedMemorySize, THIN_LDS);
        (void)hipGetLastError();
        ready = 1;
    }
    if (ready < 0) return;
    Ctx c{};
    const float** f = (const float**)&c;
    for (int i = 0; i < 23; ++i) f[i] = (const float*)d_in[i];
    c.out = (float*)d_out; c.ws = (unsigned char*)d_ws;
    unsigned char* ws = c.ws;
    hipMemsetAsync(ws + WS_CTL, 0, CTL_ZERO_BYTES, stream);
    k_thin<0><<<256, 512, THIN_LDS, stream>>>(c);
    k_thin<1><<<256, 512, 0, stream>>>(c);
    { ProbInProj p{(const bf16*)(ws + WS_H), (const bf16*)(ws + WS_WIN_T), EpiInProj{ws}}; naive_gemm<ProbInProj><<<dim3(49, NROW / 64), 256, 0, stream>>>(p); }
    naive_attn<<<NB * 4 * 8, 256, 0, stream>>>(c);
    naive_gla<<<NB * 4 * 2, 128, 0, stream>>>(c);
    naive_gla_post<<<2048, 256, 0, stream>>>(c);
    { ProbOutProj p{(const bf16*)(ws + WS_MIX), (const bf16*)(ws + WS_WOUT_T), EpiOutProj{c.x, (const float*)(ws + WS_MOD), (float*)(ws + WS_X1)}}; naive_gemm<ProbOutProj><<<dim3(16, NTOK / 64), 256, 0, stream>>>(p); }
    k_thin<6><<<256, 512, THIN_LDS, stream>>>(c);
    { ProbGateUp p{(const bf16*)(ws + WS_H2), (const bf16*)(ws + WS_WGU_T), (const int*)(ws + WS_LIST), (const unsigned*)(ws + WS_CTL), EpiGateUp{(bf16*)(ws + WS_HMID)}}; naive_gemm<ProbGateUp><<<dim3(16, MOE_ROWS_MAX / 64), 256, 0, stream>>>(p); }
    { ProbDown p{(const bf16*)(ws + WS_HMID), (const bf16*)(ws + WS_WD_T), (const unsigned*)(ws + WS_CTL), EpiDown{(bf16*)(ws + WS_YB)}}; naive_gemm<ProbDown><<<dim3(16, MOE_ROWS_MAX / 64), 256, 0, stream>>>(p); }
    k_thin<10><<<256, 512, THIN_LDS, stream>>>(c);
}
```

```cpp
#include <hip/hip_runtime.h>
#include <cstdint>
#include <cstdio>

#define GAS __attribute__((address_space(1)))
#define LAS __attribute__((address_space(3)))
typedef unsigned short bf16;
typedef float f32x4 __attribute__((ext_vector_type(4)));
typedef float f32x2 __attribute__((ext_vector_type(2)));
typedef unsigned u32x4 __attribute__((ext_vector_type(4)));
typedef unsigned u32x2 __attribute__((ext_vector_type(2)));

constexpr int NB = 16, SEQ = 2048, DM = 1024, CTXL = 256, KVL = CTXL + SEQ;
constexpr int NTOK = NB * SEQ;
constexpr int NROW = NB * KVL;
constexpr int NPROJ = 3104, NPROJ_PAD = 3328;
constexpr int NEXP = 32, EHID = 512;
constexpr int MOE_ROWS_MAX = 73728;
constexpr float NORM_EPS = 1e-6f;
constexpr float LAMBDA_INIT = 0.2f;
constexpr float QSCALE = 0.125f * 1.4426950408889634f;

constexpr int C_DAQ = 0, C_DAK = 512, C_DAV = 1024, C_GQ = 1536, C_GK = 1792, C_GV = 2048, C_GR = 2560, C_LR = 3072;

constexpr size_t MiB = 1u << 20;
constexpr size_t WS_CTL = 0, CTL_ZERO_BYTES = 1 * MiB;
constexpr size_t WS_MOD = 1 * MiB;
constexpr size_t WS_ROPE = 1 * MiB + 512 * 1024;
constexpr size_t WS_ROUTE = 2 * MiB;
constexpr size_t WS_LIST = 3 * MiB;
constexpr size_t WS_WIN_T = 7 * MiB;
constexpr size_t WS_WOUT_T = 14 * MiB;
constexpr size_t WS_WGU_T = 16 * MiB;
constexpr size_t WS_WD_T = 80 * MiB;
constexpr size_t WS_H = 112 * MiB;
constexpr size_t WS_HMID = 112 * MiB;
constexpr size_t WS_QDA = 184 * MiB;
constexpr size_t WS_KDA = 216 * MiB;
constexpr size_t WS_VDA = 252 * MiB;
constexpr size_t WS_GQ = 288 * MiB;
constexpr size_t WS_GK = 304 * MiB;
constexpr size_t WS_GV = 322 * MiB;
constexpr size_t WS_GR = 358 * MiB;
constexpr size_t WS_LR = 390 * MiB;
constexpr size_t WS_X1 = 184 * MiB;
constexpr size_t WS_H2 = 312 * MiB;
constexpr size_t WS_YB = 312 * MiB;
constexpr size_t WS_MIX = 112 * MiB;
constexpr size_t WS_UT = 184 * MiB;
constexpr size_t WS_ST = 395 * MiB;
constexpr size_t WS_DB = 460 * MiB;
constexpr size_t WS_END = 462 * MiB;

constexpr int CW_BAR = 4096;
constexpr int CW_CNT = 16384;

struct Ctx {
    const float *x, *c, *ctx, *c_ctx, *w_ada, *b_ada, *g_mix, *g_ffn, *w_in, *da_lambda, *da_subln_g, *gate_w2, *gate_b, *gla_norm_g, *w_out,
        *w_rg, *b_rg, *w_re, *b_re, *w_gate, *w_up, *w_down, *g_final;
    float* out; unsigned char* ws;
};

__device__ __forceinline__ unsigned f2bf(float f) { unsigned u = __builtin_bit_cast(unsigned, f); return (u + 0x7fffu + ((u >> 16) & 1u)) >> 16; }
__device__ __forceinline__ unsigned pk2(float lo, float hi) { return f2bf(lo) | (f2bf(hi) << 16); }
__device__ __forceinline__ float bf2f(unsigned b) { return __builtin_bit_cast(float, b << 16); }
__device__ __forceinline__ float bflo(unsigned w) { return __builtin_bit_cast(float, w << 16); }
__device__ __forceinline__ float bfhi(unsigned w) { return __builtin_bit_cast(float, w & 0xffff0000u); }
__device__ __forceinline__ float wave_sum(float v) {
#pragma unroll
    for (int o = 1; o < 64; o <<= 1) v += __shfl_xor(v, o);
    return v;
}
__device__ __forceinline__ float silu_f(float v) { return v / (1.0f + __expf(-v)); }
#define LDS_WAIT() asm volatile("s_waitcnt lgkmcnt(0)" ::: "memory")

template <class RowMap>
__device__ __forceinline__ void transpose_item(const float* W, int ldw, int k0, int n0, bf16* WT, int KT, const RowMap& rm, LAS float* scr, int lane) {
#pragma unroll 8
    for (int i = 0; i < 32; ++i) { const int kk = 2 * i + (lane >> 5); scr[kk * 33 + (lane & 31)] = W[(size_t)(k0 + kk) * ldw + n0 + (lane & 31)]; }
    LDS_WAIT(); asm volatile("" ::: "memory");
    const int c = lane & 7;
#pragma unroll
    for (int j = 0; j < 4; ++j) { const int n = (lane >> 3) + 8 * j; const LAS float* s = scr + (8 * c) * 33 + n;
        u32x4 o; o.x = pk2(s[0 * 33], s[1 * 33]); o.y = pk2(s[2 * 33], s[3 * 33]); o.z = pk2(s[4 * 33], s[5 * 33]); o.w = pk2(s[6 * 33], s[7 * 33]);
        *(u32x4*)(WT + (size_t)rm(n0 + n) * KT + k0 + 8 * c) = o; }
    LDS_WAIT(); asm volatile("" ::: "memory");
}
struct RowId { int off; __device__ __forceinline__ int operator()(int n) const { return off + n; } };
struct RowRope { __device__ __forceinline__ int operator()(int n) const { const int l = n & 31; return (n & ~31) + ((l & 15) << 1) + (l >> 4); } };
struct RowGU { int up; __device__ __forceinline__ int operator()(int n) const { return 8 * (n >> 2) + (n & 3) + 4 * up; } };

__device__ __forceinline__ void ph_prologue(const Ctx& c, LAS unsigned char* lds) {
    const int tid = threadIdx.x, lane = tid & 63, wave = tid >> 6, nw = blockDim.x >> 6;
    unsigned char* ws = c.ws;
    if (blockIdx.x < 96 && nw == 8) {
        LAS float* sv = (LAS float*)lds;
        LAS float* red = sv + 17 * 1024;
        for (int i = tid; i < 17 * 1024; i += 512) { const int r = i >> 10, k = i & 1023; const float v = r < 16 ? c.c[r * 1024 + k] : c.c_ctx[k]; sv[i] = v / (1.0f + expf(-v)); }
        __syncthreads();
        const int col = blockIdx.x * 64 + lane;
        float acc[17];
#pragma unroll
        for (int r = 0; r < 17; ++r) acc[r] = 0.f;
        for (int k = wave * 128; k < wave * 128 + 128; ++k) { const float w = c.w_ada[(size_t)k * 6144 + col];
#pragma unroll
            for (int r = 0; r < 17; ++r) acc[r] += sv[r * 1024 + k] * w; }
#pragma unroll
        for (int r = 0; r < 17; ++r) red[(wave * 17 + r) * 64 + lane] = acc[r];
        __syncthreads();
        float* MOD = (float*)(ws + WS_MOD);
        for (int i = tid; i < 17 * 64; i += 512) { const int r = i >> 6, l = i & 63; float s = 0.f;
            for (int w = 0; w < 8; ++w) s += red[(w * 17 + r) * 64 + l];
            MOD[r * 6144 + blockIdx.x * 64 + l] = s + c.b_ada[blockIdx.x * 64 + l]; }
        __syncthreads();
    }
    { f32x2* ROPE = (f32x2*)(ws + WS_ROPE);
      for (int i = blockIdx.x * blockDim.x + tid; i < 2048 * 32; i += gridDim.x * blockDim.x) {
          const int t = i >> 5, a = (i >> 4) & 1, f = i & 15; const float pos = (float)(a == 0 ? (t >> 6) : (t & 63));
          const float inv = exp2f(-(float)f * (13.287712379549449f / 16.0f));
          const float ang = pos * inv; f32x2 cs; cs.x = __cosf(ang); cs.y = __sinf(ang); ROPE[i] = cs; } }
    { u32x4* z = (u32x4*)(ws + WS_WIN_T + (size_t)NPROJ * 1024 * 2); const int n16 = (NPROJ_PAD - NPROJ) * 1024 * 2 / 16;
      for (int i = blockIdx.x * blockDim.x + tid; i < n16; i += gridDim.x * blockDim.x) z[i] = (u32x4){0u, 0u, 0u, 0u}; }
    LAS float* scr = (LAS float*)(lds + wave * 8704);
    const int gw = blockIdx.x * nw + wave, NGW = gridDim.x * nw;
    constexpr int I_IN = 16 * 97, I_OUT = 16 * 32, I_G = 32 * 16 * 16, I_U = I_G, I_D = 32 * 8 * 32;
    constexpr int NITEMS = I_IN + I_OUT + I_G + I_U + I_D;
    bf16* WIN_T = (bf16*)(ws + WS_WIN_T); bf16* WOUT_T = (bf16*)(ws + WS_WOUT_T); bf16* WGU_T = (bf16*)(ws + WS_WGU_T); bf16* WD_T = (bf16*)(ws + WS_WD_T);
    for (int it = gw; it < NITEMS; it += NGW) {
        int r = it;
        if (r < I_IN) { const int kb = r / 97, nb = r % 97, n0 = nb * 32;
            if (n0 < 1024) transpose_item(c.w_in, NPROJ, kb * 64, n0, WIN_T, 1024, RowRope{}, scr, lane);
            else transpose_item(c.w_in, NPROJ, kb * 64, n0, WIN_T, 1024, RowId{0}, scr, lane);
            continue; }
        r -= I_IN;
        if (r < I_OUT) { const int kb = r / 32, nb = r % 32; transpose_item(c.w_out, 1024, kb * 64, nb * 32, WOUT_T, 1024, RowId{0}, scr, lane); continue; }
        r -= I_OUT;
        if (r < I_G) { const int e = r / 256, q = r % 256, kb = q / 16, nb = q % 16;
            transpose_item(c.w_gate + (size_t)e * 1024 * 512, 512, kb * 64, nb * 32, WGU_T + (size_t)e * 1024 * 1024, 1024, RowGU{0}, scr, lane); continue; }
        r -= I_G;
        if (r < I_U) { const int e = r / 256, q = r % 256, kb = q / 16, nb = q % 16;
            transpose_item(c.w_up + (size_t)e * 1024 * 512, 512, kb * 64, nb * 32, WGU_T + (size_t)e * 1024 * 1024, 1024, RowGU{1}, scr, lane); continue; }
        r -= I_U;
        { const int e = r / 256, q = r % 256, kb = q / 32, nb = q % 32;
            transpose_item(c.w_down + (size_t)e * 512 * 1024, 1024, kb * 64, nb * 32, WD_T + (size_t)e * 1024 * 512, 512, RowId{0}, scr, lane); }
    }
}

__device__ __forceinline__ void ph_norm1(const Ctx& c) {
    const int tid = threadIdx.x, lane = tid & 63, wave = tid >> 6, nw = blockDim.x >> 6;
    const int gw = blockIdx.x * nw + wave, NGW = gridDim.x * nw;
    const float* MOD = (const float*)(c.ws + WS_MOD); bf16* H = (bf16*)(c.ws + WS_H);
    f32x4 g[4];
#pragma unroll
    for (int j = 0; j < 4; ++j) g[j] = *(const f32x4*)(c.g_mix + 4 * lane + 256 * j);
    for (int r = gw; r < NROW; r += NGW) {
        const int b = r / KVL, j = r % KVL; const bool isctx = j < CTXL;
        const float* src = isctx ? c.ctx + ((size_t)b * CTXL + j) * DM : c.x + ((size_t)b * SEQ + (j - CTXL)) * DM;
        const float* mod = MOD + (isctx ? 16 : b) * 6144;
        f32x4 v[4]; float ss = 0.f;
#pragma unroll
        for (int q = 0; q < 4; ++q) { v[q] = *(const f32x4*)(src + 4 * lane + 256 * q); ss += (v[q].x * v[q].x + v[q].y * v[q].y) + (v[q].z * v[q].z + v[q].w * v[q].w); }
        const float rstd = rsqrtf(wave_sum(ss) * (1.0f / DM) + NORM_EPS);
#pragma unroll
        for (int q = 0; q < 4; ++q) { const f32x4 sh = *(const f32x4*)(mod + 4 * lane + 256 * q), sc = *(const f32x4*)(mod + 1024 + 4 * lane + 256 * q);
            const f32x4 o = (v[q] * rstd * g[q]) * (sc + 1.0f) + sh;
            u32x2 w; w.x = pk2(o.x, o.y); w.y = pk2(o.z, o.w); *(u32x2*)(H + (size_t)r * DM + 4 * lane + 256 * q) = w; }
    }
}

__device__ __forceinline__ u32x4 pack8(const f32x4& a, const f32x4& b) { u32x4 w; w.x = pk2(a.x, a.y); w.y = pk2(a.z, a.w); w.z = pk2(b.x, b.y); w.w = pk2(b.z, b.w); return w; }
struct EpiInProj {
    unsigned char* ws;
    __device__ __forceinline__ void rope8(int t, int i8, f32x4& a, f32x4& b, float scale) const {
        const f32x2* R = (const f32x2*)(ws + WS_ROPE) + (size_t)t * 32 + (i8 >> 5) * 16 + ((i8 & 31) >> 1);
        const f32x4 c0 = *(const f32x4*)R, c1 = *(const f32x4*)(R + 2);
        f32x4 oa, ob;
        oa.x = (a.x * c0.x - a.y * c0.y) * scale; oa.y = (a.y * c0.x + a.x * c0.y) * scale;
        oa.z = (a.z * c0.z - a.w * c0.w) * scale; oa.w = (a.w * c0.z + a.z * c0.w) * scale;
        ob.x = (b.x * c1.x - b.y * c1.y) * scale; ob.y = (b.y * c1.x + b.x * c1.y) * scale;
        ob.z = (b.z * c1.z - b.w * c1.w) * scale; ob.w = (b.w * c1.z + b.z * c1.w) * scale;
        a = oa; b = ob;
    }
    __device__ __forceinline__ void emit8(int row, int col, f32x4 a, f32x4 b) const {
        const int bb = row / KVL, j = row % KVL; const bool lat = j >= CTXL; const int t = j - CTXL; const size_t tl = (size_t)bb * SEQ + t;
        if (col < C_DAK) { if (!lat) return; rope8(t, col & 63, a, b, QSCALE); *(u32x4*)((bf16*)(ws + WS_QDA) + tl * 512 + col) = pack8(a, b); }
        else if (col < C_DAV) { if (lat) rope8(t, col & 63, a, b, 1.0f); *(u32x4*)((bf16*)(ws + WS_KDA) + (size_t)row * 512 + (col - C_DAK)) = pack8(a, b); }
        else if (col < C_GQ) { *(u32x4*)((bf16*)(ws + WS_VDA) + (size_t)row * 512 + (col - C_DAV)) = pack8(a, b); }
        else if (col < C_GK) { if (!lat) return; *(u32x4*)((bf16*)(ws + WS_GQ) + tl * 256 + (col - C_GQ)) = pack8(a * 0.125f, b * 0.125f); }
        else if (col < C_GV) { *(u32x4*)((bf16*)(ws + WS_GK) + (size_t)row * 256 + (col - C_GK)) = pack8(a, b); }
        else if (col < C_GR) { *(u32x4*)((bf16*)(ws + WS_GV) + (size_t)row * 512 + (col - C_GV)) = pack8(a, b); }
        else if (col < C_LR) { if (!lat) return; *(u32x4*)((bf16*)(ws + WS_GR) + tl * 512 + (col - C_GR)) = pack8(a, b); }
        else if (col < NPROJ) { float* p = (float*)(ws + WS_LR) + (size_t)row * 32 + (col - C_LR); *(f32x4*)p = a; *(f32x4*)(p + 4) = b; }
    }
};
struct EpiOutProj {
    const float* x; const float* MOD; float* X1;
    __device__ __forceinline__ void emit8(int row, int col, f32x4 a, f32x4 b) const {
        const int bb = row / SEQ; const float* g = MOD + bb * 6144 + 2048 + col; const size_t o = (size_t)row * DM + col;
        const f32x4 g0 = *(const f32x4*)g, g1 = *(const f32x4*)(g + 4), x0 = *(const f32x4*)(x + o), x1 = *(const f32x4*)(x + o + 4);
        *(f32x4*)(X1 + o) = x0 + g0 * a; *(f32x4*)(X1 + o + 4) = x1 + g1 * b;
    }
};
struct EpiGateUp {
    bf16* HMID;
    __device__ __forceinline__ void emit8(int row, int col, f32x4 a, f32x4 b) const {
        f32x4 h; h.x = silu_f(a.x) * b.x; h.y = silu_f(a.y) * b.y; h.z = silu_f(a.z) * b.z; h.w = silu_f(a.w) * b.w;
        u32x2 w; w.x = pk2(h.x, h.y); w.y = pk2(h.z, h.w); *(u32x2*)(HMID + (size_t)row * EHID + (col >> 1)) = w;
    }
};
struct EpiDown {
    bf16* YB;
    __device__ __forceinline__ void emit8(int row, int col, f32x4 a, f32x4 b) const { *(u32x4*)(YB + (size_t)row * DM + col) = pack8(a, b); }
};

__device__ __forceinline__ void moe_build(LAS int* mm, const unsigned* ctl) {
    if (threadIdx.x < 64) { const int l = threadIdx.x, e = l & 31;
        const int cnt = (int)__hip_atomic_load((unsigned*)ctl + CW_CNT + 64 * e, __ATOMIC_RELAXED, __HIP_MEMORY_SCOPE_AGENT);
        const int tiles = (cnt + 255) >> 8; int incl = tiles;
#pragma unroll
        for (int o = 1; o < 32; o <<= 1) { const int v = __shfl_up(incl, o); if (e >= o) incl += v; }
        if (l < 32) { mm[e] = cnt; mm[32 + e] = incl - tiles; if (e == 31) mm[64] = incl; } }
    __syncthreads();
}
__device__ __forceinline__ int moe_tile_expert(const LAS int* mm, int tile) { int e = 0;
#pragma unroll 1
    for (int i = 1; i < NEXP; ++i) if (mm[32 + i] <= tile) e = i;
    return e; }

namespace pg8 {
typedef short bf16x8 __attribute__((ext_vector_type(8)));
constexpr int BM = 256, BK = 64, HALF = 128, HTB = HALF * BK * 2  , STAGE_BYTES = 8 * HTB;
__host__ __device__ __forceinline__ int lds_byte(int r, int c) { const int st = (r >> 4) * 2 + (c >> 5), rr = r & 15, cc = c & 31, ob = rr * 64 + cc * 2; return st * 1024 + (ob ^ (((ob >> 9) & 1) << 5)); }
__host__ __device__ __forceinline__ void stage_rc(int b, int& R, int& C) { const int st = b / 1024, sb = b % 1024, swz = sb ^ (((sb >> 9) & 1) << 5); R = (st >> 1) * 16 + swz / 64; C = (st & 1) * 32 + (swz % 64) / 2; }
__host__ __device__ __forceinline__ int perm32(int rho) { const int n = rho >> 4, i = rho & 15; return 8 * (i >> 2) + 4 * n + (i & 3); }

struct Unit { const char* A; const char* B; int row0, col0, ge, gp; };
struct Gemm { int K; const int* LIST; const LAS int* mm; };

template <class E8> struct Epi8 {
    E8 e;
    __device__ __forceinline__ void operator()(const f32x4 (&acc)[2][2][4][2], const Unit& u, int wr, int wc, int fr, int fq) const {
#pragma unroll
        for (int ai = 0; ai < 2; ++ai)
#pragma unroll
            for (int m = 0; m < 4; ++m)
#pragma unroll
                for (int bj = 0; bj < 2; ++bj) e.emit8(u.row0 + ai * HALF + wr * 64 + m * 16 + fr, u.col0 + bj * HALF + wc * 32 + 8 * fq, acc[ai][bj][m][0], acc[ai][bj][m][1]);
    }
};

template <class Epi, class Sched, bool GATHER, bool ALIGN_EPI = true, bool SP2 = true>
__device__ __forceinline__ void gemm_phase(LAS unsigned char* lds, const Gemm g, const Sched& S, const Epi& E) {
    const int tid = threadIdx.x, wid = __builtin_amdgcn_readfirstlane(tid >> 6), lane = tid & 63, wr = wid >> 2, wc = wid & 3, fr = lane & 15, fq = lane >> 4;
    const int K = g.K, nt = K / BK;
    int Rr[2], Cc[2]; unsigned voffB[2];
#pragma unroll
    for (int i = 0; i < 2; ++i) { stage_rc(tid * 16 + i * 8192, Rr[i], Cc[i]); const int Rb = (Rr[i] & ~31) + perm32(Rr[i] & 31); voffB[i] = (unsigned)(Rb * K + Cc[i]) * 2u; }
    const size_t kstep = (size_t)(BK * 2);
    const size_t hstep = (size_t)HALF * K * 2;
    const unsigned ldsw = (unsigned)wid * 1024u;
    const int aoff = lds_byte(wr * 64 + fr, fq * 8), boff = lds_byte(wc * 32 + fr, fq * 8);
#define PG8_MKOFF(u, vo) do { _Pragma("unroll") for (int _h = 0; _h < 2; ++_h) _Pragma("unroll") for (int _i = 0; _i < 2; ++_i) { \
        if (GATHER) { const int _pos = (u).gp + _h * HALF + Rr[_i]; const int _tok = g.LIST[(u).ge * NTOK + (_pos < g.mm[(u).ge] ? _pos : 0)]; (vo)[_h][_i] = (unsigned)(_tok * K + Cc[_i]) * 2u; } \
        else (vo)[_h][_i] = (unsigned)((_h * HALF + Rr[_i]) * K + Cc[_i]) * 2u; } } while (0)
#define PG8_SA(b, h) (((b) * 2 + (h)) * HTB)
#define PG8_SB(b, h) ((4 + (b) * 2 + (h)) * HTB)
#define PG8_STAGE(bufoff, gbase, voff) do { _Pragma("unroll") for (int _i = 0; _i < 2; ++_i) \
        __builtin_amdgcn_global_load_lds((const unsigned*)((const char*)(gbase) + (voff)[_i]), (LAS unsigned*)(lds + (bufoff) + ldsw + _i * 8192), 16, 0, 0); } while (0)
#define PG8_LDA(dst, b, h) do { _Pragma("unroll") for (int m = 0; m < 4; ++m) _Pragma("unroll") for (int k = 0; k < 2; ++k) dst[m][k] = *(const LAS bf16x8*)(lds + PG8_SA(b, h) + aoff + m * 2048 + k * 1024); } while (0)
#define PG8_LDB(dst, b, h) do { _Pragma("unroll") for (int n = 0; n < 2; ++n) _Pragma("unroll") for (int k = 0; k < 2; ++k) dst[n][k] = *(const LAS bf16x8*)(lds + PG8_SB(b, h) + boff + n * 2048 + k * 1024); } while (0)
#define PG8_MMA(ai, bj, At, Bt) do { __builtin_amdgcn_s_setprio(1); _Pragma("unroll") for (int m = 0; m < 4; ++m) _Pragma("unroll") for (int n = 0; n < 2; ++n) _Pragma("unroll") for (int k = 0; k < 2; ++k) \
        acc[ai][bj][m][n] = __builtin_amdgcn_mfma_f32_16x16x32_bf16(Bt[n][k], At[m][k], acc[ai][bj][m][n], 0, 0, 0); __builtin_amdgcn_s_setprio(0); } while (0)
#define PG8_WAIT_V(n) asm volatile("s_waitcnt vmcnt(" #n ")" ::: "memory")
#define PG8_WAIT_L(n) asm volatile("s_waitcnt lgkmcnt(" #n ")" ::: "memory")
#define PG8_BAR __builtin_amdgcn_s_barrier()
#define PG8_SCHED __builtin_amdgcn_sched_barrier(0)
    Unit cur, nxt; int ui = 0;
    if (!S.next(0, cur)) return;
    f32x4 acc[2][2][4][2];
#pragma unroll
    for (int a = 0; a < 2; ++a)
#pragma unroll
        for (int b = 0; b < 2; ++b)
#pragma unroll
            for (int m = 0; m < 4; ++m)
#pragma unroll
                for (int n = 0; n < 2; ++n) acc[a][b][m][n] = (f32x4){0.f, 0.f, 0.f, 0.f};
    bf16x8 At[4][2], B0[2][2], B1[2][2];
    unsigned voffA[2][2], nvoffA[2][2];
    PG8_MKOFF(cur, voffA);
    const char* cA = cur.A; const char* cB = cur.B;
    if constexpr (SP2) {
        PG8_STAGE(PG8_SB(0, 0), cB, voffB); PG8_STAGE(PG8_SB(0, 1), cB + hstep, voffB); PG8_STAGE(PG8_SA(0, 0), cA, voffA[0]); PG8_STAGE(PG8_SA(0, 1), cA, voffA[1]);
        if (wr == 1) PG8_BAR;
        PG8_WAIT_V(2); PG8_BAR;
        PG8_STAGE(PG8_SB(1, 0), cB + kstep, voffB); PG8_STAGE(PG8_SA(1, 0), cA + kstep, voffA[0]); PG8_STAGE(PG8_SB(1, 1), cB + hstep + kstep, voffB);
        PG8_WAIT_V(6); PG8_BAR;
    } else {
        PG8_STAGE(PG8_SB(0, 0), cB, voffB); PG8_STAGE(PG8_SA(0, 0), cA, voffA[0]); PG8_STAGE(PG8_SB(0, 1), cB + hstep, voffB); PG8_STAGE(PG8_SA(0, 1), cA, voffA[1]);
        if (wr == 1) PG8_BAR;
        PG8_WAIT_V(4); PG8_BAR;
        PG8_STAGE(PG8_SB(1, 0), cB + kstep, voffB); PG8_STAGE(PG8_SA(1, 0), cA + kstep, voffA[0]); PG8_STAGE(PG8_SB(1, 1), cB + hstep + kstep, voffB);
        PG8_WAIT_V(6); PG8_BAR;
    }
    for (;;) {
        const bool has_next = S.next(ui + 1, nxt);
        if (has_next) { PG8_MKOFF(nxt, nvoffA); }
        else {
#pragma unroll
            for (int h = 0; h < 2; ++h)
#pragma unroll
                for (int i = 0; i < 2; ++i) nvoffA[h][i] = voffA[h][i]; }
        const char* nA = has_next ? nxt.A : cA; const char* nB = has_next ? nxt.B : cB;
        for (int t = 0; t < nt; t += 2) {
            const bool last = (t == nt - 2);
            const char* a1 = cA + (size_t)(t + 1) * kstep;
            const char* a2 = last ? nA : cA + (size_t)(t + 2) * kstep; const char* b2 = last ? nB : cB + (size_t)(t + 2) * kstep;
            const char* a3 = a2 + kstep; const char* b3 = b2 + kstep;
            unsigned v2[2][2];
#pragma unroll
            for (int h = 0; h < 2; ++h)
#pragma unroll
                for (int i = 0; i < 2; ++i) v2[h][i] = last ? nvoffA[h][i] : voffA[h][i];
            if constexpr (SP2) {
            PG8_LDB(B0, 0, 0); PG8_LDB(B1, 0, 1); PG8_SCHED; PG8_LDA(At, 0, 0); PG8_STAGE(PG8_SA(1, 1), a1, voffA[1]);
            PG8_WAIT_V(8); PG8_WAIT_L(0); PG8_BAR; PG8_MMA(0, 0, At, B0); PG8_MMA(0, 1, At, B1); PG8_BAR; PG8_SCHED;
            PG8_LDA(At, 0, 1); PG8_STAGE(PG8_SB(0, 0), b2, voffB); PG8_STAGE(PG8_SB(0, 1), b2 + hstep, voffB); PG8_STAGE(PG8_SA(0, 0), a2, v2[0]);
            PG8_WAIT_V(8); PG8_WAIT_L(0); PG8_BAR; PG8_MMA(1, 0, At, B0); PG8_MMA(1, 1, At, B1); PG8_BAR; PG8_SCHED;
            PG8_LDB(B0, 1, 0); PG8_LDB(B1, 1, 1); PG8_SCHED; PG8_LDA(At, 1, 0); PG8_STAGE(PG8_SA(0, 1), a2, v2[1]);
            PG8_WAIT_V(8); PG8_WAIT_L(0); PG8_BAR; PG8_MMA(0, 0, At, B0); PG8_MMA(0, 1, At, B1); PG8_BAR; PG8_SCHED;
            PG8_LDA(At, 1, 1); PG8_STAGE(PG8_SB(1, 0), b3, voffB); PG8_STAGE(PG8_SB(1, 1), b3 + hstep, voffB); PG8_STAGE(PG8_SA(1, 0), a3, v2[0]);
            PG8_WAIT_V(8); PG8_WAIT_L(0); PG8_BAR; PG8_MMA(1, 0, At, B0); PG8_MMA(1, 1, At, B1); PG8_BAR; PG8_SCHED;
            } else {
            PG8_LDB(B0, 0, 0); PG8_SCHED; PG8_LDA(At, 0, 0); PG8_STAGE(PG8_SA(1, 1), a1, voffA[1]);
            PG8_WAIT_L(8); PG8_BAR; PG8_WAIT_L(0); PG8_MMA(0, 0, At, B0); PG8_BAR; PG8_SCHED;
            PG8_LDB(B1, 0, 1); PG8_STAGE(PG8_SB(0, 0), b2, voffB);
            PG8_BAR; PG8_WAIT_L(0); PG8_MMA(0, 1, At, B1); PG8_BAR;
            PG8_LDA(At, 0, 1); PG8_STAGE(PG8_SA(0, 0), a2, v2[0]);
            PG8_BAR; PG8_WAIT_L(0); PG8_MMA(1, 0, At, B0); PG8_BAR; PG8_SCHED;
            PG8_STAGE(PG8_SB(0, 1), b2 + hstep, voffB);
            PG8_WAIT_V(6); PG8_BAR; PG8_MMA(1, 1, At, B1); PG8_BAR;
            PG8_LDB(B0, 1, 0); PG8_SCHED; PG8_LDA(At, 1, 0); PG8_STAGE(PG8_SA(0, 1), a2, v2[1]);
            PG8_WAIT_L(8); PG8_BAR; PG8_WAIT_L(0); PG8_MMA(0, 0, At, B0); PG8_BAR; PG8_SCHED;
            PG8_LDB(B1, 1, 1); PG8_STAGE(PG8_SB(1, 0), b3, voffB);
            PG8_BAR; PG8_WAIT_L(0); PG8_MMA(0, 1, At, B1); PG8_BAR;
            PG8_LDA(At, 1, 1); PG8_STAGE(PG8_SA(1, 0), a3, v2[0]);
            PG8_BAR; PG8_WAIT_L(0); PG8_MMA(1, 0, At, B0); PG8_BAR; PG8_SCHED;
            PG8_STAGE(PG8_SB(1, 1), b3 + hstep, voffB);
            PG8_WAIT_V(6); PG8_BAR; PG8_MMA(1, 1, At, B1); PG8_BAR;
            }
        }
        if constexpr (ALIGN_EPI) { if (wr == 0) PG8_BAR; }
        E(acc, cur, wr, wc, fr, fq);
        if (!has_next) break;
#pragma unroll
        for (int a = 0; a < 2; ++a)
#pragma unroll
            for (int b = 0; b < 2; ++b)
#pragma unroll
                for (int m = 0; m < 4; ++m)
#pragma unroll
                    for (int n = 0; n < 2; ++n) acc[a][b][m][n] = (f32x4){0.f, 0.f, 0.f, 0.f};
        cur = nxt; cA = nA; cB = nB; ++ui;
#pragma unroll
        for (int h = 0; h < 2; ++h)
#pragma unroll
            for (int i = 0; i < 2; ++i) voffA[h][i] = nvoffA[h][i];
        if constexpr (ALIGN_EPI) { if (wr == 1) PG8_BAR; }
    }
    PG8_WAIT_V(0);
    if constexpr (!ALIGN_EPI) { if (wr == 0) PG8_BAR; }
    PG8_BAR;
#undef PG8_MKOFF
#undef PG8_SA
#undef PG8_SB
#undef PG8_STAGE
#undef PG8_LDA
#undef PG8_LDB
#undef PG8_MMA
#undef PG8_WAIT_V
#undef PG8_WAIT_L
#undef PG8_BAR
#undef PG8_SCHED
}
__device__ __forceinline__ int xcd_remap(int L, int nwg) { const int q = nwg / 8, r = nwg % 8, xcd = L % 8, off = L / 8; return (xcd < r ? xcd * (q + 1) : r * (q + 1) + (xcd - r) * q) + off; }
}

constexpr int LDS_MM_OFF = 131072;

struct OrderInProj { int G, c; const char* H; const char* W;
    __device__ __forceinline__ bool next(int i, pg8::Unit& u) const {
        const int L = i * G + c; if (L >= 1792) return false;
        int pmg, pn;
        if (L < 1664) { const int wgid = pg8::xcd_remap(L, 1664); const int nig = 8 * 13, gid = wgid / nig, p = gid * 8 + ((wgid % nig) & 7); pn = (wgid % nig) >> 3; pmg = (p >> 3) * 9 + 1 + (p & 7); }
        else { const int idx = L - 1664, p = idx & 15, ci = idx >> 4; pmg = p * 9; pn = ci < 4 ? 2 + ci : (ci < 7 ? 3 + ci : 12); }
        u.A = H + (size_t)pmg * 256 * 2048; u.B = W + (size_t)pn * 256 * 2048; u.row0 = pmg * 256; u.col0 = pn * 256; u.ge = -1; u.gp = 0; return true; } };
struct OrderOutProj { int G, c; const char* A; const char* W;
    __device__ __forceinline__ bool next(int i, pg8::Unit& u) const {
        const int L = i * G + c; if (L >= 512) return false;
        const int wgid = pg8::xcd_remap(L, 512); const int nig = 8 * 4, gid = wgid / nig, pm = gid * 8 + ((wgid % nig) & 7), pn = (wgid % nig) >> 3;
        u.A = A + (size_t)pm * 256 * 2048; u.B = W + (size_t)pn * 256 * 2048; u.row0 = pm * 256; u.col0 = pn * 256; u.ge = -1; u.gp = 0; return true; } };
struct OrderGateUp { int G, c; const char* H2; const char* W; const LAS int* mm;
    __device__ __forceinline__ bool next(int i, pg8::Unit& u) const {
        const int nwg = mm[64] * 4, L = i * G + c; if (L >= nwg) return false;
        const int wgid = pg8::xcd_remap(L, nwg), tt = wgid >> 2, pn = wgid & 3, e = moe_tile_expert(mm, tt);
        u.A = H2; u.B = W + ((size_t)e * 1024 + pn * 256) * 2048; u.row0 = tt * 256; u.col0 = pn * 256; u.ge = e; u.gp = (tt - mm[32 + e]) * 256; return true; } };
struct OrderDown { int G, c; const char* HM; const char* W; const LAS int* mm;
    __device__ __forceinline__ bool next(int i, pg8::Unit& u) const {
        const int nwg = mm[64] * 4, L = i * G + c; if (L >= nwg) return false;
        const int wgid = pg8::xcd_remap(L, nwg), tt = wgid >> 2, pn = wgid & 3, e = moe_tile_expert(mm, tt);
        u.A = HM + (size_t)tt * 256 * 1024; u.B = W + ((size_t)e * 1024 + pn * 256) * 1024; u.row0 = tt * 256; u.col0 = pn * 256; u.ge = -1; u.gp = 0; return true; } };

__device__ __forceinline__ void ph_inproj(const Ctx& c, LAS unsigned char* lds) {
    pg8::Gemm g{1024, nullptr, nullptr}; OrderInProj S{(int)gridDim.x, (int)blockIdx.x, (const char*)(c.ws + WS_H), (const char*)(c.ws + WS_WIN_T)};
    pg8::Epi8<EpiInProj> E{EpiInProj{c.ws}};
    pg8::gemm_phase<pg8::Epi8<EpiInProj>, OrderInProj, false>(lds, g, S, E);
}
__device__ __forceinline__ void ph_outproj(const Ctx& c, LAS unsigned char* lds) {
    pg8::Gemm g{1024, nullptr, nullptr}; OrderOutProj S{(int)gridDim.x, (int)blockIdx.x, (const char*)(c.ws + WS_MIX), (const char*)(c.ws + WS_WOUT_T)};
    pg8::Epi8<EpiOutProj> E{EpiOutProj{c.x, (const float*)(c.ws + WS_MOD), (float*)(c.ws + WS_X1)}};
    pg8::gemm_phase<pg8::Epi8<EpiOutProj>, OrderOutProj, false>(lds, g, S, E);
}
__device__ __forceinline__ void ph_gateup(const Ctx& c, LAS unsigned char* lds) {
    LAS int* mm = (LAS int*)(lds + LDS_MM_OFF); moe_build(mm, (const unsigned*)(c.ws + WS_CTL));
    pg8::Gemm g{1024, (const int*)(c.ws + WS_LIST), mm}; OrderGateUp S{(int)gridDim.x, (int)blockIdx.x, (const char*)(c.ws + WS_H2), (const char*)(c.ws + WS_WGU_T), mm};
    pg8::Epi8<EpiGateUp> E{EpiGateUp{(bf16*)(c.ws + WS_HMID)}};
    pg8::gemm_phase<pg8::Epi8<EpiGateUp>, OrderGateUp, true>(lds, g, S, E);
}
__device__ __forceinline__ void ph_down(const Ctx& c, LAS unsigned char* lds) {
    LAS int* mm = (LAS int*)(lds + LDS_MM_OFF); moe_build(mm, (const unsigned*)(c.ws + WS_CTL));
    pg8::Gemm g{512, nullptr, mm}; OrderDown S{(int)gridDim.x, (int)blockIdx.x, (const char*)(c.ws + WS_HMID), (const char*)(c.ws + WS_WD_T), mm};
    pg8::Epi8<EpiDown> E{EpiDown{(bf16*)(c.ws + WS_YB)}};
    pg8::gemm_phase<pg8::Epi8<EpiDown>, OrderDown, false>(lds, g, S, E);
}

__device__ __forceinline__ float da_lambda_full(const float* lp) {
    float s0 = 0.f, s1 = 0.f;
    for (int i = 0; i < 64; ++i) { s0 += lp[i] * lp[64 + i]; s1 += lp[128 + i] * lp[192 + i]; }
    return expf(s0) - expf(s1) + LAMBDA_INIT;
}
namespace da {
typedef short bf16x8 __attribute__((ext_vector_type(8)));
typedef short s16x4 __attribute__((ext_vector_type(4)));
typedef float f32x16 __attribute__((ext_vector_type(16)));
typedef float f32x2_t __attribute__((ext_vector_type(2))); typedef __bf16 bf16x2_t __attribute__((ext_vector_type(2)));
__device__ __forceinline__ unsigned cvtpk(float lo, float hi) { f32x2_t v = {lo, hi}; bf16x2_t b = __builtin_convertvector(v, bf16x2_t); return __builtin_bit_cast(unsigned, b); }
__device__ __forceinline__ bf16x8 pack_half(const f32x16& x, int s) {
    u32x4 p; p.x = cvtpk(x[8 * s], x[8 * s + 1]); p.y = cvtpk(x[8 * s + 2], x[8 * s + 3]); p.z = cvtpk(x[8 * s + 4], x[8 * s + 5]); p.w = cvtpk(x[8 * s + 6], x[8 * s + 7]);
    return __builtin_bit_cast(bf16x8, p); }
__device__ __forceinline__ s16x4 vtr(const LAS unsigned char* p) { return __builtin_bit_cast(s16x4, __builtin_amdgcn_ds_read_tr16_b64_v4i16((LAS s16x4*)p)); }
#define DA_MFMA(a, b, c) __builtin_amdgcn_mfma_f32_32x32x16_bf16((a), (b), (c), 0, 0, 0)
constexpr int NT = KVL / 64;
constexpr int QS_OFF = 65536;

template <int BO> __device__ __forceinline__ void tile(const LAS unsigned char* lds, const LAS unsigned char* kq, const LAS unsigned char* qs, int vlane, f32x16 (&O)[4], float& mrun, float& lrun) {
    f32x16 s0, s1;
#pragma unroll
    for (int r = 0; r < 16; ++r) { s0[r] = 0.f; s1[r] = 0.f; }
#pragma unroll
    for (int ks = 0; ks < 4; ++ks) {
        const bf16x8 k0 = *(const LAS bf16x8*)(kq + BO + ks * 2048), k1 = *(const LAS bf16x8*)(kq + BO + ks * 2048 + 512), qq = *(const LAS bf16x8*)(qs + ks * 1024);
        s0 = DA_MFMA(k0, qq, s0); s1 = DA_MFMA(k1, qq, s1); }
    float mx = fmaxf(s0[0], s1[0]);
#pragma unroll
    for (int r = 1; r < 16; ++r) mx = fmaxf(mx, fmaxf(s0[r], s1[r]));
    mx = fmaxf(mx, __shfl_xor(mx, 32));
    const float mnew = fmaxf(mrun, mx), alpha = __builtin_amdgcn_exp2f(mrun - mnew);
    mrun = mnew;
#pragma unroll
    for (int dt = 0; dt < 4; ++dt)
#pragma unroll
        for (int r = 0; r < 16; ++r) O[dt][r] *= alpha;
    float ps = 0.f;
#pragma unroll
    for (int r = 0; r < 16; ++r) { s0[r] = __builtin_amdgcn_exp2f(s0[r] - mnew); s1[r] = __builtin_amdgcn_exp2f(s1[r] - mnew); ps += s0[r] + s1[r]; }
    lrun = lrun * alpha + ps;
    bf16x8 P[4];
    P[0] = pack_half(s0, 0); P[1] = pack_half(s0, 1); P[2] = pack_half(s1, 0); P[3] = pack_half(s1, 1);
    const LAS unsigned char* vb = lds + BO + 16384 + vlane;
#pragma unroll
    for (int dt = 0; dt < 4; ++dt)
#pragma unroll
        for (int ks = 0; ks < 4; ++ks) {
            const s16x4 lo = vtr(vb + (dt * 4 + ks) * 1024), hh = vtr(vb + (dt * 4 + ks) * 1024 + 512);
            const bf16x8 vf = __builtin_shufflevector(lo, hh, 0, 1, 2, 3, 4, 5, 6, 7);
            O[dt] = DA_MFMA(vf, P[ks], O[dt]); }
}

__device__ __forceinline__ void attn_phase(const Ctx& c, LAS unsigned char* lds) {
    const int tid = threadIdx.x, lane = tid & 63, wid = __builtin_amdgcn_readfirstlane(tid >> 6), r32 = lane & 31, hi = lane >> 5;
    const int m = wid >> 2, qsub = wid & 3;
    const bf16* Q = (const bf16*)(c.ws + WS_QDA); const bf16* K = (const bf16*)(c.ws + WS_KDA); const bf16* V = (const bf16*)(c.ws + WS_VDA); bf16* MIX = (bf16*)(c.ws + WS_MIX);
    const float lam = da_lambda_full(c.da_lambda);
    const int vlane = (4 * hi + ((lane & 15) >> 2)) * 64 + ((lane >> 4) & 1) * 32 + (lane & 3) * 8;
    LAS unsigned char* qs = lds + QS_OFF + wid * 4096 + hi * 512 + r32 * 16;
    const LAS unsigned char* kq = lds + (m * 8 + hi) * 1024 + r32 * 16;
    const unsigned kgo0 = (unsigned)(lane * 512 + (wid * 2) * 8) * 2u, kgo1 = kgo0 + 16u;
    const unsigned vgo0 = (unsigned)((((wid * 2) & 3) * 16 + (lane >> 2)) * 512 + ((wid * 2) >> 2) * 32 + (lane & 3) * 8) * 2u, vgo1 = vgo0 + 16u * 512u * 2u;
    for (int it = 0;; ++it) {
        const int L = it * (int)gridDim.x + (int)blockIdx.x; if (L >= 1024) break;
        const int wg = pg8::xcd_remap(L, 1024), bh = wg >> 4, qb = wg & 15, b = bh >> 2, h = bh & 3;
        const char* Kb = (const char*)(K + (size_t)b * KVL * 512 + h * 128); const char* Vb = (const char*)(V + (size_t)b * KVL * 512 + h * 128);
        const size_t qrow = (size_t)b * SEQ + qb * 128 + qsub * 32 + r32;
#define DA_DMA(t, bo) do { const size_t _to = (size_t)(t) * (64 * 512 * 2); \
            __builtin_amdgcn_global_load_lds((const unsigned*)(Kb + _to + kgo0), (LAS unsigned*)(lds + (bo) + (wid * 2) * 1024), 16, 0, 0); \
            __builtin_amdgcn_global_load_lds((const unsigned*)(Kb + _to + kgo1), (LAS unsigned*)(lds + (bo) + (wid * 2 + 1) * 1024), 16, 0, 0); \
            __builtin_amdgcn_global_load_lds((const unsigned*)(Vb + _to + vgo0), (LAS unsigned*)(lds + (bo) + 16384 + (wid * 2) * 1024), 16, 0, 0); \
            __builtin_amdgcn_global_load_lds((const unsigned*)(Vb + _to + vgo1), (LAS unsigned*)(lds + (bo) + 16384 + (wid * 2 + 1) * 1024), 16, 0, 0); } while (0)
        DA_DMA(0, 0);
#pragma unroll
        for (int ks = 0; ks < 4; ++ks) *(LAS bf16x8*)(qs + ks * 1024) = *(const bf16x8*)(Q + qrow * 512 + h * 128 + m * 64 + ks * 16 + hi * 8);
        f32x16 O[4];
#pragma unroll
        for (int dt = 0; dt < 4; ++dt)
#pragma unroll
            for (int r = 0; r < 16; ++r) O[dt][r] = 0.f;
        float mrun = -1e30f, lrun = 0.f;
        asm volatile("s_waitcnt vmcnt(0)" ::: "memory"); __syncthreads();
        for (int t = 0; t < NT; t += 2) {
            DA_DMA(t + 1, 32768);
            tile<0>(lds, kq, qs, vlane, O, mrun, lrun);
            asm volatile("s_waitcnt vmcnt(0)" ::: "memory"); __syncthreads();
            if (t + 2 < NT) DA_DMA(t + 2, 0);
            tile<32768>(lds, kq, qs, vlane, O, mrun, lrun);
            asm volatile("s_waitcnt vmcnt(0)" ::: "memory"); __syncthreads();
        }
        const float lt = lrun + __shfl_xor(lrun, 32);
        LAS float* xch = (LAS float*)(lds + qsub * 16384) + lane;
        if (m == 1) { const float sc = lam / lt;
#pragma unroll
            for (int dt = 0; dt < 4; ++dt)
#pragma unroll
                for (int r = 0; r < 16; ++r) xch[(dt * 16 + r) * 64] = O[dt][r] * sc; }
        __syncthreads();
        if (m == 0) { const float i1 = 1.0f / lt; float ss = 0.f;
#pragma unroll
            for (int dt = 0; dt < 4; ++dt)
#pragma unroll
                for (int r = 0; r < 16; ++r) { const float a = O[dt][r] * i1 - xch[(dt * 16 + r) * 64]; O[dt][r] = a; ss += a * a; }
            ss += __shfl_xor(ss, 32);
            const float rstd = rsqrtf(ss * (1.0f / 128.0f) + NORM_EPS) * (1.0f - LAMBDA_INIT);
            bf16* orow = MIX + qrow * 1024 + h * 128;
#pragma unroll
            for (int dt = 0; dt < 4; ++dt)
#pragma unroll
                for (int g4 = 0; g4 < 4; ++g4) { const int d0 = 32 * dt + 8 * g4 + 4 * hi; const f32x4 gg = *(const f32x4*)(c.da_subln_g + d0);
                    u32x2 w; w.x = cvtpk(O[dt][4 * g4] * rstd * gg.x, O[dt][4 * g4 + 1] * rstd * gg.y); w.y = cvtpk(O[dt][4 * g4 + 2] * rstd * gg.z, O[dt][4 * g4 + 3] * rstd * gg.w);
                    *(u32x2*)(orow + d0) = w; } }
        __syncthreads();
#undef DA_DMA
    }
}
#undef DA_MFMA
}

namespace gla {
using da::bf16x8; using da::s16x4; using da::f32x16; using da::cvtpk; using da::pack_half; using da::vtr;
#define GL_MFMA(a, b, c) __builtin_amdgcn_mfma_f32_32x32x16_bf16((a), (b), (c), 0, 0, 0)
constexpr int RT_BYTES = 64 * 144;
constexpr int PT64_BYTES = 8192;
constexpr int PTV_BYTES = 16384;
__device__ __forceinline__ int pt_off(int tok, int col) { return ((col >> 5) * 4 + (tok >> 4)) * 1024 + (tok & 15) * 64 + (col & 31) * 2; }

template <bool QK, bool KEND>
__device__ __forceinline__ void prep(const Ctx& c, int b, int h, int dir, int cc, LAS unsigned char* qd_rt, LAS unsigned char* ki_rt, LAS unsigned char* kend_pt, float* dout, int lane, int w) {
    const size_t row = (size_t)b * KVL + cc * 64 + lane;
    const float* lr = (const float*)(c.ws + WS_LR) + row * 32 + dir * 16;
    const f32x4 l0 = *(const f32x4*)lr, l1 = *(const f32x4*)(lr + 4), l2 = *(const f32x4*)(lr + 8), l3 = *(const f32x4*)(lr + 12);
    const float lv[16] = {l0.x, l0.y, l0.z, l0.w, l1.x, l1.y, l1.z, l1.w, l2.x, l2.y, l2.z, l2.w, l3.x, l3.y, l3.z, l3.w};
    const float* w2 = c.gate_w2 + dir * 16 * 256 + h * 64 + w * 8; const float* gb = c.gate_b + dir * 256 + h * 64 + w * 8;
    float g[8], incl[8];
#pragma unroll
    for (int i = 0; i < 8; ++i) g[i] = gb[i];
#pragma unroll
    for (int r = 0; r < 16; ++r)
#pragma unroll
        for (int i = 0; i < 8; ++i) g[i] += lv[r] * w2[r * 256 + i];
#pragma unroll
    for (int i = 0; i < 8; ++i) { const float z = g[i]; g[i] = (fminf(z, 0.f) - __logf(1.0f + __expf(-fabsf(z)))) * (1.0f / 16.0f); incl[i] = g[i]; }
#pragma unroll
    for (int o = 1; o < 64; o <<= 1)
#pragma unroll
        for (int i = 0; i < 8; ++i) { const float v = __shfl_up(incl[i], o); if (lane >= o) incl[i] += v; }
    float eq[8], ek[8], ee[8], tot[8];
#pragma unroll
    for (int i = 0; i < 8; ++i) { tot[i] = __shfl(incl[i], 63);
        if (dir == 0) { eq[i] = __expf(incl[i]); ek[i] = __expf(-incl[i]); ee[i] = __expf(tot[i] - incl[i]); }
        else { const float bb = tot[i] - incl[i] + g[i]; eq[i] = __expf(bb); ek[i] = __expf(-bb); ee[i] = __expf(incl[i] - g[i]); } }
    const u32x4 kw = *(const u32x4*)((const bf16*)(c.ws + WS_GK) + row * 256 + h * 64 + w * 8);
    const float kf[8] = {bflo(kw.x), bfhi(kw.x), bflo(kw.y), bfhi(kw.y), bflo(kw.z), bfhi(kw.z), bflo(kw.w), bfhi(kw.w)};
    if (QK) {
        const u32x4 qw = *(const u32x4*)((const bf16*)(c.ws + WS_GQ) + ((size_t)b * SEQ + (cc - 4) * 64 + lane) * 256 + h * 64 + w * 8);
        const float qf[8] = {bflo(qw.x), bfhi(qw.x), bflo(qw.y), bfhi(qw.y), bflo(qw.z), bfhi(qw.z), bflo(qw.w), bfhi(qw.w)};
        u32x4 a, k2;
        a.x = cvtpk(qf[0] * eq[0], qf[1] * eq[1]); a.y = cvtpk(qf[2] * eq[2], qf[3] * eq[3]); a.z = cvtpk(qf[4] * eq[4], qf[5] * eq[5]); a.w = cvtpk(qf[6] * eq[6], qf[7] * eq[7]);
        k2.x = cvtpk(kf[0] * ek[0], kf[1] * ek[1]); k2.y = cvtpk(kf[2] * ek[2], kf[3] * ek[3]); k2.z = cvtpk(kf[4] * ek[4], kf[5] * ek[5]); k2.w = cvtpk(kf[6] * ek[6], kf[7] * ek[7]);
        *(LAS u32x4*)(qd_rt + lane * 144 + w * 16) = a; *(LAS u32x4*)(ki_rt + lane * 144 + w * 16) = k2;
    }
    if (KEND) {
        u32x4 e2;
        e2.x = cvtpk(kf[0] * ee[0], kf[1] * ee[1]); e2.y = cvtpk(kf[2] * ee[2], kf[3] * ee[3]); e2.z = cvtpk(kf[4] * ee[4], kf[5] * ee[5]); e2.w = cvtpk(kf[6] * ee[6], kf[7] * ee[7]);
        *(LAS u32x4*)(kend_pt + pt_off(lane, w * 8)) = e2;
        if (lane == 0) { f32x4 d0, d1; d0.x = __expf(tot[0]); d0.y = __expf(tot[1]); d0.z = __expf(tot[2]); d0.w = __expf(tot[3]); d1.x = __expf(tot[4]); d1.y = __expf(tot[5]); d1.z = __expf(tot[6]); d1.w = __expf(tot[7]);
            *(f32x4*)(dout + w * 8) = d0; *(f32x4*)(dout + w * 8 + 4) = d1; }
    }
}
__device__ __forceinline__ void dma_v(const Ctx& c, size_t row0, int h, LAS unsigned char* vpt, int lane, int w) {
    const bf16* V = (const bf16*)(c.ws + WS_GV);
#pragma unroll
    for (int j = 0; j < 2; ++j) { const int p = w * 2 + j;
        __builtin_amdgcn_global_load_lds((const unsigned*)(V + (row0 + (p & 3) * 16 + (lane >> 2)) * 512 + h * 128 + (p >> 2) * 32 + (lane & 3) * 8), (LAS unsigned*)(vpt + p * 1024), 16, 0, 0); }
}

__device__ __forceinline__ void g1_phase(const Ctx& c, LAS unsigned char* lds) {
    const int tid = threadIdx.x, lane = tid & 63, w = __builtin_amdgcn_readfirstlane(tid >> 6), hi = lane >> 5;
    const int vlane = (4 * hi + ((lane & 15) >> 2)) * 64 + ((lane >> 4) & 1) * 32 + (lane & 3) * 8;
    LAS unsigned char* kend = lds; LAS unsigned char* vpt = lds + PT64_BYTES;
    bf16* UT = (bf16*)(c.ws + WS_UT); float* DB = (float*)(c.ws + WS_DB);
    for (int u = blockIdx.x; u < NB * 4 * 2 * 36; u += gridDim.x) {
        const int cc = u % 36, chain = u / 36, dir = chain & 1, h = (chain >> 1) & 3, b = chain >> 3;
        dma_v(c, (size_t)b * KVL + cc * 64, h, vpt, lane, w);
        prep<false, true>(c, b, h, dir, cc, nullptr, nullptr, kend, DB + (size_t)u * 64, lane, w);
        asm volatile("s_waitcnt vmcnt(0)" ::: "memory"); __syncthreads();
        const int dkt = w >> 2, dvt = w & 3;
        f32x16 U;
#pragma unroll
        for (int r = 0; r < 16; ++r) U[r] = 0.f;
#pragma unroll
        for (int ks = 0; ks < 4; ++ks) {
            const LAS unsigned char* ap = kend + (dkt * 4 + ks) * 1024 + vlane; const LAS unsigned char* bp = vpt + (dvt * 4 + ks) * 1024 + vlane;
            const s16x4 a0 = vtr(ap), a1 = vtr(ap + 512), b0 = vtr(bp), b1 = vtr(bp + 512);
            U = GL_MFMA(__builtin_shufflevector(a0, a1, 0, 1, 2, 3, 4, 5, 6, 7), __builtin_shufflevector(b0, b1, 0, 1, 2, 3, 4, 5, 6, 7), U); }
        bf16* up = UT + (size_t)u * 8192 + (size_t)(dvt * 32 + (lane & 31)) * 64 + dkt * 32 + 4 * hi;
#pragma unroll
        for (int g4 = 0; g4 < 4; ++g4) { u32x2 wv; wv.x = cvtpk(U[4 * g4], U[4 * g4 + 1]); wv.y = cvtpk(U[4 * g4 + 2], U[4 * g4 + 3]); *(u32x2*)(up + 8 * g4) = wv; }
        __syncthreads();
    }
}
__device__ __forceinline__ void g2_phase(const Ctx& c) {
    const bf16* UT = (const bf16*)(c.ws + WS_UT); const float* DB = (const float*)(c.ws + WS_DB); bf16* ST = (bf16*)(c.ws + WS_ST);
    for (int i = blockIdx.x * blockDim.x + threadIdx.x; i < 128 * 1024; i += gridDim.x * blockDim.x) {
        const int chain = i >> 10, e8 = i & 1023, dk0 = (e8 & 7) * 8, dir = chain & 1, bh = chain >> 1;
        float S[8];
#pragma unroll
        for (int j = 0; j < 8; ++j) S[j] = 0.f;
#pragma unroll 4
        for (int s = 0; s < 36; ++s) {
            const int cc = dir == 0 ? s : (s < 4 ? 3 - s : 39 - s);
            if (cc >= 4) { u32x4 o; o.x = cvtpk(S[0], S[1]); o.y = cvtpk(S[2], S[3]); o.z = cvtpk(S[4], S[5]); o.w = cvtpk(S[6], S[7]);
                *(u32x4*)(ST + ((size_t)(dir * 64 + bh) * 32 + (cc - 4)) * 8192 + (size_t)e8 * 8) = o; }
            const size_t u = (size_t)chain * 36 + cc;
            const u32x4 uw = *(const u32x4*)(UT + u * 8192 + (size_t)e8 * 8); const f32x4 d0 = *(const f32x4*)(DB + u * 64 + dk0), d1 = *(const f32x4*)(DB + u * 64 + dk0 + 4);
            S[0] = S[0] * d0.x + bflo(uw.x); S[1] = S[1] * d0.y + bfhi(uw.x); S[2] = S[2] * d0.z + bflo(uw.y); S[3] = S[3] * d0.w + bfhi(uw.y);
            S[4] = S[4] * d1.x + bflo(uw.z); S[5] = S[5] * d1.y + bfhi(uw.z); S[6] = S[6] * d1.z + bflo(uw.w); S[7] = S[7] * d1.w + bfhi(uw.w);
        }
    }
}
__device__ __forceinline__ void g3_phase(const Ctx& c, LAS unsigned char* lds) {
    const int tid = threadIdx.x, lane = tid & 63, w = __builtin_amdgcn_readfirstlane(tid >> 6), r32 = lane & 31, hi = lane >> 5;
    const int vlane = (4 * hi + ((lane & 15) >> 2)) * 64 + ((lane >> 4) & 1) * 32 + (lane & 3) * 8;
    LAS unsigned char* qd[2] = {lds, lds + 2 * RT_BYTES}; LAS unsigned char* ki[2] = {lds + RT_BYTES, lds + 3 * RT_BYTES};
    LAS unsigned char* vpt = lds + 4 * RT_BYTES; LAS float* ssx = (LAS float*)(lds + 4 * RT_BYTES + PTV_BYTES);
    const bf16* ST = (const bf16*)(c.ws + WS_ST); const bf16* GR = (const bf16*)(c.ws + WS_GR); bf16* MIX = (bf16*)(c.ws + WS_MIX);
    const int ih = w >> 2, dq = w & 3;
    for (int u = blockIdx.x; u < NB * 4 * 32; u += gridDim.x) {
        const int cl = u & 31, h = (u >> 5) & 3, b = u >> 7, bh = b * 4 + h;
        dma_v(c, (size_t)b * KVL + (cl + 4) * 64, h, vpt, lane, w);
        prep<true, false>(c, b, h, 0, cl + 4, qd[0], ki[0], nullptr, nullptr, lane, w);
        prep<true, false>(c, b, h, 1, cl + 4, qd[1], ki[1], nullptr, nullptr, lane, w);
        asm volatile("s_waitcnt vmcnt(0)" ::: "memory"); __syncthreads();
        f32x16 At[2];
#pragma unroll
        for (int jt = 0; jt < 2; ++jt) {
#pragma unroll
            for (int r = 0; r < 16; ++r) At[jt][r] = 0.f;
#pragma unroll
            for (int dir = 0; dir < 2; ++dir) { f32x16 T;
#pragma unroll
                for (int r = 0; r < 16; ++r) T[r] = 0.f;
#pragma unroll
                for (int ks = 0; ks < 4; ++ks) { const bf16x8 a = *(const LAS bf16x8*)(ki[dir] + (jt * 32 + r32) * 144 + (2 * ks + hi) * 16), bq = *(const LAS bf16x8*)(qd[dir] + (ih * 32 + r32) * 144 + (2 * ks + hi) * 16);
                    T = GL_MFMA(a, bq, T); }
                const int icol = ih * 32 + r32;
#pragma unroll
                for (int r = 0; r < 16; ++r) { const int j = jt * 32 + (r & 3) + 8 * (r >> 2) + 4 * hi; const bool keep = dir == 0 ? (j <= icol) : (j >= icol); At[jt][r] += keep ? T[r] : 0.f; } }
        }
        bf16x8 P[4];
        P[0] = pack_half(At[0], 0); P[1] = pack_half(At[0], 1); P[2] = pack_half(At[1], 0); P[3] = pack_half(At[1], 1);
        f32x16 O;
#pragma unroll
        for (int r = 0; r < 16; ++r) O[r] = 0.f;
#pragma unroll
        for (int ks = 0; ks < 4; ++ks) { const LAS unsigned char* vp = vpt + (dq * 4 + ks) * 1024 + vlane; const s16x4 lo = vtr(vp), hh = vtr(vp + 512);
            O = GL_MFMA(__builtin_shufflevector(lo, hh, 0, 1, 2, 3, 4, 5, 6, 7), P[ks], O); }
#pragma unroll
        for (int dir = 0; dir < 2; ++dir) { const bf16* sp = ST + ((size_t)(dir * 64 + bh) * 32 + cl) * 8192 + (size_t)(dq * 32 + r32) * 64 + hi * 8;
#pragma unroll
            for (int ks = 0; ks < 4; ++ks) { const bf16x8 sa = *(const bf16x8*)(sp + ks * 16), bq = *(const LAS bf16x8*)(qd[dir] + (ih * 32 + r32) * 144 + (2 * ks + hi) * 16);
                O = GL_MFMA(sa, bq, O); } }
        float ss = 0.f;
#pragma unroll
        for (int r = 0; r < 16; ++r) ss += O[r] * O[r];
        ss += __shfl_xor(ss, 32);
        if (hi == 0) ssx[dq * 64 + ih * 32 + r32] = ss;
        __syncthreads();
        const int tokl = ih * 32 + r32; const float tot = ssx[tokl] + ssx[64 + tokl] + ssx[128 + tokl] + ssx[192 + tokl];
        const float rstd = rsqrtf(tot * (1.0f / 128.0f) + NORM_EPS);
        const size_t tl = (size_t)b * SEQ + cl * 64 + tokl;
#pragma unroll
        for (int g4 = 0; g4 < 4; ++g4) { const int dv = dq * 32 + 8 * g4 + 4 * hi; const f32x4 gn = *(const f32x4*)(c.gla_norm_g + dv); const u32x2 gr = *(const u32x2*)(GR + tl * 512 + h * 128 + dv);
            u32x2 wv; wv.x = cvtpk(O[4 * g4] * rstd * gn.x * silu_f(bflo(gr.x)), O[4 * g4 + 1] * rstd * gn.y * silu_f(bfhi(gr.x)));
            wv.y = cvtpk(O[4 * g4 + 2] * rstd * gn.z * silu_f(bflo(gr.y)), O[4 * g4 + 3] * rstd * gn.w * silu_f(bfhi(gr.y)));
            *(u32x2*)(MIX + tl * 1024 + 512 + h * 128 + dv) = wv; }
        __syncthreads();
    }
}
#undef GL_MFMA
}

__device__ __forceinline__ void ph_router(const Ctx& c, LAS unsigned char* lds) {
    const int tid = threadIdx.x, lane = tid & 63, wave = tid >> 6;
    const float* MOD = (const float*)(c.ws + WS_MOD); const float* X1 = (const float*)(c.ws + WS_X1); bf16* H2 = (bf16*)(c.ws + WS_H2);
    int* ROUTE = (int*)(c.ws + WS_ROUTE); int* LIST = (int*)(c.ws + WS_LIST); unsigned* ctl = (unsigned*)(c.ws + WS_CTL);
    LAS int* bcnt = (LAS int*)lds;
    LAS int* rt = bcnt + 64;
    f32x4 g[4];
#pragma unroll
    for (int q = 0; q < 4; ++q) g[q] = *(const f32x4*)(c.g_ffn + 4 * lane + 256 * q);
    for (int base = blockIdx.x * 128; base < NTOK; base += gridDim.x * 128) {
        if (tid < 32) bcnt[tid] = 0;
        __syncthreads();
        for (int i = 0; i < 16; ++i) {
            const int lt = wave * 16 + i, tok = base + lt, bb = tok / SEQ; const float* mod = MOD + bb * 6144;
            f32x4 v[4]; float ss = 0.f;
#pragma unroll
            for (int q = 0; q < 4; ++q) { v[q] = *(const f32x4*)(X1 + (size_t)tok * DM + 4 * lane + 256 * q); ss += (v[q].x * v[q].x + v[q].y * v[q].y) + (v[q].z * v[q].z + v[q].w * v[q].w); }
            const float rstd = rsqrtf(wave_sum(ss) * (1.0f / DM) + NORM_EPS);
#pragma unroll
            for (int q = 0; q < 4; ++q) { const f32x4 sh = *(const f32x4*)(mod + 3072 + 4 * lane + 256 * q), sc = *(const f32x4*)(mod + 4096 + 4 * lane + 256 * q);
                v[q] = (v[q] * rstd * g[q]) * (sc + 1.0f) + sh;
                u32x2 w; w.x = pk2(v[q].x, v[q].y); w.y = pk2(v[q].z, v[q].w); *(u32x2*)(H2 + (size_t)tok * DM + 4 * lane + 256 * q) = w; }
            float gl[4];
#pragma unroll
            for (int n = 0; n < 4; ++n) { float p = 0.f;
#pragma unroll
                for (int q = 0; q < 4; ++q) { const int k = 4 * lane + 256 * q; p += v[q].x * c.w_rg[(k + 0) * 4 + n] + v[q].y * c.w_rg[(k + 1) * 4 + n] + v[q].z * c.w_rg[(k + 2) * 4 + n] + v[q].w * c.w_rg[(k + 3) * 4 + n]; }
                gl[n] = wave_sum(p) + c.b_rg[n]; }
            int gs = 0; float gm = gl[0];
#pragma unroll
            for (int n = 1; n < 4; ++n) if (gl[n] > gm) { gm = gl[n]; gs = n; }
            float gden = 0.f;
#pragma unroll
            for (int n = 0; n < 4; ++n) gden += expf(gl[n] - gm);
            const float gw_ = 1.0f / gden;
            float el[8];
#pragma unroll
            for (int n = 0; n < 8; ++n) { float p = 0.f; const int col = gs * 8 + n;
#pragma unroll
                for (int q = 0; q < 4; ++q) { const int k = 4 * lane + 256 * q; p += v[q].x * c.w_re[(k + 0) * 32 + col] + v[q].y * c.w_re[(k + 1) * 32 + col] + v[q].z * c.w_re[(k + 2) * 32 + col] + v[q].w * c.w_re[(k + 3) * 32 + col]; }
                el[n] = wave_sum(p) + c.b_re[col]; }
            int i0 = 0; float v0 = el[0];
#pragma unroll
            for (int n = 1; n < 8; ++n) if (el[n] > v0) { v0 = el[n]; i0 = n; }
            int i1 = -1; float v1 = -3.0e38f;
#pragma unroll
            for (int n = 0; n < 8; ++n) if (n != i0 && el[n] > v1) { v1 = el[n]; i1 = n; }
            const float e1 = expf(v1 - v0), den = 1.0f + e1; const float w0 = gw_ / den, w1 = gw_ * e1 / den;
            if (lane == 0) { const int e0g = gs * 8 + i0, e1g = gs * 8 + i1; const int r0 = atomicAdd((int*)&bcnt[e0g], 1), r1 = atomicAdd((int*)&bcnt[e1g], 1);
                LAS int* r = rt + lt * 6; r[0] = e0g; r[1] = e1g; r[2] = r0; r[3] = r1; r[4] = __builtin_bit_cast(int, w0); r[5] = __builtin_bit_cast(int, w1); }
        }
        __syncthreads();
        if (tid < 32) bcnt[32 + tid] = (int)__hip_atomic_fetch_add(ctl + CW_CNT + 64 * tid, (unsigned)bcnt[tid], __ATOMIC_RELAXED, __HIP_MEMORY_SCOPE_AGENT);
        __syncthreads();
        if (tid < 128) { const LAS int* r = rt + tid * 6; const int tok = base + tid; const int e0g = r[0], e1g = r[1], p0 = bcnt[32 + e0g] + r[2], p1 = bcnt[32 + e1g] + r[3];
            int* ro = ROUTE + (size_t)tok * 8; ro[0] = e0g; ro[1] = e1g; ro[2] = p0; ro[3] = p1; ro[4] = r[4]; ro[5] = r[5];
            LIST[e0g * NTOK + p0] = tok; LIST[e1g * NTOK + p1] = tok; }
        __syncthreads();
    }
}

__device__ __forceinline__ void ph_final(const Ctx& c, LAS unsigned char* lds) {
    const int tid = threadIdx.x, lane = tid & 63, wave = tid >> 6, nw = blockDim.x >> 6;
    const float* MOD = (const float*)(c.ws + WS_MOD); const float* X1 = (const float*)(c.ws + WS_X1); const bf16* YB = (const bf16*)(c.ws + WS_YB);
    const int* ROUTE = (const int*)(c.ws + WS_ROUTE);
    LAS int* mm = (LAS int*)lds; moe_build(mm, (const unsigned*)(c.ws + WS_CTL));
    f32x4 g[4];
#pragma unroll
    for (int q = 0; q < 4; ++q) g[q] = *(const f32x4*)(c.g_final + 4 * lane + 256 * q);
    for (int tok = blockIdx.x * nw + wave; tok < NTOK; tok += gridDim.x * nw) {
        const int bb = tok / SEQ; const float* gt = MOD + bb * 6144 + 5120; const int* ro = ROUTE + (size_t)tok * 8;
        const int e0 = ro[0], e1 = ro[1]; const size_t r0 = ((size_t)mm[32 + e0] << 8) + ro[2], r1 = ((size_t)mm[32 + e1] << 8) + ro[3];
        const float w0 = __builtin_bit_cast(float, ro[4]), w1 = __builtin_bit_cast(float, ro[5]);
        f32x4 v[4]; float ss = 0.f;
#pragma unroll
        for (int q = 0; q < 4; ++q) { const int col = 4 * lane + 256 * q; const f32x4 xv = *(const f32x4*)(X1 + (size_t)tok * DM + col), gv = *(const f32x4*)(gt + col);
            const u32x2 ya = *(const u32x2*)(YB + r0 * DM + col), yb = *(const u32x2*)(YB + r1 * DM + col);
            f32x4 y; y.x = w0 * bflo(ya.x) + w1 * bflo(yb.x); y.y = w0 * bfhi(ya.x) + w1 * bfhi(yb.x); y.z = w0 * bflo(ya.y) + w1 * bflo(yb.y); y.w = w0 * bfhi(ya.y) + w1 * bfhi(yb.y);
            v[q] = xv + gv * y; ss += (v[q].x * v[q].x + v[q].y * v[q].y) + (v[q].z * v[q].z + v[q].w * v[q].w); }
        const float rstd = rsqrtf(wave_sum(ss) * (1.0f / DM) + NORM_EPS);
#pragma unroll
        for (int q = 0; q < 4; ++q) *(f32x4*)(c.out + (size_t)tok * DM + 4 * lane + 256 * q) = v[q] * rstd * g[q];
    }
}

#define XB_TMO      128
#define XB_XCNT(j)  (256  + 64 * (j))
#define XB_XSUB(j)  (1280 + 64 * (j))
#define XB_XGEN(j)  (2304 + 64 * (j))
#define XB_TOP      3328
#define XB_TOPGEN   3392
#define XCD_BAR_WORDS 3456
#define XB_SPIN_CAP (1u << 18)

__device__ __forceinline__ unsigned xb_ld(unsigned* p)              { return __hip_atomic_load(p, __ATOMIC_RELAXED, __HIP_MEMORY_SCOPE_AGENT); }
__device__ __forceinline__ unsigned xb_add(unsigned* p, unsigned v) { return __hip_atomic_fetch_add(p, v, __ATOMIC_RELAXED, __HIP_MEMORY_SCOPE_AGENT); }
__device__ __forceinline__ unsigned xb_xcc_id() { return (unsigned)__builtin_amdgcn_s_getreg((3 << 11) | 20) & 0xFu; }
#define XB_SPIN(cond, bar) do { unsigned _sp = 0; while (cond) { __builtin_amdgcn_s_sleep(1); \
    if ((++_sp & 255u) == 0u) { if (xb_ld(&(bar)[XB_TMO])) break; if (_sp > XB_SPIN_CAP) { atomicAdd(&(bar)[XB_TMO], 1u); break; } } } } while (0)

struct XcdBarrier {
    unsigned* bar; unsigned x;
    volatile LAS unsigned* st;
};
__device__ __forceinline__ XcdBarrier xcd_barrier_post(unsigned* bar, volatile LAS unsigned* st) {
    XcdBarrier b; b.bar = bar; b.x = xb_xcc_id(); b.st = st;
    if (threadIdx.x == 0) (void)xb_add(&bar[XB_XCNT(b.x)], 1u);
    return b;
}
__device__ __forceinline__ void xcd_barrier_complete(unsigned* bar, unsigned x, unsigned& nloc, unsigned& nx) {
    const unsigned G = gridDim.x * gridDim.y * gridDim.z;
    unsigned sum, cnt, mine, sp = 0u;
    for (;;) {
        sum = 0u; cnt = 0u; mine = 0u;
#pragma unroll
        for (unsigned j = 0; j < 16; ++j) { const unsigned c = xb_ld(&bar[XB_XCNT(j)]); sum += c; cnt += (c > 0u) ? 1u : 0u; mine = (j == x) ? c : mine; }
        if (sum == G) break;
        __builtin_amdgcn_s_sleep(1);
        if ((++sp & 255u) == 0u) { if (xb_ld(&bar[XB_TMO])) break; if (sp > XB_SPIN_CAP) { atomicAdd(&bar[XB_TMO], 1u); break; } }
    }
    nloc = mine > 0u ? mine : 1u; nx = cnt > 0u ? cnt : 1u;
}
__device__ __forceinline__ void xcd_barrier(const XcdBarrier& b) {
    asm volatile("s_waitcnt vmcnt(0)" ::: "memory");
    __syncthreads();
    if (threadIdx.x == 0) {
        unsigned* bar = b.bar;
        __builtin_amdgcn_s_waitcnt(0);
        unsigned nloc = b.st[0], nx = b.st[1];
        if (nloc == 0u) { xcd_barrier_complete(bar, b.x, nloc, nx); b.st[0] = nloc; b.st[1] = nx; }
        const unsigned old = xb_add(&bar[XB_XSUB(b.x)], 1u);
        const unsigned gen = old / nloc;
        if (old + 1u == (gen + 1u) * nloc) {
            __builtin_amdgcn_fence(__ATOMIC_RELEASE, "agent");
            asm volatile("s_waitcnt vmcnt(0)" ::: "memory");
            const unsigned og = xb_add(&bar[XB_TOP], 1u);
            const unsigned tg = og / nx;
            if (og + 1u == (tg + 1u) * nx) xb_add(&bar[XB_TOPGEN], 1u);
            else XB_SPIN(xb_ld(&bar[XB_TOPGEN]) == tg, bar);
            __builtin_amdgcn_fence(__ATOMIC_ACQUIRE, "agent");
            xb_add(&bar[XB_XGEN(b.x)], 1u);
            asm volatile("s_waitcnt vmcnt(0)" ::: "memory");
        } else {
            XB_SPIN(xb_ld(&bar[XB_XGEN(b.x)]) == gen, bar);
            __builtin_amdgcn_fence(__ATOMIC_ACQUIRE, "agent");
            asm volatile("s_waitcnt vmcnt(0)" ::: "memory");
        }
    }
    __syncthreads();
}

constexpr int LDS_BYTES = 147456;
constexpr int LDS_BARW_OFF = LDS_BYTES - 16;
__global__ void __launch_bounds__(512, 2) mega_fwd(Ctx c) {
    extern __shared__ __attribute__((aligned(16))) unsigned char lds_raw[];
    LAS unsigned char* lds = (LAS unsigned char*)lds_raw;
    if (threadIdx.x == 0) *(LAS u32x4*)(lds + LDS_BARW_OFF) = (u32x4){0u, 0u, 0u, 0u};
    __syncthreads();
    const XcdBarrier bar = xcd_barrier_post((unsigned*)(c.ws + WS_CTL) + CW_BAR, (volatile LAS unsigned*)(lds + LDS_BARW_OFF));
    ph_prologue(c, lds);        xcd_barrier(bar);
    ph_norm1(c);                xcd_barrier(bar);
    ph_inproj(c, lds);          xcd_barrier(bar);
    da::attn_phase(c, lds);     xcd_barrier(bar);
    gla::g1_phase(c, lds);      xcd_barrier(bar);
    gla::g2_phase(c);           xcd_barrier(bar);
    gla::g3_phase(c, lds);      xcd_barrier(bar);
    ph_outproj(c, lds);         xcd_barrier(bar);
    ph_router(c, lds);          xcd_barrier(bar);
    ph_gateup(c, lds);          xcd_barrier(bar);
    ph_down(c, lds);            xcd_barrier(bar);
    ph_final(c, lds);
}

extern "C" void kernel_launch(void* const* d_in, const int* in_sizes, int n_in, void* d_out, int out_size, void* d_ws, size_t ws_size, hipStream_t stream) {
    static int grid = 0;
    if (grid == 0) {
        if (n_in != 23 || in_sizes[0] != NTOK * DM || out_size != NTOK * DM || ws_size < WS_END) { fprintf(stderr, "kernel_launch: unexpected problem shape (n_in %d, in0 %d, out %d, ws %zu)\n", n_in, n_in > 0 ? in_sizes[0] : -1, out_size, ws_size); grid = -1; return; }
        int dev = 0, cus = 0, per_cu = 0;
        if (hipGetDevice(&dev) != hipSuccess || hipDeviceGetAttribute(&cus, hipDeviceAttributeMultiprocessorCount, dev) != hipSuccess) { grid = -1; return; }
        if (hipFuncSetAttribute((const void*)mega_fwd, hipFuncAttributeMaxDynamicSharedMemorySize, LDS_BYTES) != hipSuccess) { fprintf(stderr, "kernel_launch: hipFuncSetAttribute failed\n"); grid = -1; return; }
        if (hipOccupancyMaxActiveBlocksPerMultiprocessor(&per_cu, (const void*)mega_fwd, 512, LDS_BYTES) != hipSuccess || per_cu < 1) fprintf(stderr, "kernel_launch: occupancy query reports %d workgroups per CU\n", per_cu);
        (void)hipGetLastError();
        grid = cus;
    }
    if (grid < 0) return;
    Ctx c{};
    const float** f = (const float**)&c;
    for (int i = 0; i < 23; ++i) f[i] = (const float*)d_in[i];
    c.out = (float*)d_out; c.ws = (unsigned char*)d_ws;
    if (hipMemsetAsync((unsigned char*)d_ws + WS_CTL, 0, CTL_ZERO_BYTES, stream) != hipSuccess) return;
    hipLaunchKernelGGL(mega_fwd, dim3(grid), dim3(512), LDS_BYTES, stream, c);
}
```

```cpp
#include <hip/hip_runtime.h>
#include <cstdint>
#include <cstdio>

#define GAS __attribute__((address_space(1)))
#define LAS __attribute__((address_space(3)))
typedef unsigned short bf16;
typedef float f32x4 __attribute__((ext_vector_type(4)));
typedef float f32x2 __attribute__((ext_vector_type(2)));
typedef unsigned u32x4 __attribute__((ext_vector_type(4)));
typedef unsigned u32x2 __attribute__((ext_vector_type(2)));

constexpr int NB = 16, SEQ = 2048, DM = 1024, CTXL = 256, KVL = CTXL + SEQ;
constexpr int NTOK = NB * SEQ;
constexpr int NROW = NB * KVL;
constexpr int NPROJ = 3104, NPROJ_PAD = 3328;
constexpr int NEXP = 32, EHID = 512;
constexpr int MOE_ROWS_MAX = 73728;
constexpr float NORM_EPS = 1e-6f;
constexpr float LAMBDA_INIT = 0.2f;
constexpr float QSCALE = 0.125f * 1.4426950408889634f;

constexpr int C_DAQ = 0, C_DAK = 512, C_DAV = 1024, C_GQ = 1536, C_GK = 1792, C_GV = 2048, C_GR = 2560, C_LR = 3072;

constexpr size_t MiB = 1u << 20;
constexpr size_t WS_CTL = 0, CTL_ZERO_BYTES = 1 * MiB;
constexpr size_t WS_MOD = 1 * MiB;
constexpr size_t WS_ROPE = 1 * MiB + 512 * 1024;
constexpr size_t WS_WRT = 462 * MiB;
constexpr size_t WS_SHW = 462 * MiB + 256 * 1024;
constexpr size_t WS_ROUTE = 2 * MiB;
constexpr size_t WS_LIST = 3 * MiB;
constexpr size_t WS_WIN_T = 7 * MiB;
constexpr size_t WS_WOUT_T = 14 * MiB;
constexpr size_t WS_WGU_T = 16 * MiB;
constexpr size_t WS_WD_T = 80 * MiB;
constexpr size_t WS_H = 112 * MiB;
constexpr size_t WS_HMID = 112 * MiB;
constexpr size_t WS_QDA = 184 * MiB;
constexpr size_t WS_KDA = 216 * MiB;
constexpr size_t WS_VDA = 252 * MiB;
constexpr size_t WS_GQ = 288 * MiB;
constexpr size_t WS_GK = 304 * MiB;
constexpr size_t WS_GV = 322 * MiB;
constexpr size_t WS_GR = 358 * MiB;
constexpr size_t WS_LR = 390 * MiB;
constexpr size_t WS_X1 = 184 * MiB;
constexpr size_t WS_H2 = 312 * MiB;
constexpr size_t WS_YB = 312 * MiB;
constexpr size_t WS_MIX = 112 * MiB;
constexpr size_t WS_UT = 184 * MiB;
constexpr size_t WS_ST = 256 * MiB;
constexpr size_t WS_QD = 395 * MiB;
constexpr size_t WS_KI = 427 * MiB;
constexpr size_t WS_KEND = 464 * MiB;
constexpr size_t WS_DB = 460 * MiB;
constexpr size_t WS_END = 500 * MiB;

constexpr int CW_BAR = 4096;
constexpr int CW_CNT = 16384;

struct Ctx {
    const float *x, *c, *ctx, *c_ctx, *w_ada, *b_ada, *g_mix, *g_ffn, *w_in, *da_lambda, *da_subln_g, *gate_w2, *gate_b, *gla_norm_g, *w_out,
        *w_rg, *b_rg, *w_re, *b_re, *w_gate, *w_up, *w_down, *g_final;
    float* out; unsigned char* ws;
};

__device__ __forceinline__ unsigned f2bf(float f) { unsigned u = __builtin_bit_cast(unsigned, f); return (u + 0x7fffu + ((u >> 16) & 1u)) >> 16; }
__device__ __forceinline__ unsigned pk2(float lo, float hi) { return f2bf(lo) | (f2bf(hi) << 16); }
__device__ __forceinline__ float bf2f(unsigned b) { return __builtin_bit_cast(float, b << 16); }
__device__ __forceinline__ float bflo(unsigned w) { return __builtin_bit_cast(float, w << 16); }
__device__ __forceinline__ float bfhi(unsigned w) { return __builtin_bit_cast(float, w & 0xffff0000u); }
__device__ __forceinline__ float wave_sum(float v) {
#pragma unroll
    for (int o = 1; o < 64; o <<= 1) v += __shfl_xor(v, o);
    return v;
}
__device__ __forceinline__ float silu_f(float v) { return v / (1.0f + __expf(-v)); }
#define LDS_WAIT() asm volatile("s_waitcnt lgkmcnt(0)" ::: "memory")

template <class RowMap>
__device__ __forceinline__ void transpose_item(const float* W, int ldw, int k0, int n0, bf16* WT, int KT, const RowMap& rm, LAS float* scr, int lane) {
    float v[32];
#pragma unroll
    for (int i = 0; i < 32; ++i) v[i] = W[(size_t)(k0 + 2 * i + (lane >> 5)) * ldw + n0 + (lane & 31)];
#pragma unroll
    for (int i = 0; i < 32; ++i) scr[(2 * i + (lane >> 5)) * 33 + (lane & 31)] = v[i];
    LDS_WAIT(); asm volatile("" ::: "memory");
    const int c = lane & 7;
#pragma unroll
    for (int j = 0; j < 4; ++j) { const int n = (lane >> 3) + 8 * j; const LAS float* s = scr + (8 * c) * 33 + n;
        u32x4 o; o.x = pk2(s[0 * 33], s[1 * 33]); o.y = pk2(s[2 * 33], s[3 * 33]); o.z = pk2(s[4 * 33], s[5 * 33]); o.w = pk2(s[6 * 33], s[7 * 33]);
        *(u32x4*)(WT + (size_t)rm(n0 + n) * KT + k0 + 8 * c) = o; }
    LDS_WAIT(); asm volatile("" ::: "memory");
}
struct RowId { int off; __device__ __forceinline__ int operator()(int n) const { return off + n; } };
struct RowRope { __device__ __forceinline__ int operator()(int n) const { const int l = n & 31; return (n & ~31) + ((l & 15) << 1) + (l >> 4); } };
struct RowGU { int up; __device__ __forceinline__ int operator()(int n) const { return 8 * (n >> 2) + (n & 3) + 4 * up; } };

__device__ __forceinline__ void ph_prologue(const Ctx& c, LAS unsigned char* lds) {
    const int tid = threadIdx.x, lane = tid & 63, wave = tid >> 6, nw = blockDim.x >> 6;
    unsigned char* ws = c.ws;
    if (blockIdx.x < 96 && nw == 8) {
        LAS float* sv = (LAS float*)lds;
        LAS float* red = sv + 17 * 1024;
        for (int i = tid; i < 17 * 1024; i += 512) { const int r = i >> 10, k = i & 1023; const float v = r < 16 ? c.c[r * 1024 + k] : c.c_ctx[k]; sv[i] = v / (1.0f + expf(-v)); }
        __syncthreads();
        const int col = blockIdx.x * 64 + lane;
        float acc[17];
#pragma unroll
        for (int r = 0; r < 17; ++r) acc[r] = 0.f;
        for (int k = wave * 128; k < wave * 128 + 128; ++k) { const float w = c.w_ada[(size_t)k * 6144 + col];
#pragma unroll
            for (int r = 0; r < 17; ++r) acc[r] += sv[r * 1024 + k] * w; }
#pragma unroll
        for (int r = 0; r < 17; ++r) red[(wave * 17 + r) * 64 + lane] = acc[r];
        __syncthreads();
        float* MOD = (float*)(ws + WS_MOD);
        for (int i = tid; i < 17 * 64; i += 512) { const int r = i >> 6, l = i & 63; float s = 0.f;
            for (int w = 0; w < 8; ++w) s += red[(w * 17 + r) * 64 + l];
            MOD[r * 6144 + blockIdx.x * 64 + l] = s + c.b_ada[blockIdx.x * 64 + l]; }
        __syncthreads();
    }
    { f32x2* ROPE = (f32x2*)(ws + WS_ROPE);
      for (int i = blockIdx.x * blockDim.x + tid; i < 2048 * 32; i += gridDim.x * blockDim.x) {
          const int t = i >> 5, a = (i >> 4) & 1, f = i & 15; const float pos = (float)(a == 0 ? (t >> 6) : (t & 63));
          const float inv = exp2f(-(float)f * (13.287712379549449f / 16.0f));
          const float ang = pos * inv; f32x2 cs; cs.x = __cosf(ang); cs.y = __sinf(ang); ROPE[i] = cs; } }
    { bf16* WRT = (bf16*)(ws + WS_WRT);
      for (int i = blockIdx.x * blockDim.x + tid; i < 36 * 1024; i += gridDim.x * blockDim.x) { const int n = i >> 10, k = i & 1023;
          const float wv = n < 32 ? c.w_re[k * 32 + n] : c.w_rg[k * 4 + (n - 32)]; const unsigned h = f2bf(wv); WRT[i] = (bf16)h; WRT[36 * 1024 + i] = (bf16)f2bf(wv - bf2f(h)); } }
    { u32x4* z = (u32x4*)(ws + WS_WIN_T + (size_t)NPROJ * 1024 * 2); const int n16 = (NPROJ_PAD - NPROJ) * 1024 * 2 / 16;
      for (int i = blockIdx.x * blockDim.x + tid; i < n16; i += gridDim.x * blockDim.x) z[i] = (u32x4){0u, 0u, 0u, 0u}; }
    LAS float* scr = (LAS float*)(lds + wave * 8704);
    const int gw = blockIdx.x * nw + wave, NGW = gridDim.x * nw;
    constexpr int I_IN = 16 * 97, I_OUT = 16 * 32, I_G = 32 * 16 * 16, I_U = I_G, I_D = 32 * 8 * 32;
    constexpr int NITEMS = I_IN + I_OUT + I_G + I_U + I_D;
    bf16* WIN_T = (bf16*)(ws + WS_WIN_T); bf16* WOUT_T = (bf16*)(ws + WS_WOUT_T); bf16* WGU_T = (bf16*)(ws + WS_WGU_T); bf16* WD_T = (bf16*)(ws + WS_WD_T);
    for (int it = gw; it < NITEMS; it += NGW) {
        int r = it;
        if (r < I_IN) { const int kb = r / 97, nb = r % 97, n0 = nb * 32;
            if (n0 < 1024) transpose_item(c.w_in, NPROJ, kb * 64, n0, WIN_T, 1024, RowRope{}, scr, lane);
            else transpose_item(c.w_in, NPROJ, kb * 64, n0, WIN_T, 1024, RowId{0}, scr, lane);
            continue; }
        r -= I_IN;
        if (r < I_OUT) { const int kb = r / 32, nb = r % 32; transpose_item(c.w_out, 1024, kb * 64, nb * 32, WOUT_T, 1024, RowId{0}, scr, lane); continue; }
        r -= I_OUT;
        if (r < I_G) { const int e = r / 256, q = r % 256, kb = q / 16, nb = q % 16;
            transpose_item(c.w_gate + (size_t)e * 1024 * 512, 512, kb * 64, nb * 32, WGU_T + (size_t)e * 1024 * 1024, 1024, RowGU{0}, scr, lane); continue; }
        r -= I_G;
        if (r < I_U) { const int e = r / 256, q = r % 256, kb = q / 16, nb = q % 16;
            transpose_item(c.w_up + (size_t)e * 1024 * 512, 512, kb * 64, nb * 32, WGU_T + (size_t)e * 1024 * 1024, 1024, RowGU{1}, scr, lane); continue; }
        r -= I_U;
        { const int e = r / 256, q = r % 256, kb = q / 32, nb = q % 32;
            transpose_item(c.w_down + (size_t)e * 512 * 1024, 1024, kb * 64, nb * 32, WD_T + (size_t)e * 1024 * 512, 512, RowId{0}, scr, lane); }
    }
}

__device__ __forceinline__ void ph_norm1(const Ctx& c) {
    const int tid = threadIdx.x, lane = tid & 63, wave = tid >> 6, nw = blockDim.x >> 6;
    const int gw = blockIdx.x * nw + wave, NGW = gridDim.x * nw;
    const float* MOD = (const float*)(c.ws + WS_MOD); bf16* H = (bf16*)(c.ws + WS_H);
    f32x4 g[4];
#pragma unroll
    for (int j = 0; j < 4; ++j) g[j] = *(const f32x4*)(c.g_mix + 4 * lane + 256 * j);
    if (gw < 16 * 36) { const int b = gw / 36, n = gw % 36; const float* sh = MOD + b * 6144 + 3072; float p = 0.f;
        for (int q = 0; q < 16; ++q) { const int k = lane + 64 * q; p += sh[k] * (n < 32 ? c.w_re[k * 32 + n] : c.w_rg[k * 4 + (n - 32)]); }
        p = wave_sum(p); if (lane == 0) ((float*)(c.ws + WS_SHW))[gw] = p; }
    for (int r0 = gw * 2; r0 < NROW; r0 += NGW * 2) {
        f32x4 v[2][4];
#pragma unroll
        for (int t = 0; t < 2; ++t) { const int r = r0 + t, b = r / KVL, j = r % KVL; const bool isctx = j < CTXL;
            const float* src = isctx ? c.ctx + ((size_t)b * CTXL + j) * DM : c.x + ((size_t)b * SEQ + (j - CTXL)) * DM;
#pragma unroll
            for (int q = 0; q < 4; ++q) v[t][q] = *(const f32x4*)(src + 4 * lane + 256 * q); }
#pragma unroll
        for (int t = 0; t < 2; ++t) { const int r = r0 + t, b = r / KVL, j = r % KVL; const bool isctx = j < CTXL;
            const float* mod = MOD + (isctx ? 16 : b) * 6144; float ss = 0.f;
#pragma unroll
            for (int q = 0; q < 4; ++q) ss += (v[t][q].x * v[t][q].x + v[t][q].y * v[t][q].y) + (v[t][q].z * v[t][q].z + v[t][q].w * v[t][q].w);
            const float rstd = rsqrtf(wave_sum(ss) * (1.0f / DM) + NORM_EPS);
#pragma unroll
            for (int q = 0; q < 4; ++q) { const f32x4 sh = *(const f32x4*)(mod + 4 * lane + 256 * q), sc = *(const f32x4*)(mod + 1024 + 4 * lane + 256 * q);
                const f32x4 o = (v[t][q] * rstd * g[q]) * (sc + 1.0f) + sh;
                u32x2 w; w.x = pk2(o.x, o.y); w.y = pk2(o.z, o.w); *(u32x2*)(H + (size_t)r * DM + 4 * lane + 256 * q) = w; } }
    }
}

__device__ __forceinline__ u32x4 pack8(const f32x4& a, const f32x4& b) { u32x4 w; w.x = pk2(a.x, a.y); w.y = pk2(a.z, a.w); w.z = pk2(b.x, b.y); w.w = pk2(b.z, b.w); return w; }
struct EpiInProj {
    unsigned char* ws;
    __device__ __forceinline__ void rope8(int t, int i8, f32x4& a, f32x4& b, float scale) const {
        const f32x2* R = (const f32x2*)(ws + WS_ROPE) + (size_t)t * 32 + (i8 >> 5) * 16 + ((i8 & 31) >> 1);
        const f32x4 c0 = *(const f32x4*)R, c1 = *(const f32x4*)(R + 2);
        f32x4 oa, ob;
        oa.x = (a.x * c0.x - a.y * c0.y) * scale; oa.y = (a.y * c0.x + a.x * c0.y) * scale;
        oa.z = (a.z * c0.z - a.w * c0.w) * scale; oa.w = (a.w * c0.z + a.z * c0.w) * scale;
        ob.x = (b.x * c1.x - b.y * c1.y) * scale; ob.y = (b.y * c1.x + b.x * c1.y) * scale;
        ob.z = (b.z * c1.z - b.w * c1.w) * scale; ob.w = (b.w * c1.z + b.z * c1.w) * scale;
        a = oa; b = ob;
    }
    __device__ __forceinline__ void emit8(int row, int col, f32x4 a, f32x4 b) const {
        const int bb = row / KVL, j = row % KVL; const bool lat = j >= CTXL; const int t = j - CTXL; const size_t tl = (size_t)bb * SEQ + t;
        if (col < C_DAK) { if (!lat) return; rope8(t, col & 63, a, b, QSCALE); *(u32x4*)((bf16*)(ws + WS_QDA) + tl * 512 + col) = pack8(a, b); }
        else if (col < C_DAV) { if (lat) rope8(t, col & 63, a, b, 1.0f); *(u32x4*)((bf16*)(ws + WS_KDA) + (size_t)row * 512 + (col - C_DAK)) = pack8(a, b); }
        else if (col < C_GQ) { *(u32x4*)((bf16*)(ws + WS_VDA) + (size_t)row * 512 + (col - C_DAV)) = pack8(a, b); }
        else if (col < C_GK) { if (!lat) return; *(u32x4*)((bf16*)(ws + WS_GQ) + tl * 256 + (col - C_GQ)) = pack8(a * 0.125f, b * 0.125f); }
        else if (col < C_GV) { *(u32x4*)((bf16*)(ws + WS_GK) + (size_t)row * 256 + (col - C_GK)) = pack8(a, b); }
        else if (col < C_GR) { *(u32x4*)((bf16*)(ws + WS_GV) + (size_t)row * 512 + (col - C_GV)) = pack8(a, b); }
        else if (col < C_LR) { if (!lat) return; *(u32x4*)((bf16*)(ws + WS_GR) + tl * 512 + (col - C_GR)) = pack8(a, b); }
        else if (col < NPROJ) { float* p = (float*)(ws + WS_LR) + (size_t)row * 32 + (col - C_LR); *(f32x4*)p = a; *(f32x4*)(p + 4) = b; }
    }
};
struct EpiOutProj {
    const float* x; const float* MOD; bf16* X1;
    __device__ __forceinline__ void emit8(int row, int col, f32x4 a, f32x4 b) const {
        const int bb = row / SEQ; const float* g = MOD + bb * 6144 + 2048 + col; const size_t o = (size_t)row * DM + col;
        const f32x4 g0 = *(const f32x4*)g, g1 = *(const f32x4*)(g + 4), x0 = *(const f32x4*)(x + o), x1 = *(const f32x4*)(x + o + 4);
        *(u32x4*)(X1 + o) = pack8(x0 + g0 * a, x1 + g1 * b);
    }
};
struct EpiGateUp {
    bf16* HMID;
    __device__ __forceinline__ void emit8(int row, int col, f32x4 a, f32x4 b) const {
        f32x4 h; h.x = silu_f(a.x) * b.x; h.y = silu_f(a.y) * b.y; h.z = silu_f(a.z) * b.z; h.w = silu_f(a.w) * b.w;
        u32x2 w; w.x = pk2(h.x, h.y); w.y = pk2(h.z, h.w); *(u32x2*)(HMID + (size_t)row * EHID + (col >> 1)) = w;
    }
};
struct EpiDown {
    bf16* YB;
    __device__ __forceinline__ void emit8(int row, int col, f32x4 a, f32x4 b) const { *(u32x4*)(YB + (size_t)row * DM + col) = pack8(a, b); }
};

__device__ __forceinline__ void moe_build(LAS int* mm, const unsigned* ctl) {
    if (threadIdx.x < 64) { const int l = threadIdx.x, e = l & 31;
        const int cnt = (int)__hip_atomic_load((unsigned*)ctl + CW_CNT + 64 * e, __ATOMIC_RELAXED, __HIP_MEMORY_SCOPE_AGENT);
        const int tiles = (cnt + 255) >> 8; int incl = tiles;
#pragma unroll
        for (int o = 1; o < 32; o <<= 1) { const int v = __shfl_up(incl, o); if (e >= o) incl += v; }
        if (l < 32) { mm[e] = cnt; mm[32 + e] = incl - tiles; if (e == 31) mm[64] = incl; } }
    __syncthreads();
}
__device__ __forceinline__ int moe_tile_expert(const LAS int* mm, int tile) { int e = 0;
#pragma unroll 1
    for (int i = 1; i < NEXP; ++i) if (mm[32 + i] <= tile) e = i;
    return e; }

namespace pg8 {
typedef short bf16x8 __attribute__((ext_vector_type(8)));
constexpr int BM = 256, BK = 64, HALF = 128, HTB = HALF * BK * 2  , STAGE_BYTES = 8 * HTB;
__host__ __device__ __forceinline__ int lds_byte(int r, int c) { const int st = (r >> 4) * 2 + (c >> 5), rr = r & 15, cc = c & 31, ob = rr * 64 + cc * 2; return st * 1024 + (ob ^ (((ob >> 9) & 1) << 5)); }
__host__ __device__ __forceinline__ void stage_rc(int b, int& R, int& C) { const int st = b / 1024, sb = b % 1024, swz = sb ^ (((sb >> 9) & 1) << 5); R = (st >> 1) * 16 + swz / 64; C = (st & 1) * 32 + (swz % 64) / 2; }
__host__ __device__ __forceinline__ int perm32(int rho) { const int n = rho >> 4, i = rho & 15; return 8 * (i >> 2) + 4 * n + (i & 3); }

struct Unit { const char* A; const char* B; int row0, col0, ge, gp; };
struct Gemm { int K; const int* LIST; const LAS int* mm; };

template <class E8> struct Epi8 {
    E8 e;
    __device__ __forceinline__ void operator()(const f32x4 (&acc)[2][2][4][2], const Unit& u, int wr, int wc, int fr, int fq) const {
#pragma unroll
        for (int ai = 0; ai < 2; ++ai)
#pragma unroll
            for (int m = 0; m < 4; ++m)
#pragma unroll
                for (int bj = 0; bj < 2; ++bj) e.emit8(u.row0 + ai * HALF + wr * 64 + m * 16 + fr, u.col0 + bj * HALF + wc * 32 + 8 * fq, acc[ai][bj][m][0], acc[ai][bj][m][1]);
    }
};

template <class Epi, class Sched, bool GATHER, bool ALIGN_EPI = true, bool SP2 = true>
__device__ __forceinline__ void gemm_phase(LAS unsigned char* lds, const Gemm g, const Sched& S, const Epi& E) {
    const int tid = threadIdx.x, wid = __builtin_amdgcn_readfirstlane(tid >> 6), lane = tid & 63, wr = wid >> 2, wc = wid & 3, fr = lane & 15, fq = lane >> 4;
    const int K = g.K, nt = K / BK;
    int Rr[2], Cc[2]; unsigned voffB[2];
#pragma unroll
    for (int i = 0; i < 2; ++i) { stage_rc(tid * 16 + i * 8192, Rr[i], Cc[i]); const int Rb = (Rr[i] & ~31) + perm32(Rr[i] & 31); voffB[i] = (unsigned)(Rb * K + Cc[i]) * 2u; }
    const size_t kstep = (size_t)(BK * 2);
    const size_t hstep = (size_t)HALF * K * 2;
    const unsigned ldsw = (unsigned)wid * 1024u;
    const int aoff = lds_byte(wr * 64 + fr, fq * 8), boff = lds_byte(wc * 32 + fr, fq * 8);
#define PG8_MKOFF(u, vo) do { _Pragma("unroll") for (int _h = 0; _h < 2; ++_h) _Pragma("unroll") for (int _i = 0; _i < 2; ++_i) { \
        if (GATHER) { const int _pos = (u).gp + _h * HALF + Rr[_i]; const int _tok = g.LIST[(u).ge * NTOK + (_pos < g.mm[(u).ge] ? _pos : 0)]; (vo)[_h][_i] = (unsigned)(_tok * K + Cc[_i]) * 2u; } \
        else (vo)[_h][_i] = (unsigned)((_h * HALF + Rr[_i]) * K + Cc[_i]) * 2u; } } while (0)
#define PG8_SA(b, h) (((b) * 2 + (h)) * HTB)
#define PG8_SB(b, h) ((4 + (b) * 2 + (h)) * HTB)
#define PG8_STAGE(bufoff, gbase, voff) do { _Pragma("unroll") for (int _i = 0; _i < 2; ++_i) \
        __builtin_amdgcn_global_load_lds((const unsigned*)((const char*)(gbase) + (voff)[_i]), (LAS unsigned*)(lds + (bufoff) + ldsw + _i * 8192), 16, 0, 0); } while (0)
#define PG8_LDA(dst, b, h) do { _Pragma("unroll") for (int m = 0; m < 4; ++m) _Pragma("unroll") for (int k = 0; k < 2; ++k) dst[m][k] = *(const LAS bf16x8*)(lds + PG8_SA(b, h) + aoff + m * 2048 + k * 1024); } while (0)
#define PG8_LDB(dst, b, h) do { _Pragma("unroll") for (int n = 0; n < 2; ++n) _Pragma("unroll") for (int k = 0; k < 2; ++k) dst[n][k] = *(const LAS bf16x8*)(lds + PG8_SB(b, h) + boff + n * 2048 + k * 1024); } while (0)
#define PG8_MMA(ai, bj, At, Bt) do { __builtin_amdgcn_s_setprio(1); _Pragma("unroll") for (int m = 0; m < 4; ++m) _Pragma("unroll") for (int n = 0; n < 2; ++n) _Pragma("unroll") for (int k = 0; k < 2; ++k) \
        acc[ai][bj][m][n] = __builtin_amdgcn_mfma_f32_16x16x32_bf16(Bt[n][k], At[m][k], acc[ai][bj][m][n], 0, 0, 0); __builtin_amdgcn_s_setprio(0); } while (0)
#define PG8_WAIT_V(n) asm volatile("s_waitcnt vmcnt(" #n ")" ::: "memory")
#define PG8_WAIT_L(n) asm volatile("s_waitcnt lgkmcnt(" #n ")" ::: "memory")
#define PG8_BAR __builtin_amdgcn_s_barrier()
#define PG8_SCHED __builtin_amdgcn_sched_barrier(0)
    Unit cur, nxt; int ui = 0;
    if (!S.next(0, cur)) return;
    f32x4 acc[2][2][4][2];
#pragma unroll
    for (int a = 0; a < 2; ++a)
#pragma unroll
        for (int b = 0; b < 2; ++b)
#pragma unroll
            for (int m = 0; m < 4; ++m)
#pragma unroll
                for (int n = 0; n < 2; ++n) acc[a][b][m][n] = (f32x4){0.f, 0.f, 0.f, 0.f};
    bf16x8 At[4][2], B0[2][2], B1[2][2];
    unsigned voffA[2][2], nvoffA[2][2];
    PG8_MKOFF(cur, voffA);
    const char* cA = cur.A; const char* cB = cur.B;
    if constexpr (SP2) {
        PG8_STAGE(PG8_SB(0, 0), cB, voffB); PG8_STAGE(PG8_SB(0, 1), cB + hstep, voffB); PG8_STAGE(PG8_SA(0, 0), cA, voffA[0]); PG8_STAGE(PG8_SA(0, 1), cA, voffA[1]);
        if (wr == 1) PG8_BAR;
        PG8_WAIT_V(2); PG8_BAR;
        PG8_STAGE(PG8_SB(1, 0), cB + kstep, voffB); PG8_STAGE(PG8_SA(1, 0), cA + kstep, voffA[0]); PG8_STAGE(PG8_SB(1, 1), cB + hstep + kstep, voffB);
        PG8_WAIT_V(6); PG8_BAR;
    } else {
        PG8_STAGE(PG8_SB(0, 0), cB, voffB); PG8_STAGE(PG8_SA(0, 0), cA, voffA[0]); PG8_STAGE(PG8_SB(0, 1), cB + hstep, voffB); PG8_STAGE(PG8_SA(0, 1), cA, voffA[1]);
        if (wr == 1) PG8_BAR;
        PG8_WAIT_V(4); PG8_BAR;
        PG8_STAGE(PG8_SB(1, 0), cB + kstep, voffB); PG8_STAGE(PG8_SA(1, 0), cA + kstep, voffA[0]); PG8_STAGE(PG8_SB(1, 1), cB + hstep + kstep, voffB);
        PG8_WAIT_V(6); PG8_BAR;
    }
    for (;;) {
        const bool has_next = S.next(ui + 1, nxt);
        if (has_next) { PG8_MKOFF(nxt, nvoffA); }
        else {
#pragma unroll
            for (int h = 0; h < 2; ++h)
#pragma unroll
                for (int i = 0; i < 2; ++i) nvoffA[h][i] = voffA[h][i]; }
        const char* nA = has_next ? nxt.A : cA; const char* nB = has_next ? nxt.B : cB;
        for (int t = 0; t < nt; t += 2) {
            const bool last = (t == nt - 2);
            const char* a1 = cA + (size_t)(t + 1) * kstep;
            const char* a2 = last ? nA : cA + (size_t)(t + 2) * kstep; const char* b2 = last ? nB : cB + (size_t)(t + 2) * kstep;
            const char* a3 = a2 + kstep; const char* b3 = b2 + kstep;
            unsigned v2[2][2];
#pragma unroll
            for (int h = 0; h < 2; ++h)
#pragma unroll
                for (int i = 0; i < 2; ++i) v2[h][i] = last ? nvoffA[h][i] : voffA[h][i];
            if constexpr (SP2) {
            PG8_LDB(B0, 0, 0); PG8_LDB(B1, 0, 1); PG8_SCHED; PG8_LDA(At, 0, 0); PG8_STAGE(PG8_SA(1, 1), a1, voffA[1]);
            PG8_WAIT_V(8); PG8_WAIT_L(0); PG8_BAR; PG8_MMA(0, 0, At, B0); PG8_MMA(0, 1, At, B1); PG8_BAR; PG8_SCHED;
            PG8_LDA(At, 0, 1); PG8_STAGE(PG8_SB(0, 0), b2, voffB); PG8_STAGE(PG8_SB(0, 1), b2 + hstep, voffB); PG8_STAGE(PG8_SA(0, 0), a2, v2[0]);
            PG8_WAIT_V(8); PG8_WAIT_L(0); PG8_BAR; PG8_MMA(1, 0, At, B0); PG8_MMA(1, 1, At, B1); PG8_BAR; PG8_SCHED;
            PG8_LDB(B0, 1, 0); PG8_LDB(B1, 1, 1); PG8_SCHED; PG8_LDA(At, 1, 0); PG8_STAGE(PG8_SA(0, 1), a2, v2[1]);
            PG8_WAIT_V(8); PG8_WAIT_L(0); PG8_BAR; PG8_MMA(0, 0, At, B0); PG8_MMA(0, 1, At, B1); PG8_BAR; PG8_SCHED;
            PG8_LDA(At, 1, 1); PG8_STAGE(PG8_SB(1, 0), b3, voffB); PG8_STAGE(PG8_SB(1, 1), b3 + hstep, voffB); PG8_STAGE(PG8_SA(1, 0), a3, v2[0]);
            PG8_WAIT_V(8); PG8_WAIT_L(0); PG8_BAR; PG8_MMA(1, 0, At, B0); PG8_MMA(1, 1, At, B1); PG8_BAR; PG8_SCHED;
            } else {
            PG8_LDB(B0, 0, 0); PG8_SCHED; PG8_LDA(At, 0, 0); PG8_STAGE(PG8_SA(1, 1), a1, voffA[1]);
            PG8_WAIT_L(8); PG8_BAR; PG8_WAIT_L(0); PG8_MMA(0, 0, At, B0); PG8_BAR; PG8_SCHED;
            PG8_LDB(B1, 0, 1); PG8_STAGE(PG8_SB(0, 0), b2, voffB);
            PG8_BAR; PG8_WAIT_L(0); PG8_MMA(0, 1, At, B1); PG8_BAR;
            PG8_LDA(At, 0, 1); PG8_STAGE(PG8_SA(0, 0), a2, v2[0]);
            PG8_BAR; PG8_WAIT_L(0); PG8_MMA(1, 0, At, B0); PG8_BAR; PG8_SCHED;
            PG8_STAGE(PG8_SB(0, 1), b2 + hstep, voffB);
            PG8_WAIT_V(6); PG8_BAR; PG8_MMA(1, 1, At, B1); PG8_BAR;
            PG8_LDB(B0, 1, 0); PG8_SCHED; PG8_LDA(At, 1, 0); PG8_STAGE(PG8_SA(0, 1), a2, v2[1]);
            PG8_WAIT_L(8); PG8_BAR; PG8_WAIT_L(0); PG8_MMA(0, 0, At, B0); PG8_BAR; PG8_SCHED;
            PG8_LDB(B1, 1, 1); PG8_STAGE(PG8_SB(1, 0), b3, voffB);
            PG8_BAR; PG8_WAIT_L(0); PG8_MMA(0, 1, At, B1); PG8_BAR;
            PG8_LDA(At, 1, 1); PG8_STAGE(PG8_SA(1, 0), a3, v2[0]);
            PG8_BAR; PG8_WAIT_L(0); PG8_MMA(1, 0, At, B0); PG8_BAR; PG8_SCHED;
            PG8_STAGE(PG8_SB(1, 1), b3 + hstep, voffB);
            PG8_WAIT_V(6); PG8_BAR; PG8_MMA(1, 1, At, B1); PG8_BAR;
            }
        }
        if constexpr (ALIGN_EPI) { if (wr == 0) PG8_BAR; }
        E(acc, cur, wr, wc, fr, fq);
        if (!has_next) break;
#pragma unroll
        for (int a = 0; a < 2; ++a)
#pragma unroll
            for (int b = 0; b < 2; ++b)
#pragma unroll
                for (int m = 0; m < 4; ++m)
#pragma unroll
                    for (int n = 0; n < 2; ++n) acc[a][b][m][n] = (f32x4){0.f, 0.f, 0.f, 0.f};
        cur = nxt; cA = nA; cB = nB; ++ui;
#pragma unroll
        for (int h = 0; h < 2; ++h)
#pragma unroll
            for (int i = 0; i < 2; ++i) voffA[h][i] = nvoffA[h][i];
        if constexpr (ALIGN_EPI) { if (wr == 1) PG8_BAR; }
    }
    PG8_WAIT_V(0);
    if constexpr (!ALIGN_EPI) { if (wr == 0) PG8_BAR; }
    PG8_BAR;
#undef PG8_MKOFF
#undef PG8_SA
#undef PG8_SB
#undef PG8_STAGE
#undef PG8_LDA
#undef PG8_LDB
#undef PG8_MMA
#undef PG8_WAIT_V
#undef PG8_WAIT_L
#undef PG8_BAR
#undef PG8_SCHED
}
__device__ __forceinline__ int xcd_remap(int L, int nwg) { const int q = nwg / 8, r = nwg % 8, xcd = L % 8, off = L / 8; return (xcd < r ? xcd * (q + 1) : r * (q + 1) + (xcd - r) * q) + off; }
}

constexpr int LDS_MM_OFF = 131072;

struct OrderInProj { int G, c; const char* H; const char* W;
    __device__ __forceinline__ bool next(int i, pg8::Unit& u) const {
        const int L = i * G + c; if (L >= 1792) return false;
        int pmg, pn;
        if (L < 1664) { const int wgid = pg8::xcd_remap(L, 1664); const int nig = 8 * 13, gid = wgid / nig, p = gid * 8 + ((wgid % nig) & 7); pn = (wgid % nig) >> 3; pmg = (p >> 3) * 9 + 1 + (p & 7); }
        else { const int idx = L - 1664, p = idx & 15, ci = idx >> 4; pmg = p * 9; pn = ci < 4 ? 2 + ci : (ci < 7 ? 3 + ci : 12); }
        u.A = H + (size_t)pmg * 256 * 2048; u.B = W + (size_t)pn * 256 * 2048; u.row0 = pmg * 256; u.col0 = pn * 256; u.ge = -1; u.gp = 0; return true; } };
struct OrderOutProj { int G, c; const char* A; const char* W;
    __device__ __forceinline__ bool next(int i, pg8::Unit& u) const {
        const int L = i * G + c; if (L >= 512) return false;
        const int wgid = pg8::xcd_remap(L, 512); const int nig = 8 * 4, gid = wgid / nig, pm = gid * 8 + ((wgid % nig) & 7), pn = (wgid % nig) >> 3;
        u.A = A + (size_t)pm * 256 * 2048; u.B = W + (size_t)pn * 256 * 2048; u.row0 = pm * 256; u.col0 = pn * 256; u.ge = -1; u.gp = 0; return true; } };
struct OrderGateUp { int G, c; const char* H2; const char* W; const LAS int* mm;
    __device__ __forceinline__ bool next(int i, pg8::Unit& u) const {
        const int nwg = mm[64] * 4, L = i * G + c; if (L >= nwg) return false;
        const int wgid = pg8::xcd_remap(L, nwg), tt = wgid >> 2, pn = wgid & 3, e = moe_tile_expert(mm, tt);
        u.A = H2; u.B = W + ((size_t)e * 1024 + pn * 256) * 2048; u.row0 = tt * 256; u.col0 = pn * 256; u.ge = e; u.gp = (tt - mm[32 + e]) * 256; return true; } };
struct OrderDown { int G, c; const char* HM; const char* W; const LAS int* mm;
    __device__ __forceinline__ bool next(int i, pg8::Unit& u) const {
        const int nwg = mm[64] * 4, L = i * G + c; if (L >= nwg) return false;
        const int wgid = pg8::xcd_remap(L, nwg), tt = wgid >> 2, pn = wgid & 3, e = moe_tile_expert(mm, tt);
        u.A = HM + (size_t)tt * 256 * 1024; u.B = W + ((size_t)e * 1024 + pn * 256) * 1024; u.row0 = tt * 256; u.col0 = pn * 256; u.ge = -1; u.gp = 0; return true; } };

__device__ __forceinline__ void ph_inproj(const Ctx& c, LAS unsigned char* lds) {
    pg8::Gemm g{1024, nullptr, nullptr}; OrderInProj S{(int)gridDim.x, (int)blockIdx.x, (const char*)(c.ws + WS_H), (const char*)(c.ws + WS_WIN_T)};
    pg8::Epi8<EpiInProj> E{EpiInProj{c.ws}};
    pg8::gemm_phase<pg8::Epi8<EpiInProj>, OrderInProj, false>(lds, g, S, E);
}
__device__ __forceinline__ void ph_outproj(const Ctx& c, LAS unsigned char* lds) {
    pg8::Gemm g{1024, nullptr, nullptr}; OrderOutProj S{(int)gridDim.x, (int)blockIdx.x, (const char*)(c.ws + WS_MIX), (const char*)(c.ws + WS_WOUT_T)};
    pg8::Epi8<EpiOutProj> E{EpiOutProj{c.x, (const float*)(c.ws + WS_MOD), (bf16*)(c.ws + WS_X1)}};
    pg8::gemm_phase<pg8::Epi8<EpiOutProj>, OrderOutProj, false>(lds, g, S, E);
}
__device__ __forceinline__ void ph_gateup(const Ctx& c, LAS unsigned char* lds) {
    LAS int* mm = (LAS int*)(lds + LDS_MM_OFF); moe_build(mm, (const unsigned*)(c.ws + WS_CTL));
    pg8::Gemm g{1024, (const int*)(c.ws + WS_LIST), mm}; OrderGateUp S{(int)gridDim.x, (int)blockIdx.x, (const char*)(c.ws + WS_H2), (const char*)(c.ws + WS_WGU_T), mm};
    pg8::Epi8<EpiGateUp> E{EpiGateUp{(bf16*)(c.ws + WS_HMID)}};
    pg8::gemm_phase<pg8::Epi8<EpiGateUp>, OrderGateUp, true>(lds, g, S, E);
}
__device__ __forceinline__ void ph_down(const Ctx& c, LAS unsigned char* lds) {
    LAS int* mm = (LAS int*)(lds + LDS_MM_OFF); moe_build(mm, (const unsigned*)(c.ws + WS_CTL));
    pg8::Gemm g{512, nullptr, mm}; OrderDown S{(int)gridDim.x, (int)blockIdx.x, (const char*)(c.ws + WS_HMID), (const char*)(c.ws + WS_WD_T), mm};
    pg8::Epi8<EpiDown> E{EpiDown{(bf16*)(c.ws + WS_YB)}};
    pg8::gemm_phase<pg8::Epi8<EpiDown>, OrderDown, false>(lds, g, S, E);
}

__device__ __forceinline__ float da_lambda_full(const float* lp) {
    float s0 = 0.f, s1 = 0.f;
    for (int i = 0; i < 64; ++i) { s0 += lp[i] * lp[64 + i]; s1 += lp[128 + i] * lp[192 + i]; }
    return expf(s0) - expf(s1) + LAMBDA_INIT;
}
namespace da {
typedef short bf16x8 __attribute__((ext_vector_type(8)));
typedef short s16x4 __attribute__((ext_vector_type(4)));
typedef float f32x16 __attribute__((ext_vector_type(16)));
typedef float f32x2_t __attribute__((ext_vector_type(2))); typedef __bf16 bf16x2_t __attribute__((ext_vector_type(2)));
__device__ __forceinline__ unsigned cvtpk(float lo, float hi) { f32x2_t v = {lo, hi}; bf16x2_t b = __builtin_convertvector(v, bf16x2_t); return __builtin_bit_cast(unsigned, b); }
__device__ __forceinline__ bf16x8 pack_half(const f32x16& x, int s) {
    u32x4 p; p.x = cvtpk(x[8 * s], x[8 * s + 1]); p.y = cvtpk(x[8 * s + 2], x[8 * s + 3]); p.z = cvtpk(x[8 * s + 4], x[8 * s + 5]); p.w = cvtpk(x[8 * s + 6], x[8 * s + 7]);
    return __builtin_bit_cast(bf16x8, p); }
__device__ __forceinline__ s16x4 vtr(const LAS unsigned char* p) { return __builtin_bit_cast(s16x4, __builtin_amdgcn_ds_read_tr16_b64_v4i16((LAS s16x4*)p)); }
#define DA_MFMA(a, b, c) __builtin_amdgcn_mfma_f32_32x32x16_bf16((a), (b), (c), 0, 0, 0)
constexpr int NT = KVL / 64;
constexpr int QS_OFF = 81920;

template <int KB> __device__ __forceinline__ void qk_tile(const LAS unsigned char* kq, const bf16x8 (&qf)[4], const f32x16& negm, f32x16& s0, f32x16& s1) {
#pragma unroll
    for (int ks = 0; ks < 4; ++ks) {
        const bf16x8 k0 = *(const LAS bf16x8*)(kq + KB + ks * 2048), k1 = *(const LAS bf16x8*)(kq + KB + ks * 2048 + 512), qq = qf[ks];
        if (ks == 0) { s0 = DA_MFMA(k0, qq, negm); s1 = DA_MFMA(k1, qq, negm); } else { s0 = DA_MFMA(k0, qq, s0); s1 = DA_MFMA(k1, qq, s1); } }
}
__device__ __forceinline__ float max3f(float a, float b, float c) { return fmaxf(fmaxf(a, b), c); }
template <int VB> __device__ __forceinline__ void softmax_pv(const LAS unsigned char* lds, int vlane, f32x16& s0, f32x16& s1, f32x16 (&O)[4], f32x16& negm, float& lrun) {
    float ma = max3f(s0[0], s0[1], s1[0]), mb = max3f(s0[2], s0[3], s1[1]); ma = max3f(ma, s1[2], s1[3]);
#pragma unroll
    for (int r = 4; r < 16; r += 4) { ma = max3f(ma, s0[r], s0[r + 1]); mb = max3f(mb, s0[r + 2], s0[r + 3]); ma = max3f(ma, s1[r], s1[r + 1]); mb = max3f(mb, s1[r + 2], s1[r + 3]); }
    float mx = fmaxf(ma, mb);
    mx = fmaxf(mx, __shfl_xor(mx, 32));
    if (__any(mx > 8.0f)) {
        const float dl = fmaxf(mx, 0.f), alpha = __builtin_amdgcn_exp2f(-dl);
        lrun *= alpha;
#pragma unroll
        for (int r = 0; r < 16; ++r) { s0[r] -= dl; s1[r] -= dl; negm[r] -= dl; }
#pragma unroll
        for (int dt = 0; dt < 4; ++dt)
#pragma unroll
            for (int r = 0; r < 16; ++r) O[dt][r] *= alpha;
    }
    float ps = 0.f;
#pragma unroll
    for (int r = 0; r < 16; ++r) { s0[r] = __builtin_amdgcn_exp2f(s0[r]); s1[r] = __builtin_amdgcn_exp2f(s1[r]); ps += s0[r] + s1[r]; }
    lrun += ps;
    bf16x8 P[4];
    P[0] = pack_half(s0, 0); P[1] = pack_half(s0, 1); P[2] = pack_half(s1, 0); P[3] = pack_half(s1, 1);
    const unsigned vb = (unsigned)(size_t)(lds + VB + vlane);
    s16x4 fa[8], fb[8];
#define DA_VRD(dst, dt) do { _Pragma("unroll") for (int _k = 0; _k < 4; ++_k) { \
        asm volatile("ds_read_b64_tr_b16 %0, %1 offset:%2" : "=&v"(dst[2 * _k]) : "v"(vb), "n"(((dt) * 4 + _k) * 1024) : "memory"); \
        asm volatile("ds_read_b64_tr_b16 %0, %1 offset:%2" : "=&v"(dst[2 * _k + 1]) : "v"(vb), "n"(((dt) * 4 + _k) * 1024 + 512) : "memory"); } } while (0)
#define DA_VWAIT(N, f) asm volatile("s_waitcnt lgkmcnt(" #N ")" : "+v"(f[0]), "+v"(f[1]), "+v"(f[2]), "+v"(f[3]), "+v"(f[4]), "+v"(f[5]), "+v"(f[6]), "+v"(f[7]) :: "memory")
#define DA_PVM(f, dt) do { _Pragma("unroll") for (int _k = 0; _k < 4; ++_k) O[dt] = DA_MFMA(__builtin_shufflevector(f[2 * _k], f[2 * _k + 1], 0, 1, 2, 3, 4, 5, 6, 7), P[_k], O[dt]); } while (0)
    DA_VRD(fa, 0);
    DA_VRD(fb, 1); DA_VWAIT(8, fa); DA_PVM(fa, 0);
    DA_VRD(fa, 2); DA_VWAIT(8, fb); DA_PVM(fb, 1);
    DA_VRD(fb, 3); DA_VWAIT(8, fa); DA_PVM(fa, 2);
    DA_VWAIT(0, fb); DA_PVM(fb, 3);
#undef DA_VRD
#undef DA_VWAIT
#undef DA_PVM
}

template <int m> __device__ __forceinline__ void attn_body(const Ctx& c, LAS unsigned char* lds) {
    const int tid = threadIdx.x, lane = tid & 63, wid = __builtin_amdgcn_readfirstlane(tid >> 6), r32 = lane & 31, hi = lane >> 5;
    const int qsub = wid & 3;
    const bf16* Q = (const bf16*)(c.ws + WS_QDA); const bf16* K = (const bf16*)(c.ws + WS_KDA); const bf16* V = (const bf16*)(c.ws + WS_VDA); bf16* MIX = (bf16*)(c.ws + WS_MIX);
    const float lam = da_lambda_full(c.da_lambda);
    const int vlane = (4 * hi + ((lane & 15) >> 2)) * 64 + ((lane >> 4) & 1) * 32 + (lane & 3) * 8;
    const LAS unsigned char* kq = lds + (m * 8 + hi) * 1024 + r32 * 16;
    const unsigned kgo0 = (unsigned)(lane * 512 + (wid * 2) * 8) * 2u, kgo1 = kgo0 + 16u;
    const unsigned vgo0 = (unsigned)((((wid * 2) & 3) * 16 + (lane >> 2)) * 512 + ((wid * 2) >> 2) * 32 + (lane & 3) * 8) * 2u, vgo1 = vgo0 + 16u * 512u * 2u;
    for (int it = 0;; ++it) {
        const int L = it * (int)gridDim.x + (int)blockIdx.x; if (L >= 1024) break;
        const int wg = pg8::xcd_remap(L, 1024), bh = wg >> 4, qb = wg & 15, b = bh >> 2, h = bh & 3;
        const char* Kb = (const char*)(K + (size_t)b * KVL * 512 + h * 128); const char* Vb = (const char*)(V + (size_t)b * KVL * 512 + h * 128);
        const size_t qrow = (size_t)b * SEQ + qb * 128 + qsub * 32 + r32;
#define DA_DMA_K(t, bo) do { const size_t _to = (size_t)(t) * (64 * 512 * 2); \
            __builtin_amdgcn_global_load_lds((const unsigned*)(Kb + _to + kgo0), (LAS unsigned*)(lds + (bo) + (wid * 2) * 1024), 16, 0, 0); \
            __builtin_amdgcn_global_load_lds((const unsigned*)(Kb + _to + kgo1), (LAS unsigned*)(lds + (bo) + (wid * 2 + 1) * 1024), 16, 0, 0); } while (0)
#define DA_DMA_V(t, bo) do { const size_t _to = (size_t)(t) * (64 * 512 * 2); \
            __builtin_amdgcn_global_load_lds((const unsigned*)(Vb + _to + vgo0), (LAS unsigned*)(lds + (bo) + (wid * 2) * 1024), 16, 0, 0); \
            __builtin_amdgcn_global_load_lds((const unsigned*)(Vb + _to + vgo1), (LAS unsigned*)(lds + (bo) + (wid * 2 + 1) * 1024), 16, 0, 0); } while (0)
        DA_DMA_K(0, 0); DA_DMA_K(1, 16384); DA_DMA_K(2, 32768); DA_DMA_V(0, 65536); DA_DMA_V(1, 81920);
        bf16x8 qf[4];
#pragma unroll
        for (int ks = 0; ks < 4; ++ks) qf[ks] = *(const bf16x8*)(Q + qrow * 512 + h * 128 + m * 64 + ks * 16 + hi * 8);
        f32x16 O[4];
#pragma unroll
        for (int dt = 0; dt < 4; ++dt)
#pragma unroll
            for (int r = 0; r < 16; ++r) O[dt][r] = 0.f;
        float lrun = 0.f; f32x16 negm, s0, s1;
#pragma unroll
        for (int r = 0; r < 16; ++r) negm[r] = 0.f;
        asm volatile("s_waitcnt vmcnt(0) lgkmcnt(0)\n\ts_barrier" ::: "memory");
        if constexpr (m == 1) qk_tile<0>(kq, qf, negm, s0, s1);
#define DA_STEP(tt, KBC, KBN, KB3, VBC, VB2) do { \
            if ((tt) + 3 < NT) DA_DMA_K((tt) + 3, KB3); else DA_DMA_K(NT - 1, KB3); \
            if ((tt) + 2 < NT) DA_DMA_V((tt) + 2, VB2); else DA_DMA_V(NT - 1, VB2); \
            if constexpr (m == 0) { qk_tile<KBC>(kq, qf, negm, s0, s1); softmax_pv<VBC>(lds, vlane, s0, s1, O, negm, lrun); } \
            else { softmax_pv<VBC>(lds, vlane, s0, s1, O, negm, lrun); if ((tt) + 1 < NT) qk_tile<KBN>(kq, qf, negm, s0, s1); } \
            asm volatile("s_waitcnt vmcnt(4) lgkmcnt(0)\n\ts_barrier" ::: "memory"); } while (0)
        for (int t = 0; t < NT; t += 12) {
            DA_STEP(t + 0, 0, 16384, 49152, 65536, 98304);
            DA_STEP(t + 1, 16384, 32768, 0, 81920, 65536);
            DA_STEP(t + 2, 32768, 49152, 16384, 98304, 81920);
            DA_STEP(t + 3, 49152, 0, 32768, 65536, 98304);
            DA_STEP(t + 4, 0, 16384, 49152, 81920, 65536);
            DA_STEP(t + 5, 16384, 32768, 0, 98304, 81920);
            DA_STEP(t + 6, 32768, 49152, 16384, 65536, 98304);
            DA_STEP(t + 7, 49152, 0, 32768, 81920, 65536);
            DA_STEP(t + 8, 0, 16384, 49152, 98304, 81920);
            DA_STEP(t + 9, 16384, 32768, 0, 65536, 98304);
            DA_STEP(t + 10, 32768, 49152, 16384, 81920, 65536);
            DA_STEP(t + 11, 49152, 0, 32768, 98304, 81920);
        }
#undef DA_STEP
        asm volatile("s_waitcnt vmcnt(0) lgkmcnt(0)\n\ts_barrier" ::: "memory");
        const float lt = lrun + __shfl_xor(lrun, 32);
        LAS float* xch = (LAS float*)(lds + qsub * 16384) + lane;
        if (m == 1) { const float sc = lam / lt;
#pragma unroll
            for (int dt = 0; dt < 4; ++dt)
#pragma unroll
                for (int r = 0; r < 16; ++r) xch[(dt * 16 + r) * 64] = O[dt][r] * sc; }
        __syncthreads();
        if (m == 0) { const float i1 = 1.0f / lt; float ss = 0.f;
#pragma unroll
            for (int dt = 0; dt < 4; ++dt)
#pragma unroll
                for (int r = 0; r < 16; ++r) { const float a = O[dt][r] * i1 - xch[(dt * 16 + r) * 64]; O[dt][r] = a; ss += a * a; }
            ss += __shfl_xor(ss, 32);
            const float rstd = rsqrtf(ss * (1.0f / 128.0f) + NORM_EPS) * (1.0f - LAMBDA_INIT);
            bf16* orow = MIX + qrow * 1024 + h * 128;
#pragma unroll
            for (int dt = 0; dt < 4; ++dt)
#pragma unroll
                for (int g4 = 0; g4 < 4; ++g4) { const int d0 = 32 * dt + 8 * g4 + 4 * hi; const f32x4 gg = *(const f32x4*)(c.da_subln_g + d0);
                    u32x2 w; w.x = cvtpk(O[dt][4 * g4] * rstd * gg.x, O[dt][4 * g4 + 1] * rstd * gg.y); w.y = cvtpk(O[dt][4 * g4 + 2] * rstd * gg.z, O[dt][4 * g4 + 3] * rstd * gg.w);
                    *(u32x2*)(orow + d0) = w; } }
        __syncthreads();
#undef DA_DMA_K
#undef DA_DMA_V
    }
}
__device__ __forceinline__ void attn_phase(const Ctx& c, LAS unsigned char* lds) {
    if (__builtin_amdgcn_readfirstlane((int)threadIdx.x >> 8) == 0) attn_body<0>(c, lds); else attn_body<1>(c, lds);
}
#undef DA_MFMA
}

namespace gla {
using da::bf16x8; using da::s16x4; using da::f32x16; using da::cvtpk; using da::pack_half; using da::vtr;
#define GL_MFMA(a, b, c) __builtin_amdgcn_mfma_f32_32x32x16_bf16((a), (b), (c), 0, 0, 0)
constexpr int NTASK = NB * 4 * 2 * 36;
constexpr int PT64_BYTES = 8192;
constexpr int PTV_BYTES = 16384;

template <int CTRL, int RM, bool BC> __device__ __forceinline__ float dpp_get(float x) { return __builtin_bit_cast(float, __builtin_amdgcn_update_dpp(0, __builtin_bit_cast(int, x), CTRL, RM, 0xf, BC)); }
__device__ __forceinline__ float scan32(float x) {
    x += dpp_get<0x111, 0xf, true>(x); x += dpp_get<0x112, 0xf, true>(x); x += dpp_get<0x114, 0xf, true>(x); x += dpp_get<0x118, 0xf, true>(x);
    x += dpp_get<0x142, 0xa, false>(x);
    return x; }
__device__ __forceinline__ float last32(float x, int hi) {
    const float a = __builtin_bit_cast(float, __builtin_amdgcn_readlane(__builtin_bit_cast(int, x), 31)), b = __builtin_bit_cast(float, __builtin_amdgcn_readlane(__builtin_bit_cast(int, x), 63));
    return hi ? b : a; }
__device__ __forceinline__ void g0_phase(const Ctx& c, LAS unsigned char* lds) {
    const int tid = threadIdx.x, lane = tid & 63, w = __builtin_amdgcn_readfirstlane(tid >> 6), r32 = lane & 31, hi = lane >> 5;
    bf16* KE = (bf16*)(c.ws + WS_KEND); bf16* QD = (bf16*)(c.ws + WS_QD); bf16* KI = (bf16*)(c.ws + WS_KI); float* DB = (float*)(c.ws + WS_DB);
    LAS unsigned char* w2f = lds;
    LAS float* gbs = (LAS float*)(lds + 32768);
    for (int q = tid; q < 16 * 64; q += 512) { const int combo = q >> 6, l = q & 63, dir = combo >> 3, h = (combo >> 1) & 3, Dk = combo & 1, dk = h * 64 + 32 * Dk + (l & 31), hh = l >> 5;
        float v[8];
#pragma unroll
        for (int j = 0; j < 8; ++j) v[j] = c.gate_w2[(dir * 16 + 8 * hh + j) * 256 + dk];
        u32x4 ph; ph.x = pk2(v[0], v[1]); ph.y = pk2(v[2], v[3]); ph.z = pk2(v[4], v[5]); ph.w = pk2(v[6], v[7]);
        u32x4 pl; pl.x = pk2(v[0] - bflo(ph.x), v[1] - bfhi(ph.x)); pl.y = pk2(v[2] - bflo(ph.y), v[3] - bfhi(ph.y)); pl.z = pk2(v[4] - bflo(ph.z), v[5] - bfhi(ph.z)); pl.w = pk2(v[6] - bflo(ph.w), v[7] - bfhi(ph.w));
        *(LAS u32x4*)(w2f + q * 32) = ph; *(LAS u32x4*)(w2f + q * 32 + 16) = pl; }
    if (tid < 128) *(LAS f32x4*)(gbs + 4 * tid) = *(const f32x4*)(c.gate_b + 4 * tid);
    __syncthreads();
    for (int u = blockIdx.x * 8 + w; u < NTASK; u += gridDim.x * 8) {
        const int cc = u % 36, chain = u / 36, dir = chain & 1, h = (chain >> 1) & 3, b = chain >> 3, bh = chain >> 1;
        const bool lat = cc >= 4;
        const size_t row0 = (size_t)b * KVL + cc * 64 + r32;
        bf16x8 lrh[2], lrl[2];
#pragma unroll
        for (int T = 0; T < 2; ++T) { const float* lr = (const float*)(c.ws + WS_LR) + (row0 + 32 * T) * 32 + dir * 16 + 8 * hi;
            const f32x4 x0 = *(const f32x4*)lr, x1 = *(const f32x4*)(lr + 4);
            u32x4 ph; ph.x = pk2(x0.x, x0.y); ph.y = pk2(x0.z, x0.w); ph.z = pk2(x1.x, x1.y); ph.w = pk2(x1.z, x1.w);
            u32x4 pl; pl.x = pk2(x0.x - bflo(ph.x), x0.y - bfhi(ph.x)); pl.y = pk2(x0.z - bflo(ph.y), x0.w - bfhi(ph.y)); pl.z = pk2(x1.x - bflo(ph.z), x1.y - bfhi(ph.z)); pl.w = pk2(x1.z - bflo(ph.w), x1.w - bfhi(ph.w));
            lrh[T] = __builtin_bit_cast(bf16x8, ph); lrl[T] = __builtin_bit_cast(bf16x8, pl); }
        const bf16* kbase = (const bf16*)(c.ws + WS_GK) + row0 * 256 + h * 64;
        const bf16* qbase = (const bf16*)(c.ws + WS_GQ) + ((size_t)b * SEQ + (lat ? (cc - 4) * 64 + r32 : 0)) * 256 + h * 64;
        bf16* kebase = KE + ((size_t)u * 64 + r32) * 64;
        const size_t qo = (((size_t)(dir * 64 + bh) * 32 + (lat ? cc - 4 : 0)) * 64 + r32) * 64;
#pragma unroll 1
        for (int Dk = 0; Dk < 2; ++Dk) {
            const LAS unsigned char* wf = w2f + (((dir * 4 + h) * 2 + Dk) * 64 + lane) * 32;
            const bf16x8 wh = *(const LAS bf16x8*)wf, wl = *(const LAS bf16x8*)(wf + 16);
            f32x16 z[2];
#pragma unroll
            for (int T = 0; T < 2; ++T) {
#pragma unroll
                for (int r = 0; r < 16; ++r) z[T][r] = 0.f;
                z[T] = GL_MFMA(wh, lrh[T], z[T]); z[T] = GL_MFMA(wl, lrh[T], z[T]); z[T] = GL_MFMA(wh, lrl[T], z[T]); }
            u32x2 kv[2][4], qv[2][4];
#pragma unroll
            for (int T = 0; T < 2; ++T)
#pragma unroll
                for (int g4 = 0; g4 < 4; ++g4) { const int dko = 32 * Dk + 8 * g4 + 4 * hi; kv[T][g4] = *(const u32x2*)(kbase + (size_t)(32 * T) * 256 + dko); qv[T][g4] = *(const u32x2*)(qbase + (size_t)(lat ? 32 * T : 0) * 256 + dko); }
            float g[2][16], inc[2][16], dtot[16], tot[16];
#pragma unroll
            for (int g4 = 0; g4 < 4; ++g4) { const f32x4 bs = *(const LAS f32x4*)(gbs + dir * 256 + h * 64 + 32 * Dk + 8 * g4 + 4 * hi);
#pragma unroll
                for (int j = 0; j < 4; ++j)
#pragma unroll
                    for (int T = 0; T < 2; ++T) { const float zz = z[T][4 * g4 + j] + bs[j];
                        const float t = __builtin_amdgcn_exp2f(-fabsf(zz) * 1.4426950408889634f);
                        g[T][4 * g4 + j] = (fminf(zz, 0.f) - __builtin_amdgcn_logf(1.0f + t) * 0.6931471805599453f) * (1.0f / 16.0f); } }
#pragma unroll
            for (int r = 0; r < 16; ++r) { inc[0][r] = scan32(g[0][r]); const float l0 = last32(inc[0][r], hi); inc[1][r] = scan32(g[1][r]) + l0; tot[r] = last32(inc[1][r], hi); dtot[r] = __builtin_amdgcn_exp2f(tot[r] * 1.4426950408889634f); }
#pragma unroll
            for (int T = 0; T < 2; ++T)
#pragma unroll
                for (int g4 = 0; g4 < 4; ++g4) { const int dko = 32 * Dk + 8 * g4 + 4 * hi;
                    float eq[4], ek[4], ee[4];
#pragma unroll
                    for (int j = 0; j < 4; ++j) { const int r = 4 * g4 + j; const float bc = dir == 0 ? inc[T][r] : tot[r] - inc[T][r] + g[T][r];
                        eq[j] = __builtin_amdgcn_exp2f(bc * 1.4426950408889634f); ek[j] = __builtin_amdgcn_rcpf(eq[j]); ee[j] = ek[j] * dtot[r]; }
                    const float k0 = bflo(kv[T][g4].x), k1 = bfhi(kv[T][g4].x), k2 = bflo(kv[T][g4].y), k3 = bfhi(kv[T][g4].y);
                    u32x2 e2; e2.x = cvtpk(k0 * ee[0], k1 * ee[1]); e2.y = cvtpk(k2 * ee[2], k3 * ee[3]);
                    *(u32x2*)(kebase + (size_t)(32 * T) * 64 + dko) = e2;
                    if (lat) { const float q0 = bflo(qv[T][g4].x), q1 = bfhi(qv[T][g4].x), q2 = bflo(qv[T][g4].y), q3 = bfhi(qv[T][g4].y);
                        u32x2 a2, k2v; a2.x = cvtpk(q0 * eq[0], q1 * eq[1]); a2.y = cvtpk(q2 * eq[2], q3 * eq[3]); k2v.x = cvtpk(k0 * ek[0], k1 * ek[1]); k2v.y = cvtpk(k2 * ek[2], k3 * ek[3]);
                        *(u32x2*)(QD + qo + (size_t)(32 * T) * 64 + dko) = a2; *(u32x2*)(KI + qo + (size_t)(32 * T) * 64 + dko) = k2v; } }
            if (r32 == 0) {
#pragma unroll
                for (int g4 = 0; g4 < 4; ++g4) *(f32x4*)(DB + (size_t)u * 64 + 32 * Dk + 8 * g4 + 4 * hi) = (f32x4){dtot[4 * g4], dtot[4 * g4 + 1], dtot[4 * g4 + 2], dtot[4 * g4 + 3]}; }
        }
    }
    __syncthreads();
}
__device__ __forceinline__ void dma_piece(const bf16* base, int pitch, int p, LAS unsigned char* dst, int lane) {
    __builtin_amdgcn_global_load_lds((const unsigned*)(base + (size_t)((p & 3) * 16 + (lane >> 2)) * pitch + (p >> 2) * 32 + (lane & 3) * 8), (LAS unsigned*)(dst + p * 1024), 16, 0, 0);
}
__device__ __forceinline__ void dma_chunk(const bf16* tile, int row0, int ch, LAS unsigned char* dst, int lane) {
    __builtin_amdgcn_global_load_lds((const unsigned*)(tile + (size_t)(row0 + lane) * 64 + ch * 8), (LAS unsigned*)dst, 16, 0, 0);
}
__device__ __forceinline__ void g1_phase(const Ctx& c, LAS unsigned char* lds) {
    const int tid = threadIdx.x, lane = tid & 63, w = __builtin_amdgcn_readfirstlane(tid >> 6), hi = lane >> 5, dir = w >> 2, dvt = w & 3;
    const int vlane = (4 * hi + ((lane & 15) >> 2)) * 64 + ((lane >> 4) & 1) * 32 + (lane & 3) * 8;
    const bf16* KE = (const bf16*)(c.ws + WS_KEND); const bf16* GV = (const bf16*)(c.ws + WS_GV); bf16* UT = (bf16*)(c.ws + WS_UT);
    constexpr int BUF = 32768;
    const int nun = NB * 4 * 36;
#define G1_STAGE(un, bo) do { const int _cc = (un) % 36, _bh = (un) / 36, _b = _bh >> 2, _h = _bh & 3; \
        dma_piece(GV + ((size_t)_b * KVL + _cc * 64) * 512 + _h * 128, 512, w * 2, lds + (bo), lane); dma_piece(GV + ((size_t)_b * KVL + _cc * 64) * 512 + _h * 128, 512, w * 2 + 1, lds + (bo), lane); \
        dma_piece(KE + ((size_t)(_bh * 2) * 36 + _cc) * 4096, 64, w, lds + (bo) + 16384, lane); dma_piece(KE + ((size_t)(_bh * 2 + 1) * 36 + _cc) * 4096, 64, w, lds + (bo) + 24576, lane); } while (0)
    int un = blockIdx.x, par = 0;
    if (un < nun) G1_STAGE(un, 0);
    asm volatile("s_waitcnt vmcnt(0)" ::: "memory"); __syncthreads();
    for (; un < nun; un += gridDim.x, par ^= 1) {
        const int bo = par * BUF, nx = un + (int)gridDim.x;
        if (nx < nun) G1_STAGE(nx, BUF - bo);
        const int cc = un % 36, bh = un / 36;
        const LAS unsigned char* vpt = lds + bo; const LAS unsigned char* kend = lds + bo + 16384 + dir * 8192;
        f32x16 U[2];
#pragma unroll
        for (int dkt = 0; dkt < 2; ++dkt)
#pragma unroll
            for (int r = 0; r < 16; ++r) U[dkt][r] = 0.f;
#pragma unroll
        for (int ks = 0; ks < 4; ++ks) {
            const LAS unsigned char* bp = vpt + (dvt * 4 + ks) * 1024 + vlane; const s16x4 b0 = vtr(bp), b1 = vtr(bp + 512);
            const bf16x8 bfr = __builtin_shufflevector(b0, b1, 0, 1, 2, 3, 4, 5, 6, 7);
#pragma unroll
            for (int dkt = 0; dkt < 2; ++dkt) { const LAS unsigned char* ap = kend + (dkt * 4 + ks) * 1024 + vlane; const s16x4 a0 = vtr(ap), a1 = vtr(ap + 512);
                U[dkt] = GL_MFMA(__builtin_shufflevector(a0, a1, 0, 1, 2, 3, 4, 5, 6, 7), bfr, U[dkt]); } }
        const size_t task = ((size_t)(bh * 2 + dir)) * 36 + cc;
#pragma unroll
        for (int dkt = 0; dkt < 2; ++dkt) { bf16* up = UT + task * 8192 + (size_t)(dvt * 32 + (lane & 31)) * 64 + dkt * 32 + 4 * hi;
#pragma unroll
            for (int g4 = 0; g4 < 4; ++g4) { u32x2 wv; wv.x = cvtpk(U[dkt][4 * g4], U[dkt][4 * g4 + 1]); wv.y = cvtpk(U[dkt][4 * g4 + 2], U[dkt][4 * g4 + 3]); *(u32x2*)(up + 8 * g4) = wv; } }
        asm volatile("s_waitcnt vmcnt(0)" ::: "memory"); __syncthreads();
    }
#undef G1_STAGE
}
__device__ __forceinline__ void g2_phase(const Ctx& c) {
    const bf16* UT = (const bf16*)(c.ws + WS_UT); const float* DB = (const float*)(c.ws + WS_DB); bf16* ST = (bf16*)(c.ws + WS_ST);
    for (int i = blockIdx.x * blockDim.x + threadIdx.x; i < 128 * 1024; i += gridDim.x * blockDim.x) {
        const int chain = i >> 10, e8 = i & 1023, dk0 = (e8 & 7) * 8, dir = chain & 1, bh = chain >> 1;
        float S[8];
#pragma unroll
        for (int j = 0; j < 8; ++j) S[j] = 0.f;
#pragma unroll 4
        for (int s = 0; s < 36; ++s) {
            const int cc = dir == 0 ? s : (s < 4 ? 3 - s : 39 - s);
            if (cc >= 4) { u32x4 o; o.x = cvtpk(S[0], S[1]); o.y = cvtpk(S[2], S[3]); o.z = cvtpk(S[4], S[5]); o.w = cvtpk(S[6], S[7]);
                *(u32x4*)(ST + ((size_t)(dir * 64 + bh) * 32 + (cc - 4)) * 8192 + (size_t)e8 * 8) = o; }
            const size_t u = (size_t)chain * 36 + cc;
            const u32x4 uw = *(const u32x4*)(UT + u * 8192 + (size_t)e8 * 8); const f32x4 d0 = *(const f32x4*)(DB + u * 64 + dk0), d1 = *(const f32x4*)(DB + u * 64 + dk0 + 4);
            S[0] = S[0] * d0.x + bflo(uw.x); S[1] = S[1] * d0.y + bfhi(uw.x); S[2] = S[2] * d0.z + bflo(uw.y); S[3] = S[3] * d0.w + bfhi(uw.y);
            S[4] = S[4] * d1.x + bflo(uw.z); S[5] = S[5] * d1.y + bfhi(uw.z); S[6] = S[6] * d1.z + bflo(uw.w); S[7] = S[7] * d1.w + bfhi(uw.w);
        }
    }
}
__device__ __forceinline__ void g3_phase(const Ctx& c, LAS unsigned char* lds) {
    const int tid = threadIdx.x, lane = tid & 63, w = __builtin_amdgcn_readfirstlane(tid >> 6), r32 = lane & 31, hi = lane >> 5, ih = w >> 2, dq = w & 3;
    const int vlane = (4 * hi + ((lane & 15) >> 2)) * 64 + ((lane >> 4) & 1) * 32 + (lane & 3) * 8;
    const bf16* ST = (const bf16*)(c.ws + WS_ST); const bf16* GR = (const bf16*)(c.ws + WS_GR); const bf16* GV = (const bf16*)(c.ws + WS_GV); bf16* MIX = (bf16*)(c.ws + WS_MIX);
    const bf16* QD = (const bf16*)(c.ws + WS_QD); const bf16* KI = (const bf16*)(c.ws + WS_KI);
    constexpr int BUF = 49152;
    LAS float* ssx = (LAS float*)(lds + 2 * BUF);
    const int nun = NB * 4 * 32;
#define G3_STAGE(un, bo) do { const int _cl = (un) & 31, _bh = (un) >> 5, _b = _bh >> 2, _h = _bh & 3; \
        dma_piece(GV + ((size_t)_b * KVL + (_cl + 4) * 64) * 512 + _h * 128, 512, w * 2, lds + (bo), lane); dma_piece(GV + ((size_t)_b * KVL + (_cl + 4) * 64) * 512 + _h * 128, 512, w * 2 + 1, lds + (bo), lane); \
        _Pragma("unroll") for (int _d = 0; _d < 2; ++_d) { const size_t _tb = ((size_t)(_d * 64 + _bh) * 32 + _cl) * 4096; \
            dma_chunk(QD + _tb, 0, w, lds + (bo) + 16384 + _d * 8192 + w * 1024, lane); dma_chunk(KI + _tb, 0, w, lds + (bo) + 32768 + _d * 8192 + w * 1024, lane); } } while (0)
    int un = blockIdx.x, par = 0;
    if (un < nun) G3_STAGE(un, 0);
    asm volatile("s_waitcnt vmcnt(0)" ::: "memory"); __syncthreads();
    for (; un < nun; un += gridDim.x, par ^= 1) {
        const int bo = par * BUF, nx = un + (int)gridDim.x;
        if (nx < nun) G3_STAGE(nx, BUF - bo);
        const int cl = un & 31, bh = un >> 5, b = bh >> 2, h = bh & 3;
        const size_t tl = (size_t)b * SEQ + cl * 64 + ih * 32 + r32;
        bf16x8 sa[2][4];
#pragma unroll
        for (int dir = 0; dir < 2; ++dir)
#pragma unroll
            for (int ks = 0; ks < 4; ++ks) sa[dir][ks] = *(const bf16x8*)(ST + ((size_t)(dir * 64 + bh) * 32 + cl) * 8192 + (size_t)(dq * 32 + r32) * 64 + ks * 16 + hi * 8);
        u32x2 gr[4];
#pragma unroll
        for (int g4 = 0; g4 < 4; ++g4) gr[g4] = *(const u32x2*)(GR + tl * 512 + h * 128 + dq * 32 + 8 * g4 + 4 * hi);
        const LAS unsigned char* vpt = lds + bo; const LAS unsigned char* qimg = lds + bo + 16384; const LAS unsigned char* kimg = lds + bo + 32768;
        f32x16 At[2];
#pragma unroll
        for (int jt = 0; jt < 2; ++jt)
#pragma unroll
            for (int r = 0; r < 16; ++r) At[jt][r] = 0.f;
        bf16x8 qf[2][4];
#pragma unroll
        for (int dir = 0; dir < 2; ++dir) {
#pragma unroll
            for (int ks = 0; ks < 4; ++ks) qf[dir][ks] = *(const LAS bf16x8*)(qimg + dir * 8192 + (2 * ks + hi) * 1024 + (ih * 32 + r32) * 16);
#pragma unroll
            for (int jt = 0; jt < 2; ++jt) { f32x16 T;
#pragma unroll
                for (int r = 0; r < 16; ++r) T[r] = 0.f;
#pragma unroll
                for (int ks = 0; ks < 4; ++ks) { const bf16x8 a = *(const LAS bf16x8*)(kimg + dir * 8192 + (2 * ks + hi) * 1024 + (jt * 32 + r32) * 16); T = GL_MFMA(a, qf[dir][ks], T); }
                const int icol = ih * 32 + r32;
#pragma unroll
                for (int r = 0; r < 16; ++r) { const int j = jt * 32 + (r & 3) + 8 * (r >> 2) + 4 * hi; const bool keep = dir == 0 ? (j <= icol) : (j >= icol); At[jt][r] += keep ? T[r] : 0.f; } }
        }
        bf16x8 P[4];
        P[0] = pack_half(At[0], 0); P[1] = pack_half(At[0], 1); P[2] = pack_half(At[1], 0); P[3] = pack_half(At[1], 1);
        f32x16 O;
#pragma unroll
        for (int r = 0; r < 16; ++r) O[r] = 0.f;
#pragma unroll
        for (int ks = 0; ks < 4; ++ks) { const LAS unsigned char* vp = vpt + (dq * 4 + ks) * 1024 + vlane; const s16x4 lo = vtr(vp), hh = vtr(vp + 512);
            O = GL_MFMA(__builtin_shufflevector(lo, hh, 0, 1, 2, 3, 4, 5, 6, 7), P[ks], O); }
#pragma unroll
        for (int dir = 0; dir < 2; ++dir)
#pragma unroll
            for (int ks = 0; ks < 4; ++ks) O = GL_MFMA(sa[dir][ks], qf[dir][ks], O);
        float ss = 0.f;
#pragma unroll
        for (int r = 0; r < 16; ++r) ss += O[r] * O[r];
        ss += __shfl_xor(ss, 32);
        if (hi == 0) ssx[dq * 64 + ih * 32 + r32] = ss;
        __syncthreads();
        const int tokl = ih * 32 + r32; const float tot = ssx[tokl] + ssx[64 + tokl] + ssx[128 + tokl] + ssx[192 + tokl];
        const float rstd = rsqrtf(tot * (1.0f / 128.0f) + NORM_EPS);
#pragma unroll
        for (int g4 = 0; g4 < 4; ++g4) { const int dv = dq * 32 + 8 * g4 + 4 * hi; const f32x4 gn = *(const f32x4*)(c.gla_norm_g + dv);
            u32x2 wv; wv.x = cvtpk(O[4 * g4] * rstd * gn.x * silu_f(bflo(gr[g4].x)), O[4 * g4 + 1] * rstd * gn.y * silu_f(bfhi(gr[g4].x)));
            wv.y = cvtpk(O[4 * g4 + 2] * rstd * gn.z * silu_f(bflo(gr[g4].y)), O[4 * g4 + 3] * rstd * gn.w * silu_f(bfhi(gr[g4].y)));
            *(u32x2*)(MIX + tl * 1024 + 512 + h * 128 + dv) = wv; }
        asm volatile("s_waitcnt vmcnt(0)" ::: "memory"); __syncthreads();
    }
#undef G3_STAGE
}
#undef GL_MFMA
}

template <bool DRY> __device__ __forceinline__ void ph_router(const Ctx& c, LAS unsigned char* lds) {
    typedef short bf16x8 __attribute__((ext_vector_type(8)));
    const int tid = threadIdx.x, lane = tid & 63, wave = tid >> 6, tk = lane & 15, kg = lane >> 4;
    const float* MOD = (const float*)(c.ws + WS_MOD); const bf16* X1 = (const bf16*)(c.ws + WS_X1); bf16* H2 = (bf16*)(c.ws + WS_H2);
    const bf16* WRT = (const bf16*)(c.ws + WS_WRT); const float* SHW = (const float*)(c.ws + WS_SHW);
    int* ROUTE = (int*)(c.ws + WS_ROUTE); int* LIST = (int*)(c.ws + WS_LIST); unsigned* ctl = (unsigned*)(c.ws + WS_CTL);
    constexpr int WROW = 1040, WHALF = 36 * WROW;
    LAS unsigned char* whi = lds; LAS unsigned char* wlo = lds + WHALF;
    LAS int* bcnt = (LAS int*)(lds + 2 * WHALF);
    LAS int* rt = bcnt + 64;
    for (int base = blockIdx.x * 128; base < NTOK; base += gridDim.x * 128) {
        if (tid < 32) bcnt[tid] = 0;
        const int lt = wave * 16 + tk, tok = base + lt, bb = tok / SEQ;
        const bf16* xr = X1 + (size_t)tok * DM + 8 * kg; const float* gp = c.g_ffn + 8 * kg; const float* scp = MOD + bb * 6144 + 4096 + 8 * kg; const float* shp = MOD + bb * 6144 + 3072 + 8 * kg;
        f32x4 acc[3]; float ss = 0.f;
#pragma unroll
        for (int ct = 0; ct < 3; ++ct) acc[ct] = (f32x4){0.f, 0.f, 0.f, 0.f};
        const int arow0 = tk, arow1 = 16 + tk, arow2 = (32 + tk) < 36 ? 32 + tk : 35;
        for (int kh = 0; kh < 2; ++kh) {
            __syncthreads();
            for (int q = tid; q < 2 * 36 * 64; q += 512) { const int which = q / 2304, r = (q % 2304) >> 6, ch = q & 63;
                *(LAS u32x4*)((which ? wlo : whi) + r * WROW + ch * 16) = *(const u32x4*)(WRT + (size_t)which * 36 * 1024 + r * 1024 + kh * 512 + ch * 8); }
            __syncthreads();
#pragma unroll 2
            for (int s = 0; s < 16; ++s) { const int ko = kh * 512 + 32 * s;
                const u32x4 xw = *(const u32x4*)(xr + ko); const f32x4 x0 = {bflo(xw.x), bfhi(xw.x), bflo(xw.y), bfhi(xw.y)}, x1 = {bflo(xw.z), bfhi(xw.z), bflo(xw.w), bfhi(xw.w)};
                const f32x4 g0 = *(const f32x4*)(gp + ko), g1 = *(const f32x4*)(gp + ko + 4), s0 = *(const f32x4*)(scp + ko), s1 = *(const f32x4*)(scp + ko + 4);
                ss += (x0.x * x0.x + x0.y * x0.y) + (x0.z * x0.z + x0.w * x0.w) + (x1.x * x1.x + x1.y * x1.y) + (x1.z * x1.z + x1.w * x1.w);
                const f32x4 u0 = x0 * g0 * (s0 + 1.0f), u1 = x1 * g1 * (s1 + 1.0f);
                u32x4 hw; hw.x = pk2(u0.x, u0.y); hw.y = pk2(u0.z, u0.w); hw.z = pk2(u1.x, u1.y); hw.w = pk2(u1.z, u1.w);
                u32x4 lw; lw.x = pk2(u0.x - bflo(hw.x), u0.y - bfhi(hw.x)); lw.y = pk2(u0.z - bflo(hw.y), u0.w - bfhi(hw.y)); lw.z = pk2(u1.x - bflo(hw.z), u1.y - bfhi(hw.z)); lw.w = pk2(u1.z - bflo(hw.w), u1.w - bfhi(hw.w));
                const bf16x8 uh = __builtin_bit_cast(bf16x8, hw), ul = __builtin_bit_cast(bf16x8, lw);
                const int co = (32 * s + 8 * kg) * 2;
#pragma unroll
                for (int ct = 0; ct < 3; ++ct) { const int ar = ct == 0 ? arow0 : (ct == 1 ? arow1 : arow2);
                    const bf16x8 ah = *(const LAS bf16x8*)(whi + ar * WROW + co), al = *(const LAS bf16x8*)(wlo + ar * WROW + co);
                    acc[ct] = __builtin_amdgcn_mfma_f32_16x16x32_bf16(ah, uh, acc[ct], 0, 0, 0);
                    acc[ct] = __builtin_amdgcn_mfma_f32_16x16x32_bf16(al, uh, acc[ct], 0, 0, 0);
                    acc[ct] = __builtin_amdgcn_mfma_f32_16x16x32_bf16(ah, ul, acc[ct], 0, 0, 0); }
            }
        }
        ss += __shfl_xor(ss, 16); ss += __shfl_xor(ss, 32);
        const float rstd = rsqrtf(ss * (1.0f / DM) + NORM_EPS);
        float gl[4];
#pragma unroll
        for (int j = 0; j < 4; ++j) gl[j] = __shfl(acc[2][j] * rstd + SHW[bb * 36 + 32 + j] + c.b_rg[j], tk);
        int gs = 0; float gm = gl[0];
#pragma unroll
        for (int n = 1; n < 4; ++n) if (gl[n] > gm) { gm = gl[n]; gs = n; }
        float gden = 0.f;
#pragma unroll
        for (int n = 0; n < 4; ++n) gden += expf(gl[n] - gm);
        const float gw_ = 1.0f / gden;
        float cand[4];
#pragma unroll
        for (int j = 0; j < 4; ++j) { const int n = 16 * (gs >> 1) + 4 * kg + j; cand[j] = ((gs >> 1) ? acc[1][j] : acc[0][j]) * rstd + SHW[bb * 36 + n] + c.b_re[n]; }
        float el[8]; const int srcl = tk + 32 * (gs & 1);
#pragma unroll
        for (int j = 0; j < 4; ++j) { el[j] = __shfl(cand[j], srcl); el[4 + j] = __shfl(cand[j], srcl + 16); }
        int i0 = 0; float v0 = el[0];
#pragma unroll
        for (int n = 1; n < 8; ++n) if (el[n] > v0) { v0 = el[n]; i0 = n; }
        int i1 = i0 == 0 ? 1 : 0; float v1 = i0 == 0 ? el[1] : el[0];
#pragma unroll
        for (int n = 1; n < 8; ++n) if (n != i0 && el[n] > v1) { v1 = el[n]; i1 = n; }
        const float e1 = expf(v1 - v0), den = 1.0f + e1; const float w0 = gw_ / den, w1 = gw_ * e1 / den;
        if (DRY) { asm volatile("" :: "v"(w0), "v"(w1), "v"(i0), "v"(i1)); }
        if (kg == 0 && !DRY) { const int e0g = gs * 8 + i0, e1g = gs * 8 + i1; const int r0 = atomicAdd((int*)&bcnt[e0g], 1), r1 = atomicAdd((int*)&bcnt[e1g], 1);
            LAS int* r = rt + lt * 6; r[0] = e0g; r[1] = e1g; r[2] = r0; r[3] = r1; r[4] = __builtin_bit_cast(int, w0); r[5] = __builtin_bit_cast(int, w1); }
#pragma unroll 4
        for (int s = 0; s < 32; ++s) { const int ko = 32 * s;
            const u32x4 xw = *(const u32x4*)(xr + ko); const f32x4 x0 = {bflo(xw.x), bfhi(xw.x), bflo(xw.y), bfhi(xw.y)}, x1 = {bflo(xw.z), bfhi(xw.z), bflo(xw.w), bfhi(xw.w)};
            const f32x4 g0 = *(const f32x4*)(gp + ko), g1 = *(const f32x4*)(gp + ko + 4), s0 = *(const f32x4*)(scp + ko), s1 = *(const f32x4*)(scp + ko + 4);
            const f32x4 h0 = *(const f32x4*)(shp + ko), h1 = *(const f32x4*)(shp + ko + 4);
            const f32x4 o0 = (x0 * rstd * g0) * (s0 + 1.0f) + h0, o1 = (x1 * rstd * g1) * (s1 + 1.0f) + h1;
            *(u32x4*)(H2 + (size_t)tok * DM + 8 * kg + ko) = pack8(o0, o1); }
        __syncthreads();
        if (DRY) continue;
        if (tid < 32) bcnt[32 + tid] = (int)__hip_atomic_fetch_add(ctl + CW_CNT + 64 * tid, (unsigned)bcnt[tid], __ATOMIC_RELAXED, __HIP_MEMORY_SCOPE_AGENT);
        __syncthreads();
        if (tid < 128) { const LAS int* r = rt + tid * 6; const int tk2 = base + tid; const int e0g = r[0], e1g = r[1], p0 = bcnt[32 + e0g] + r[2], p1 = bcnt[32 + e1g] + r[3];
            int* ro = ROUTE + (size_t)tk2 * 8; ro[0] = e0g; ro[1] = e1g; ro[2] = p0; ro[3] = p1; ro[4] = r[4]; ro[5] = r[5];
            LIST[e0g * NTOK + p0] = tk2; LIST[e1g * NTOK + p1] = tk2; }
        __syncthreads();
    }
}

__device__ __forceinline__ void ph_final(const Ctx& c, LAS unsigned char* lds) {
    const int tid = threadIdx.x, lane = tid & 63, wave = tid >> 6, nw = blockDim.x >> 6;
    const float* MOD = (const float*)(c.ws + WS_MOD); const bf16* X1 = (const bf16*)(c.ws + WS_X1); const bf16* YB = (const bf16*)(c.ws + WS_YB);
    const int* ROUTE = (const int*)(c.ws + WS_ROUTE);
    LAS int* mm = (LAS int*)lds; moe_build(mm, (const unsigned*)(c.ws + WS_CTL));
    f32x4 g[4];
#pragma unroll
    for (int q = 0; q < 4; ++q) g[q] = *(const f32x4*)(c.g_final + 4 * lane + 256 * q);
    for (int tok = blockIdx.x * nw + wave; tok < NTOK; tok += gridDim.x * nw) {
        const int bb = tok / SEQ; const float* gt = MOD + bb * 6144 + 5120; const int* ro = ROUTE + (size_t)tok * 8;
        const int e0 = ro[0], e1 = ro[1]; const size_t r0 = ((size_t)mm[32 + e0] << 8) + ro[2], r1 = ((size_t)mm[32 + e1] << 8) + ro[3];
        const float w0 = __builtin_bit_cast(float, ro[4]), w1 = __builtin_bit_cast(float, ro[5]);
        f32x4 v[4]; float ss = 0.f;
#pragma unroll
        for (int q = 0; q < 4; ++q) { const int col = 4 * lane + 256 * q; const u32x2 xw = *(const u32x2*)(X1 + (size_t)tok * DM + col); const f32x4 xv = {bflo(xw.x), bfhi(xw.x), bflo(xw.y), bfhi(xw.y)}, gv = *(const f32x4*)(gt + col);
            const u32x2 ya = *(const u32x2*)(YB + r0 * DM + col), yb = *(const u32x2*)(YB + r1 * DM + col);
            f32x4 y; y.x = w0 * bflo(ya.x) + w1 * bflo(yb.x); y.y = w0 * bfhi(ya.x) + w1 * bfhi(yb.x); y.z = w0 * bflo(ya.y) + w1 * bflo(yb.y); y.w = w0 * bfhi(ya.y) + w1 * bfhi(yb.y);
            v[q] = xv + gv * y; ss += (v[q].x * v[q].x + v[q].y * v[q].y) + (v[q].z * v[q].z + v[q].w * v[q].w); }
        const float rstd = rsqrtf(wave_sum(ss) * (1.0f / DM) + NORM_EPS);
#pragma unroll
        for (int q = 0; q < 4; ++q) *(f32x4*)(c.out + (size_t)tok * DM + 4 * lane + 256 * q) = v[q] * rstd * g[q];
    }
}

#define XB_TMO      128
#define XB_XCNT(j)  (256  + 64 * (j))
#define XB_XSUB(j)  (1280 + 64 * (j))
#define XB_XGEN(j)  (2304 + 64 * (j))
#define XB_TOP      3328
#define XB_TOPGEN   3392
#define XCD_BAR_WORDS 3456
#define XB_SPIN_CAP (1u << 18)

__device__ __forceinline__ unsigned xb_ld(unsigned* p)              { return __hip_atomic_load(p, __ATOMIC_RELAXED, __HIP_MEMORY_SCOPE_AGENT); }
__device__ __forceinline__ unsigned xb_add(unsigned* p, unsigned v) { return __hip_atomic_fetch_add(p, v, __ATOMIC_RELAXED, __HIP_MEMORY_SCOPE_AGENT); }
__device__ __forceinline__ unsigned xb_xcc_id() { return (unsigned)__builtin_amdgcn_s_getreg((3 << 11) | 20) & 0xFu; }
#define XB_SPIN(cond, bar) do { unsigned _sp = 0; while (cond) { __builtin_amdgcn_s_sleep(1); \
    if ((++_sp & 255u) == 0u) { if (xb_ld(&(bar)[XB_TMO])) break; if (_sp > XB_SPIN_CAP) { atomicAdd(&(bar)[XB_TMO], 1u); break; } } } } while (0)

struct XcdBarrier {
    unsigned* bar; unsigned x;
    volatile LAS unsigned* st;
};
__device__ __forceinline__ XcdBarrier xcd_barrier_post(unsigned* bar, volatile LAS unsigned* st) {
    XcdBarrier b; b.bar = bar; b.x = xb_xcc_id(); b.st = st;
    if (threadIdx.x == 0) (void)xb_add(&bar[XB_XCNT(b.x)], 1u);
    return b;
}
__device__ __forceinline__ void xcd_barrier_complete(unsigned* bar, unsigned x, unsigned& nloc, unsigned& nx) {
    const unsigned G = gridDim.x * gridDim.y * gridDim.z;
    unsigned sum, cnt, mine, sp = 0u;
    for (;;) {
        sum = 0u; cnt = 0u; mine = 0u;
#pragma unroll
        for (unsigned j = 0; j < 16; ++j) { const unsigned c = xb_ld(&bar[XB_XCNT(j)]); sum += c; cnt += (c > 0u) ? 1u : 0u; mine = (j == x) ? c : mine; }
        if (sum == G) break;
        __builtin_amdgcn_s_sleep(1);
        if ((++sp & 255u) == 0u) { if (xb_ld(&bar[XB_TMO])) break; if (sp > XB_SPIN_CAP) { atomicAdd(&bar[XB_TMO], 1u); break; } }
    }
    nloc = mine > 0u ? mine : 1u; nx = cnt > 0u ? cnt : 1u;
}
__device__ __forceinline__ void xcd_barrier(const XcdBarrier& b) {
    asm volatile("s_waitcnt vmcnt(0)" ::: "memory");
    __syncthreads();
    if (threadIdx.x == 0) {
        unsigned* bar = b.bar;
        __builtin_amdgcn_s_waitcnt(0);
        unsigned nloc = b.st[0], nx = b.st[1];
        if (nloc == 0u) { xcd_barrier_complete(bar, b.x, nloc, nx); b.st[0] = nloc; b.st[1] = nx; }
        const unsigned old = xb_add(&bar[XB_XSUB(b.x)], 1u);
        const unsigned gen = old / nloc;
        if (old + 1u == (gen + 1u) * nloc) {
            __builtin_amdgcn_fence(__ATOMIC_RELEASE, "agent");
            asm volatile("s_waitcnt vmcnt(0)" ::: "memory");
            const unsigned og = xb_add(&bar[XB_TOP], 1u);
            const unsigned tg = og / nx;
            if (og + 1u == (tg + 1u) * nx) xb_add(&bar[XB_TOPGEN], 1u);
            else XB_SPIN(xb_ld(&bar[XB_TOPGEN]) == tg, bar);
            __builtin_amdgcn_fence(__ATOMIC_ACQUIRE, "agent");
            xb_add(&bar[XB_XGEN(b.x)], 1u);
            asm volatile("s_waitcnt vmcnt(0)" ::: "memory");
        } else {
            XB_SPIN(xb_ld(&bar[XB_XGEN(b.x)]) == gen, bar);
            __builtin_amdgcn_fence(__ATOMIC_ACQUIRE, "agent");
            asm volatile("s_waitcnt vmcnt(0)" ::: "memory");
        }
    }
    __syncthreads();
}

#ifndef PROBE_MASK
#define PROBE_MASK 0
#endif
constexpr int LDS_BYTES = 147456;
constexpr int LDS_BARW_OFF = LDS_BYTES - 16;
__global__ void __launch_bounds__(512, 2) mega_fwd(Ctx c) {
    extern __shared__ __attribute__((aligned(16))) unsigned char lds_raw[];
    LAS unsigned char* lds = (LAS unsigned char*)lds_raw;
    if (threadIdx.x == 0) *(LAS u32x4*)(lds + LDS_BARW_OFF) = (u32x4){0u, 0u, 0u, 0u};
    __syncthreads();
    const XcdBarrier bar = xcd_barrier_post((unsigned*)(c.ws + WS_CTL) + CW_BAR, (volatile LAS unsigned*)(lds + LDS_BARW_OFF));
#define RUN(k, call) do { call; xcd_barrier(bar); if (PROBE_MASK & (1 << (k))) { call; xcd_barrier(bar); } } while (0)
    RUN(0, ph_prologue(c, lds));
    RUN(1, ph_norm1(c));
    RUN(2, ph_inproj(c, lds));
    if (PROBE_MASK & (1 << 12)) gla::g0_phase(c, lds);
    if (PROBE_MASK & (1 << 13)) { da::attn_phase(c, lds); }
    RUN(3, (gla::g0_phase(c, lds), da::attn_phase(c, lds)));
    RUN(4, gla::g1_phase(c, lds));
    RUN(5, gla::g2_phase(c));
    RUN(6, gla::g3_phase(c, lds));
    RUN(7, ph_outproj(c, lds));
    if (PROBE_MASK & (1 << 8)) { ph_router<true>(c, lds); xcd_barrier(bar); }
    ph_router<false>(c, lds); xcd_barrier(bar);
    RUN(9, ph_gateup(c, lds));
    RUN(10, ph_down(c, lds));
    if (PROBE_MASK & (1 << 11)) { ph_final(c, lds); xcd_barrier(bar); }
    ph_final(c, lds);
}

extern "C" void kernel_launch(void* const* d_in, const int* in_sizes, int n_in, void* d_out, int out_size, void* d_ws, size_t ws_size, hipStream_t stream) {
    static int grid = 0;
    if (grid == 0) {
        if (n_in != 23 || in_sizes[0] != NTOK * DM || out_size != NTOK * DM || ws_size < WS_END) { fprintf(stderr, "kernel_launch: unexpected problem shape (n_in %d, in0 %d, out %d, ws %zu)\n", n_in, n_in > 0 ? in_sizes[0] : -1, out_size, ws_size); grid = -1; return; }
        int dev = 0, cus = 0, per_cu = 0;
        if (hipGetDevice(&dev) != hipSuccess || hipDeviceGetAttribute(&cus, hipDeviceAttributeMultiprocessorCount, dev) != hipSuccess) { grid = -1; return; }
        if (hipFuncSetAttribute((const void*)mega_fwd, hipFuncAttributeMaxDynamicSharedMemorySize, LDS_BYTES) != hipSuccess) { fprintf(stderr, "kernel_launch: hipFuncSetAttribute failed\n"); grid = -1; return; }
        if (hipOccupancyMaxActiveBlocksPerMultiprocessor(&per_cu, (const void*)mega_fwd, 512, LDS_BYTES) != hipSuccess || per_cu < 1) fprintf(stderr, "kernel_launch: occupancy query reports %d workgroups per CU\n", per_cu);
        (void)hipGetLastError();
        grid = cus;
    }
    if (grid < 0) return;
    Ctx c{};
    const float** f = (const float**)&c;
    for (int i = 0; i < 23; ++i) f[i] = (const float*)d_in[i];
    c.out = (float*)d_out; c.ws = (unsigned char*)d_ws;
    if (hipMemsetAsync((unsigned char*)d_ws + WS_CTL, 0, CTL_ZERO_BYTES, stream) != hipSuccess) return;
    hipLaunchKernelGGL(mega_fwd, dim3(grid), dim3(512), LDS_BYTES, stream, c);
}
```

```cpp
#include <hip/hip_runtime.h>
#include <cstdint>
#include <cstdio>

#define GAS __attribute__((address_space(1)))
#define LAS __attribute__((address_space(3)))
typedef unsigned short bf16;
typedef float f32x4 __attribute__((ext_vector_type(4)));
typedef float f32x2 __attribute__((ext_vector_type(2)));
typedef unsigned u32x4 __attribute__((ext_vector_type(4)));
typedef unsigned u32x2 __attribute__((ext_vector_type(2)));

constexpr int NB = 16, SEQ = 2048, DM = 1024, CTXL = 256, KVL = CTXL + SEQ;
constexpr int NTOK = NB * SEQ;
constexpr int NROW = NB * KVL;
constexpr int NPROJ = 3104, NPROJ_PAD = 3328;
constexpr int NEXP = 32, EHID = 512;
constexpr int MOE_ROWS_MAX = 73728;
constexpr float NORM_EPS = 1e-6f;
constexpr float LAMBDA_INIT = 0.2f;
constexpr float QSCALE = 0.125f * 1.4426950408889634f;

constexpr int C_DAQ = 0, C_DAK = 512, C_DAV = 1024, C_GQ = 1536, C_GK = 1792, C_GV = 2048, C_GR = 2560, C_LR = 3072;

constexpr size_t MiB = 1u << 20;
constexpr size_t WS_CTL = 0, CTL_ZERO_BYTES = 1 * MiB;
constexpr size_t WS_MOD = 1 * MiB;
constexpr size_t WS_ROPE = 1 * MiB + 512 * 1024;
constexpr size_t WS_WRT = 462 * MiB;
constexpr size_t WS_ROUTE = 2 * MiB;
constexpr size_t WS_LIST = 3 * MiB;
constexpr size_t WS_WIN_T = 7 * MiB;
constexpr size_t WS_WOUT_T = 14 * MiB;
constexpr size_t WS_WGU_T = 16 * MiB;
constexpr size_t WS_WD_T = 80 * MiB;
constexpr size_t WS_H = 112 * MiB;
constexpr size_t WS_HMID = 112 * MiB;
constexpr size_t WS_QDA = 184 * MiB;
constexpr size_t WS_KDA = 216 * MiB;
constexpr size_t WS_VDA = 252 * MiB;
constexpr size_t WS_GQ = 288 * MiB;
constexpr size_t WS_GK = 304 * MiB;
constexpr size_t WS_GV = 322 * MiB;
constexpr size_t WS_GR = 358 * MiB;
constexpr size_t WS_LR = 390 * MiB;
constexpr size_t WS_X1 = 184 * MiB;
constexpr size_t WS_H2 = 312 * MiB;
constexpr size_t WS_YB = 312 * MiB;
constexpr size_t WS_MIX = 112 * MiB;
constexpr size_t WS_UT = 184 * MiB;
constexpr size_t WS_ST = 256 * MiB;
constexpr size_t WS_QD = 395 * MiB;
constexpr size_t WS_KI = 427 * MiB;
constexpr size_t WS_KEND = 464 * MiB;
constexpr size_t WS_DB = 460 * MiB;
constexpr size_t WS_SSP = 500 * MiB;
constexpr size_t WS_END = 502 * MiB;

constexpr int CW_BAR = 4096;
constexpr int CW_CNT = 16384;

struct Ctx {
    const float *x, *c, *ctx, *c_ctx, *w_ada, *b_ada, *g_mix, *g_ffn, *w_in, *da_lambda, *da_subln_g, *gate_w2, *gate_b, *gla_norm_g, *w_out,
        *w_rg, *b_rg, *w_re, *b_re, *w_gate, *w_up, *w_down, *g_final;
    float* out; unsigned char* ws;
};

__device__ __forceinline__ unsigned f2bf(float f) { unsigned u = __builtin_bit_cast(unsigned, f); return (u + 0x7fffu + ((u >> 16) & 1u)) >> 16; }
typedef float f32x2_c __attribute__((ext_vector_type(2))); typedef __bf16 bf16x2_c __attribute__((ext_vector_type(2)));
__device__ __forceinline__ unsigned pk2(float lo, float hi) { f32x2_c v = {lo, hi}; bf16x2_c b = __builtin_convertvector(v, bf16x2_c); return __builtin_bit_cast(unsigned, b); }
__device__ __forceinline__ float bf2f(unsigned b) { return __builtin_bit_cast(float, b << 16); }
__device__ __forceinline__ float bflo(unsigned w) { return __builtin_bit_cast(float, w << 16); }
__device__ __forceinline__ float bfhi(unsigned w) { return __builtin_bit_cast(float, w & 0xffff0000u); }
__device__ __forceinline__ float wave_sum(float v) {
#pragma unroll
    for (int o = 1; o < 64; o <<= 1) v += __shfl_xor(v, o);
    return v;
}
__device__ __forceinline__ float silu_f(float v) { return v / (1.0f + __expf(-v)); }
#define LDS_WAIT() asm volatile("s_waitcnt lgkmcnt(0)" ::: "memory")

template <class RowMap>
__device__ __forceinline__ void transpose_item(const float* W, int ldw, int k0, int n0, bf16* WT, int KT, const RowMap& rm, LAS float* scr, int lane) {
    float v[32];
#pragma unroll
    for (int i = 0; i < 32; ++i) v[i] = W[(size_t)(k0 + 2 * i + (lane >> 5)) * ldw + n0 + (lane & 31)];
#pragma unroll
    for (int i = 0; i < 32; ++i) scr[(2 * i + (lane >> 5)) * 33 + (lane & 31)] = v[i];
    LDS_WAIT(); asm volatile("" ::: "memory");
    const int c = lane & 7;
#pragma unroll
    for (int j = 0; j < 4; ++j) { const int n = (lane >> 3) + 8 * j; const LAS float* s = scr + (8 * c) * 33 + n;
        u32x4 o; o.x = pk2(s[0 * 33], s[1 * 33]); o.y = pk2(s[2 * 33], s[3 * 33]); o.z = pk2(s[4 * 33], s[5 * 33]); o.w = pk2(s[6 * 33], s[7 * 33]);
        *(u32x4*)(WT + (size_t)rm(n0 + n) * KT + k0 + 8 * c) = o; }
    LDS_WAIT(); asm volatile("" ::: "memory");
}
struct TItem { const float* src; bf16* dst; int ldw, KT, n0, mode; };
__device__ __forceinline__ int titem_row(const TItem& t, int n) { const int a = t.n0 + n;
    return t.mode == 0 ? a : (t.mode == 1 ? (a & ~31) + (((a & 31) & 15) << 1) + ((a & 31) >> 4) : 8 * (a >> 2) + (a & 3) + 4 * (t.mode - 2)); }
__device__ __forceinline__ void titem_load(const TItem& t, float (&v)[32], int lane) {
#pragma unroll
    for (int i = 0; i < 32; ++i) v[i] = t.src[(size_t)(2 * i + (lane >> 5)) * t.ldw + (lane & 31)];
}
__device__ __forceinline__ void titem_store(const TItem& t, const float (&v)[32], LAS float* scr, int lane) {
#pragma unroll
    for (int i = 0; i < 32; ++i) scr[(2 * i + (lane >> 5)) * 33 + (lane & 31)] = v[i];
    LDS_WAIT(); asm volatile("" ::: "memory");
    const int c = lane & 7;
#pragma unroll
    for (int j = 0; j < 4; ++j) { const int n = (lane >> 3) + 8 * j; const LAS float* s = scr + (8 * c) * 33 + n;
        u32x4 o; o.x = pk2(s[0 * 33], s[1 * 33]); o.y = pk2(s[2 * 33], s[3 * 33]); o.z = pk2(s[4 * 33], s[5 * 33]); o.w = pk2(s[6 * 33], s[7 * 33]);
        *(u32x4*)(t.dst + (size_t)titem_row(t, n) * t.KT + 8 * c) = o; }
    LDS_WAIT(); asm volatile("" ::: "memory");
}
struct RowId { int off; __device__ __forceinline__ int operator()(int n) const { return off + n; } };
struct RowRope { __device__ __forceinline__ int operator()(int n) const { const int l = n & 31; return (n & ~31) + ((l & 15) << 1) + (l >> 4); } };
struct RowGU { int up; __device__ __forceinline__ int operator()(int n) const { return 8 * (n >> 2) + (n & 3) + 4 * up; } };

__device__ __forceinline__ void ph_prologue(const Ctx& c, LAS unsigned char* lds) {
    const int tid = threadIdx.x, lane = tid & 63, wave = tid >> 6, nw = blockDim.x >> 6;
    unsigned char* ws = c.ws;
    if (blockIdx.x < 96 && nw == 8) {
        LAS float* sv = (LAS float*)lds;
        LAS float* red = sv + 17 * 1024;
        for (int i = tid; i < 17 * 1024; i += 512) { const int r = i >> 10, k = i & 1023; const float v = r < 16 ? c.c[r * 1024 + k] : c.c_ctx[k]; sv[i] = v / (1.0f + expf(-v)); }
        __syncthreads();
        const int col = blockIdx.x * 64 + lane;
        float acc[17];
#pragma unroll
        for (int r = 0; r < 17; ++r) acc[r] = 0.f;
        for (int k = wave * 128; k < wave * 128 + 128; ++k) { const float w = c.w_ada[(size_t)k * 6144 + col];
#pragma unroll
            for (int r = 0; r < 17; ++r) acc[r] += sv[r * 1024 + k] * w; }
#pragma unroll
        for (int r = 0; r < 17; ++r) red[(wave * 17 + r) * 64 + lane] = acc[r];
        __syncthreads();
        float* MOD = (float*)(ws + WS_MOD);
        for (int i = tid; i < 17 * 64; i += 512) { const int r = i >> 6, l = i & 63; float s = 0.f;
            for (int w = 0; w < 8; ++w) s += red[(w * 17 + r) * 64 + l];
            MOD[r * 6144 + blockIdx.x * 64 + l] = s + c.b_ada[blockIdx.x * 64 + l]; }
        __syncthreads();
    }
    { f32x2* ROPE = (f32x2*)(ws + WS_ROPE);
      for (int i = blockIdx.x * blockDim.x + tid; i < 2048 * 32; i += gridDim.x * blockDim.x) {
          const int t = i >> 5, a = (i >> 4) & 1, f = i & 15; const float pos = (float)(a == 0 ? (t >> 6) : (t & 63));
          const float inv = exp2f(-(float)f * (13.287712379549449f / 16.0f));
          const float ang = pos * inv; f32x2 cs; cs.x = __cosf(ang); cs.y = __sinf(ang); ROPE[i] = cs; } }
    { bf16* WRT = (bf16*)(ws + WS_WRT);
      for (int i = blockIdx.x * blockDim.x + tid; i < 36 * 1024; i += gridDim.x * blockDim.x) { const int n = i >> 10, k = i & 1023;
          const float wv = n < 32 ? c.w_re[k * 32 + n] : c.w_rg[k * 4 + (n - 32)]; const unsigned h = f2bf(wv); WRT[i] = (bf16)h; WRT[36 * 1024 + i] = (bf16)f2bf(wv - bf2f(h)); } }
    { u32x4* z = (u32x4*)(ws + WS_WIN_T + (size_t)NPROJ * 1024 * 2); const int n16 = (NPROJ_PAD - NPROJ) * 1024 * 2 / 16;
      for (int i = blockIdx.x * blockDim.x + tid; i < n16; i += gridDim.x * blockDim.x) z[i] = (u32x4){0u, 0u, 0u, 0u}; }
    LAS float* scr = (LAS float*)(lds + wave * 8704);
    const int gw = blockIdx.x * nw + wave, NGW = gridDim.x * nw;
    constexpr int I_IN = 16 * 97, I_OUT = 16 * 32, I_G = 32 * 16 * 16, I_U = I_G, I_D = 32 * 8 * 32;
    constexpr int NITEMS = I_IN + I_OUT + I_G + I_U + I_D;
    bf16* WIN_T = (bf16*)(ws + WS_WIN_T); bf16* WOUT_T = (bf16*)(ws + WS_WOUT_T); bf16* WGU_T = (bf16*)(ws + WS_WGU_T); bf16* WD_T = (bf16*)(ws + WS_WD_T);
    constexpr int NA_PER = 2; const int nfree = ((int)gridDim.x - 96) * nw, NA = gridDim.x > 96 ? nfree * NA_PER : 0;
    const int gfree = ((int)blockIdx.x - 96) * nw + wave;
    auto decode = [&](int it) -> TItem { TItem t; int r = it;
        if (r < I_IN) { const int kb = r / 97, nb = r % 97, n0 = nb * 32; t.src = c.w_in + (size_t)(kb * 64) * NPROJ + n0; t.dst = WIN_T + kb * 64; t.ldw = NPROJ; t.KT = 1024; t.n0 = n0; t.mode = n0 < 1024 ? 1 : 0; return t; }
        r -= I_IN;
        if (r < I_OUT) { const int kb = r / 32, nb = r % 32; t.src = c.w_out + (size_t)(kb * 64) * 1024 + nb * 32; t.dst = WOUT_T + kb * 64; t.ldw = 1024; t.KT = 1024; t.n0 = nb * 32; t.mode = 0; return t; }
        r -= I_OUT;
        if (r < I_G + I_U) { const int up = r >= I_G; if (up) r -= I_G; const int e = r / 256, q = r % 256, kb = q / 16, nb = q % 16;
            t.src = (up ? c.w_up : c.w_gate) + (size_t)e * 1024 * 512 + (size_t)(kb * 64) * 512 + nb * 32; t.dst = WGU_T + (size_t)e * 1024 * 1024 + kb * 64; t.ldw = 512; t.KT = 1024; t.n0 = nb * 32; t.mode = 2 + up; return t; }
        r -= I_G + I_U;
        { const int e = r / 256, q = r % 256, kb = q / 32, nb = q % 32; t.src = c.w_down + (size_t)e * 512 * 1024 + (size_t)(kb * 64) * 1024 + nb * 32; t.dst = WD_T + (size_t)e * 1024 * 512 + kb * 64; t.ldw = 1024; t.KT = 512; t.n0 = nb * 32; t.mode = 0; return t; } };
    for (int pass = 0; pass < 2; ++pass) {
        const int first = pass == 0 ? (blockIdx.x >= 96 ? gfree : NITEMS) : NA + gw, end = pass == 0 ? NA : NITEMS, stride = pass == 0 ? nfree : NGW;
        for (int it = first; it < end; it += 2 * stride) {
            const bool two = it + stride < end;
            const TItem ta = decode(it), tb = decode(two ? it + stride : it);
            float va[32], vb[32];
            titem_load(ta, va, lane); if (two) titem_load(tb, vb, lane);
            titem_store(ta, va, scr, lane); if (two) titem_store(tb, vb, scr, lane);
        }
    }
}

__device__ __forceinline__ void ph_norm1(const Ctx& c) {
    const int tid = threadIdx.x, lane = tid & 63, wave = tid >> 6, nw = blockDim.x >> 6;
    const int gw = blockIdx.x * nw + wave, NGW = gridDim.x * nw;
    const float* MOD = (const float*)(c.ws + WS_MOD); bf16* H = (bf16*)(c.ws + WS_H);
    f32x4 g[4];
#pragma unroll
    for (int j = 0; j < 4; ++j) g[j] = *(const f32x4*)(c.g_mix + 4 * lane + 256 * j);
    for (int r0 = gw * 2; r0 < NROW; r0 += NGW * 2) {
        f32x4 v[2][4];
#pragma unroll
        for (int t = 0; t < 2; ++t) { const int r = r0 + t, b = r / KVL, j = r % KVL; const bool isctx = j < CTXL;
            const float* src = isctx ? c.ctx + ((size_t)b * CTXL + j) * DM : c.x + ((size_t)b * SEQ + (j - CTXL)) * DM;
#pragma unroll
            for (int q = 0; q < 4; ++q) v[t][q] = *(const f32x4*)(src + 4 * lane + 256 * q); }
#pragma unroll
        for (int t = 0; t < 2; ++t) { const int r = r0 + t, b = r / KVL, j = r % KVL; const bool isctx = j < CTXL;
            const float* mod = MOD + (isctx ? 16 : b) * 6144; float ss = 0.f;
#pragma unroll
            for (int q = 0; q < 4; ++q) ss += (v[t][q].x * v[t][q].x + v[t][q].y * v[t][q].y) + (v[t][q].z * v[t][q].z + v[t][q].w * v[t][q].w);
            const float rstd = rsqrtf(wave_sum(ss) * (1.0f / DM) + NORM_EPS);
#pragma unroll
            for (int q = 0; q < 4; ++q) { const f32x4 sh = *(const f32x4*)(mod + 4 * lane + 256 * q), sc = *(const f32x4*)(mod + 1024 + 4 * lane + 256 * q);
                const f32x4 o = (v[t][q] * rstd * g[q]) * (sc + 1.0f) + sh;
                u32x2 w; w.x = pk2(o.x, o.y); w.y = pk2(o.z, o.w); *(u32x2*)(H + (size_t)r * DM + 4 * lane + 256 * q) = w; } }
    }
}

__device__ __forceinline__ u32x4 pack8(const f32x4& a, const f32x4& b) { u32x4 w; w.x = pk2(a.x, a.y); w.y = pk2(a.z, a.w); w.z = pk2(b.x, b.y); w.w = pk2(b.z, b.w); return w; }
struct EpiInProj {
    unsigned char* ws;
    __device__ __forceinline__ void rope8(int t, int i8, f32x4& a, f32x4& b, float scale) const {
        const f32x2* R = (const f32x2*)(ws + WS_ROPE) + (size_t)t * 32 + (i8 >> 5) * 16 + ((i8 & 31) >> 1);
        const f32x4 c0 = *(const f32x4*)R, c1 = *(const f32x4*)(R + 2);
        f32x4 oa, ob;
        oa.x = (a.x * c0.x - a.y * c0.y) * scale; oa.y = (a.y * c0.x + a.x * c0.y) * scale;
        oa.z = (a.z * c0.z - a.w * c0.w) * scale; oa.w = (a.w * c0.z + a.z * c0.w) * scale;
        ob.x = (b.x * c1.x - b.y * c1.y) * scale; ob.y = (b.y * c1.x + b.x * c1.y) * scale;
        ob.z = (b.z * c1.z - b.w * c1.w) * scale; ob.w = (b.w * c1.z + b.z * c1.w) * scale;
        a = oa; b = ob;
    }
    __device__ __forceinline__ void emit8(int row, int col, f32x4 a, f32x4 b) const {
        const int bb = row / KVL, j = row % KVL; const bool lat = j >= CTXL; const int t = j - CTXL; const size_t tl = (size_t)bb * SEQ + t;
        if (col < C_DAK) { if (!lat) return; rope8(t, col & 63, a, b, QSCALE); *(u32x4*)((bf16*)(ws + WS_QDA) + tl * 512 + col) = pack8(a, b); }
        else if (col < C_DAV) { if (lat) rope8(t, col & 63, a, b, 1.0f); *(u32x4*)((bf16*)(ws + WS_KDA) + (size_t)row * 512 + (col - C_DAK)) = pack8(a, b); }
        else if (col < C_GQ) { *(u32x4*)((bf16*)(ws + WS_VDA) + (size_t)row * 512 + (col - C_DAV)) = pack8(a, b); }
        else if (col < C_GK) { if (!lat) return; *(u32x4*)((bf16*)(ws + WS_GQ) + tl * 256 + (col - C_GQ)) = pack8(a * 0.125f, b * 0.125f); }
        else if (col < C_GV) { *(u32x4*)((bf16*)(ws + WS_GK) + (size_t)row * 256 + (col - C_GK)) = pack8(a, b); }
        else if (col < C_GR) { *(u32x4*)((bf16*)(ws + WS_GV) + (size_t)row * 512 + (col - C_GV)) = pack8(a, b); }
        else if (col < C_LR) { if (!lat) return; *(u32x4*)((bf16*)(ws + WS_GR) + tl * 512 + (col - C_GR)) = pack8(a, b); }
        else if (col < NPROJ) { float* p = (float*)(ws + WS_LR) + (size_t)row * 32 + (col - C_LR); *(f32x4*)p = a; *(f32x4*)(p + 4) = b; }
    }
};
struct EpiGateUp {
    bf16* HMID;
    __device__ __forceinline__ void emit8(int row, int col, f32x4 a, f32x4 b) const {
        f32x4 h; h.x = silu_f(a.x) * b.x; h.y = silu_f(a.y) * b.y; h.z = silu_f(a.z) * b.z; h.w = silu_f(a.w) * b.w;
        u32x2 w; w.x = pk2(h.x, h.y); w.y = pk2(h.z, h.w); *(u32x2*)(HMID + (size_t)row * EHID + (col >> 1)) = w;
    }
};
struct EpiDown {
    bf16* YB;
    __device__ __forceinline__ void emit8(int row, int col, f32x4 a, f32x4 b) const { *(u32x4*)(YB + (size_t)row * DM + col) = pack8(a, b); }
};

__device__ __forceinline__ void moe_build(LAS int* mm, const unsigned* ctl) {
    if (threadIdx.x < 64) { const int l = threadIdx.x, e = l & 31;
        const int cnt = (int)__hip_atomic_load((unsigned*)ctl + CW_CNT + 64 * e, __ATOMIC_RELAXED, __HIP_MEMORY_SCOPE_AGENT);
        const int tiles = (cnt + 255) >> 8; int incl = tiles;
#pragma unroll
        for (int o = 1; o < 32; o <<= 1) { const int v = __shfl_up(incl, o); if (e >= o) incl += v; }
        if (l < 32) { mm[e] = cnt; mm[32 + e] = incl - tiles; if (e == 31) mm[64] = incl; } }
    __syncthreads();
}
__device__ __forceinline__ int moe_tile_expert(const LAS int* mm, int tile) { int e = 0;
#pragma unroll 1
    for (int i = 1; i < NEXP; ++i) if (mm[32 + i] <= tile) e = i;
    return e; }

namespace pg8 {
typedef short bf16x8 __attribute__((ext_vector_type(8)));
constexpr int BM = 256, BK = 64, HALF = 128, HTB = HALF * BK * 2  , STAGE_BYTES = 8 * HTB;
__host__ __device__ __forceinline__ int lds_byte(int r, int c) { const int st = (r >> 4) * 2 + (c >> 5), rr = r & 15, cc = c & 31, ob = rr * 64 + cc * 2; return st * 1024 + (ob ^ (((ob >> 9) & 1) << 5)); }
__host__ __device__ __forceinline__ void stage_rc(int b, int& R, int& C) { const int st = b / 1024, sb = b % 1024, swz = sb ^ (((sb >> 9) & 1) << 5); R = (st >> 1) * 16 + swz / 64; C = (st & 1) * 32 + (swz % 64) / 2; }
__host__ __device__ __forceinline__ int perm32(int rho) { const int n = rho >> 4, i = rho & 15; return 8 * (i >> 2) + 4 * n + (i & 3); }

struct Unit { const char* A; const char* B; int row0, col0, ge, gp; };
struct Gemm { int K; const int* LIST; const LAS int* mm; };

template <class E8> struct Epi8 {
    E8 e;
    __device__ __forceinline__ void operator()(const f32x4 (&acc)[2][2][4][2], const Unit& u, int wr, int wc, int fr, int fq) const {
#pragma unroll
        for (int ai = 0; ai < 2; ++ai)
#pragma unroll
            for (int m = 0; m < 4; ++m)
#pragma unroll
                for (int bj = 0; bj < 2; ++bj) e.emit8(u.row0 + ai * HALF + wr * 64 + m * 16 + fr, u.col0 + bj * HALF + wc * 32 + 8 * fq, acc[ai][bj][m][0], acc[ai][bj][m][1]);
    }
};

struct EpiOutProjB {
    const float* x; const float* MOD; bf16* X1; float* SSP;
    __device__ __forceinline__ void operator()(const f32x4 (&acc)[2][2][4][2], const Unit& u, int wr, int wc, int fr, int fq) const {
        const int bb = u.row0 / SEQ; const int colb = u.col0 + wc * 32 + 8 * fq;
        f32x4 g[2][2];
#pragma unroll
        for (int bj = 0; bj < 2; ++bj) { const float* gp = MOD + bb * 6144 + 2048 + colb + bj * HALF; g[bj][0] = *(const f32x4*)gp; g[bj][1] = *(const f32x4*)(gp + 4); }
#pragma unroll
        for (int ai = 0; ai < 2; ++ai)
#pragma unroll
            for (int mh = 0; mh < 2; ++mh) {
                f32x4 xv[2][2][2]; float ssq[2] = {0.f, 0.f};
#pragma unroll
                for (int mm_ = 0; mm_ < 2; ++mm_)
#pragma unroll
                    for (int bj = 0; bj < 2; ++bj) { const float* xp = x + (size_t)(u.row0 + ai * HALF + wr * 64 + (2 * mh + mm_) * 16 + fr) * DM + colb + bj * HALF; xv[mm_][bj][0] = *(const f32x4*)xp; xv[mm_][bj][1] = *(const f32x4*)(xp + 4); }
#pragma unroll
                for (int mm_ = 0; mm_ < 2; ++mm_)
#pragma unroll
                    for (int bj = 0; bj < 2; ++bj) { const int m = 2 * mh + mm_; const size_t o = (size_t)(u.row0 + ai * HALF + wr * 64 + m * 16 + fr) * DM + colb + bj * HALF;
                        const u32x4 pw = pack8(xv[mm_][bj][0] + g[bj][0] * acc[ai][bj][m][0], xv[mm_][bj][1] + g[bj][1] * acc[ai][bj][m][1]);
                        *(u32x4*)(X1 + o) = pw;
                        const float q0 = bflo(pw.x), q1 = bfhi(pw.x), q2 = bflo(pw.y), q3 = bfhi(pw.y), q4 = bflo(pw.z), q5 = bfhi(pw.z), q6 = bflo(pw.w), q7 = bfhi(pw.w);
                        ssq[mm_] += (q0 * q0 + q1 * q1) + (q2 * q2 + q3 * q3) + (q4 * q4 + q5 * q5) + (q6 * q6 + q7 * q7); }
#pragma unroll
                for (int mm_ = 0; mm_ < 2; ++mm_) { float s = ssq[mm_]; s += __shfl_xor(s, 16); s += __shfl_xor(s, 32);
                    if (fq == 0) SSP[(size_t)(u.row0 + ai * HALF + wr * 64 + (2 * mh + mm_) * 16 + fr) * 16 + (u.col0 >> 8) * 4 + wc] = s; }
                asm volatile("" ::: "memory");
            }
    }
};

template <class Epi, class Sched, bool GATHER, bool ALIGN_EPI = true, bool SP2 = true>
__device__ __forceinline__ void gemm_phase(LAS unsigned char* lds, const Gemm g, const Sched& S, const Epi& E) {
    int tid = threadIdx.x; asm volatile("" : "+v"(tid));
    const int wid = __builtin_amdgcn_readfirstlane(tid >> 6), lane = tid & 63, wr = wid >> 2, wc = wid & 3, fr = lane & 15, fq = lane >> 4;
    const int K = g.K, nt = K / BK;
    int Rr[2], Cc[2]; unsigned voffB[2];
#pragma unroll
    for (int i = 0; i < 2; ++i) { stage_rc(tid * 16 + i * 8192, Rr[i], Cc[i]); const int Rb = (Rr[i] & ~31) + perm32(Rr[i] & 31); voffB[i] = (unsigned)(Rb * K + Cc[i]) * 2u; }
    const size_t kstep = (size_t)(BK * 2);
    const size_t hstep = (size_t)HALF * K * 2;
    const unsigned ldsw = (unsigned)wid * 1024u;
    const int aoff = lds_byte(wr * 64 + fr, fq * 8), boff = lds_byte(wc * 32 + fr, fq * 8);
#define PG8_MKOFF(u, vo) do { _Pragma("unroll") for (int _h = 0; _h < 2; ++_h) _Pragma("unroll") for (int _i = 0; _i < 2; ++_i) { \
        if (GATHER) { const int _pos = (u).gp + _h * HALF + Rr[_i]; const int _tok = g.LIST[(u).ge * NTOK + (_pos < g.mm[(u).ge] ? _pos : 0)]; (vo)[_h][_i] = (unsigned)(_tok * K + Cc[_i]) * 2u; } \
        else (vo)[_h][_i] = (unsigned)((_h * HALF + Rr[_i]) * K + Cc[_i]) * 2u; } } while (0)
#define PG8_SA(b, h) (((b) * 2 + (h)) * HTB)
#define PG8_SB(b, h) ((4 + (b) * 2 + (h)) * HTB)
#define PG8_STAGE(bufoff, gbase, voff) do { _Pragma("unroll") for (int _i = 0; _i < 2; ++_i) \
        __builtin_amdgcn_global_load_lds((const unsigned*)((const char*)(gbase) + (voff)[_i]), (LAS unsigned*)(lds + (bufoff) + ldsw + _i * 8192), 16, 0, 0); } while (0)
#define PG8_LDA(dst, b, h) do { _Pragma("unroll") for (int m = 0; m < 4; ++m) _Pragma("unroll") for (int k = 0; k < 2; ++k) dst[m][k] = *(const LAS bf16x8*)(lds + PG8_SA(b, h) + aoff + m * 2048 + k * 1024); } while (0)
#define PG8_LDB(dst, b, h) do { _Pragma("unroll") for (int n = 0; n < 2; ++n) _Pragma("unroll") for (int k = 0; k < 2; ++k) dst[n][k] = *(const LAS bf16x8*)(lds + PG8_SB(b, h) + boff + n * 2048 + k * 1024); } while (0)
#define PG8_MMA(ai, bj, At, Bt) do { __builtin_amdgcn_s_setprio(1); _Pragma("unroll") for (int m = 0; m < 4; ++m) _Pragma("unroll") for (int n = 0; n < 2; ++n) _Pragma("unroll") for (int k = 0; k < 2; ++k) \
        acc[ai][bj][m][n] = __builtin_amdgcn_mfma_f32_16x16x32_bf16(Bt[n][k], At[m][k], acc[ai][bj][m][n], 0, 0, 0); __builtin_amdgcn_s_setprio(0); } while (0)
#define PG8_WAIT_V(n) asm volatile("s_waitcnt vmcnt(" #n ")" ::: "memory")
#define PG8_WAIT_L(n) asm volatile("s_waitcnt lgkmcnt(" #n ")" ::: "memory")
#define PG8_BAR __builtin_amdgcn_s_barrier()
#define PG8_SCHED __builtin_amdgcn_sched_barrier(0)
    Unit cur, nxt; int ui = 0;
    if (!S.next(0, cur)) return;
    f32x4 acc[2][2][4][2];
#pragma unroll
    for (int a = 0; a < 2; ++a)
#pragma unroll
        for (int b = 0; b < 2; ++b)
#pragma unroll
            for (int m = 0; m < 4; ++m)
#pragma unroll
                for (int n = 0; n < 2; ++n) acc[a][b][m][n] = (f32x4){0.f, 0.f, 0.f, 0.f};
    bf16x8 At[4][2], B0[2][2], B1[2][2];
    unsigned voffA[2][2], nvoffA[2][2];
    PG8_MKOFF(cur, voffA);
    const char* cA = cur.A; const char* cB = cur.B;
    if constexpr (SP2) {
        PG8_STAGE(PG8_SB(0, 0), cB, voffB); PG8_STAGE(PG8_SB(0, 1), cB + hstep, voffB); PG8_STAGE(PG8_SA(0, 0), cA, voffA[0]); PG8_STAGE(PG8_SA(0, 1), cA, voffA[1]);
        if (wr == 1) PG8_BAR;
        PG8_WAIT_V(2); PG8_BAR;
        PG8_STAGE(PG8_SB(1, 0), cB + kstep, voffB); PG8_STAGE(PG8_SA(1, 0), cA + kstep, voffA[0]); PG8_STAGE(PG8_SB(1, 1), cB + hstep + kstep, voffB);
        PG8_WAIT_V(6); PG8_BAR;
    } else {
        PG8_STAGE(PG8_SB(0, 0), cB, voffB); PG8_STAGE(PG8_SA(0, 0), cA, voffA[0]); PG8_STAGE(PG8_SB(0, 1), cB + hstep, voffB); PG8_STAGE(PG8_SA(0, 1), cA, voffA[1]);
        if (wr == 1) PG8_BAR;
        PG8_WAIT_V(4); PG8_BAR;
        PG8_STAGE(PG8_SB(1, 0), cB + kstep, voffB); PG8_STAGE(PG8_SA(1, 0), cA + kstep, voffA[0]); PG8_STAGE(PG8_SB(1, 1), cB + hstep + kstep, voffB);
        PG8_WAIT_V(6); PG8_BAR;
    }
    for (;;) {
        const bool has_next = S.next(ui + 1, nxt);
        if (has_next) { PG8_MKOFF(nxt, nvoffA); }
        else {
#pragma unroll
            for (int h = 0; h < 2; ++h)
#pragma unroll
                for (int i = 0; i < 2; ++i) nvoffA[h][i] = voffA[h][i]; }
        const char* nA = has_next ? nxt.A : cA; const char* nB = has_next ? nxt.B : cB;
        for (int t = 0; t < nt; t += 2) {
            const bool last = (t == nt - 2);
            const char* a1 = cA + (size_t)(t + 1) * kstep;
            const char* a2 = last ? nA : cA + (size_t)(t + 2) * kstep; const char* b2 = last ? nB : cB + (size_t)(t + 2) * kstep;
            const char* a3 = a2 + kstep; const char* b3 = b2 + kstep;
            unsigned v2[2][2];
#pragma unroll
            for (int h = 0; h < 2; ++h)
#pragma unroll
                for (int i = 0; i < 2; ++i) v2[h][i] = last ? nvoffA[h][i] : voffA[h][i];
            if constexpr (SP2) {
            PG8_LDB(B0, 0, 0); PG8_LDB(B1, 0, 1); PG8_SCHED; PG8_LDA(At, 0, 0); PG8_STAGE(PG8_SA(1, 1), a1, voffA[1]);
            PG8_WAIT_V(8); PG8_WAIT_L(0); PG8_BAR; PG8_MMA(0, 0, At, B0); PG8_MMA(0, 1, At, B1); PG8_BAR; PG8_SCHED;
            PG8_LDA(At, 0, 1); PG8_STAGE(PG8_SB(0, 0), b2, voffB); PG8_STAGE(PG8_SB(0, 1), b2 + hstep, voffB); PG8_STAGE(PG8_SA(0, 0), a2, v2[0]);
            PG8_WAIT_V(8); PG8_WAIT_L(0); PG8_BAR; PG8_MMA(1, 0, At, B0); PG8_MMA(1, 1, At, B1); PG8_BAR; PG8_SCHED;
            PG8_LDB(B0, 1, 0); PG8_LDB(B1, 1, 1); PG8_SCHED; PG8_LDA(At, 1, 0); PG8_STAGE(PG8_SA(0, 1), a2, v2[1]);
            PG8_WAIT_V(8); PG8_WAIT_L(0); PG8_BAR; PG8_MMA(0, 0, At, B0); PG8_MMA(0, 1, At, B1); PG8_BAR; PG8_SCHED;
            PG8_LDA(At, 1, 1); PG8_STAGE(PG8_SB(1, 0), b3, voffB); PG8_STAGE(PG8_SB(1, 1), b3 + hstep, voffB); PG8_STAGE(PG8_SA(1, 0), a3, v2[0]);
            PG8_WAIT_V(8); PG8_WAIT_L(0); PG8_BAR; PG8_MMA(1, 0, At, B0); PG8_MMA(1, 1, At, B1); PG8_BAR; PG8_SCHED;
            } else {
            PG8_LDB(B0, 0, 0); PG8_SCHED; PG8_LDA(At, 0, 0); PG8_STAGE(PG8_SA(1, 1), a1, voffA[1]);
            PG8_WAIT_L(8); PG8_BAR; PG8_WAIT_L(0); PG8_MMA(0, 0, At, B0); PG8_BAR; PG8_SCHED;
            PG8_LDB(B1, 0, 1); PG8_STAGE(PG8_SB(0, 0), b2, voffB);
            PG8_BAR; PG8_WAIT_L(0); PG8_MMA(0, 1, At, B1); PG8_BAR;
            PG8_LDA(At, 0, 1); PG8_STAGE(PG8_SA(0, 0), a2, v2[0]);
            PG8_BAR; PG8_WAIT_L(0); PG8_MMA(1, 0, At, B0); PG8_BAR; PG8_SCHED;
            PG8_STAGE(PG8_SB(0, 1), b2 + hstep, voffB);
            PG8_WAIT_V(6); PG8_BAR; PG8_MMA(1, 1, At, B1); PG8_BAR;
            PG8_LDB(B0, 1, 0); PG8_SCHED; PG8_LDA(At, 1, 0); PG8_STAGE(PG8_SA(0, 1), a2, v2[1]);
            PG8_WAIT_L(8); PG8_BAR; PG8_WAIT_L(0); PG8_MMA(0, 0, At, B0); PG8_BAR; PG8_SCHED;
            PG8_LDB(B1, 1, 1); PG8_STAGE(PG8_SB(1, 0), b3, voffB);
            PG8_BAR; PG8_WAIT_L(0); PG8_MMA(0, 1, At, B1); PG8_BAR;
            PG8_LDA(At, 1, 1); PG8_STAGE(PG8_SA(1, 0), a3, v2[0]);
            PG8_BAR; PG8_WAIT_L(0); PG8_MMA(1, 0, At, B0); PG8_BAR; PG8_SCHED;
            PG8_STAGE(PG8_SB(1, 1), b3 + hstep, voffB);
            PG8_WAIT_V(6); PG8_BAR; PG8_MMA(1, 1, At, B1); PG8_BAR;
            }
        }
        if constexpr (ALIGN_EPI) { if (wr == 0) PG8_BAR; }
        E(acc, cur, wr, wc, fr, fq);
        if (!has_next) break;
#pragma unroll
        for (int a = 0; a < 2; ++a)
#pragma unroll
            for (int b = 0; b < 2; ++b)
#pragma unroll
                for (int m = 0; m < 4; ++m)
#pragma unroll
                    for (int n = 0; n < 2; ++n) acc[a][b][m][n] = (f32x4){0.f, 0.f, 0.f, 0.f};
        cur = nxt; cA = nA; cB = nB; ++ui;
#pragma unroll
        for (int h = 0; h < 2; ++h)
#pragma unroll
            for (int i = 0; i < 2; ++i) voffA[h][i] = nvoffA[h][i];
        if constexpr (ALIGN_EPI) { if (wr == 1) PG8_BAR; }
    }
    PG8_WAIT_V(0);
    if constexpr (!ALIGN_EPI) { if (wr == 0) PG8_BAR; }
    PG8_BAR;
#undef PG8_MKOFF
#undef PG8_SA
#undef PG8_SB
#undef PG8_STAGE
#undef PG8_LDA
#undef PG8_LDB
#undef PG8_MMA
#undef PG8_WAIT_V
#undef PG8_WAIT_L
#undef PG8_BAR
#undef PG8_SCHED
}
__device__ __forceinline__ int xcd_remap(int L, int nwg) { const int q = nwg / 8, r = nwg % 8, xcd = L % 8, off = L / 8; return (xcd < r ? xcd * (q + 1) : r * (q + 1) + (xcd - r) * q) + off; }
}

constexpr int LDS_MM_OFF = 131072;

struct OrderInProj { int G, c; const char* H; const char* W;
    __device__ __forceinline__ bool next(int i, pg8::Unit& u) const {
        const int L = i * G + c; if (L >= 1792) return false;
        int pmg, pn;
        if (L < 1664) { const int wgid = pg8::xcd_remap(L, 1664); const int nig = 8 * 13, gid = wgid / nig, p = gid * 8 + ((wgid % nig) & 7); pn = (wgid % nig) >> 3; pmg = (p >> 3) * 9 + 1 + (p & 7); }
        else { const int idx = L - 1664, p = idx & 15, ci = idx >> 4; pmg = p * 9; pn = ci < 4 ? 2 + ci : (ci < 7 ? 3 + ci : 12); }
        u.A = H + (size_t)pmg * 256 * 2048; u.B = W + (size_t)pn * 256 * 2048; u.row0 = pmg * 256; u.col0 = pn * 256; u.ge = -1; u.gp = 0; return true; } };
struct OrderOutProj { int G, c; const char* A; const char* W;
    __device__ __forceinline__ bool next(int i, pg8::Unit& u) const {
        const int L = i * G + c; if (L >= 512) return false;
        const int wgid = pg8::xcd_remap(L, 512); const int nig = 8 * 4, gid = wgid / nig, pm = gid * 8 + ((wgid % nig) & 7), pn = (wgid % nig) >> 3;
        u.A = A + (size_t)pm * 256 * 2048; u.B = W + (size_t)pn * 256 * 2048; u.row0 = pm * 256; u.col0 = pn * 256; u.ge = -1; u.gp = 0; return true; } };
struct OrderGateUp { int G, c; const char* H2; const char* W; const LAS int* mm;
    __device__ __forceinline__ bool next(int i, pg8::Unit& u) const {
        const int nwg = mm[64] * 4, L = i * G + c; if (L >= nwg) return false;
        const int wgid = pg8::xcd_remap(L, nwg), tt = wgid >> 2, pn = wgid & 3, e = moe_tile_expert(mm, tt);
        u.A = H2; u.B = W + ((size_t)e * 1024 + pn * 256) * 2048; u.row0 = tt * 256; u.col0 = pn * 256; u.ge = e; u.gp = (tt - mm[32 + e]) * 256; return true; } };
struct OrderDown { int G, c; const char* HM; const char* W; const LAS int* mm;
    __device__ __forceinline__ bool next(int i, pg8::Unit& u) const {
        const int nwg = mm[64] * 4, L = i * G + c; if (L >= nwg) return false;
        const int wgid = pg8::xcd_remap(L, nwg), tt = wgid >> 2, pn = wgid & 3, e = moe_tile_expert(mm, tt);
        u.A = HM + (size_t)tt * 256 * 1024; u.B = W + ((size_t)e * 1024 + pn * 256) * 1024; u.row0 = tt * 256; u.col0 = pn * 256; u.ge = -1; u.gp = 0; return true; } };

__device__ __forceinline__ void ph_inproj(const Ctx& c, LAS unsigned char* lds) {
    pg8::Gemm g{1024, nullptr, nullptr}; OrderInProj S{(int)gridDim.x, (int)blockIdx.x, (const char*)(c.ws + WS_H), (const char*)(c.ws + WS_WIN_T)};
    pg8::Epi8<EpiInProj> E{EpiInProj{c.ws}};
    pg8::gemm_phase<pg8::Epi8<EpiInProj>, OrderInProj, false>(lds, g, S, E);
}
__device__ __forceinline__ void ph_outproj(const Ctx& c, LAS unsigned char* lds) {
    pg8::Gemm g{1024, nullptr, nullptr}; OrderOutProj S{(int)gridDim.x, (int)blockIdx.x, (const char*)(c.ws + WS_MIX), (const char*)(c.ws + WS_WOUT_T)};
    pg8::EpiOutProjB E{c.x, (const float*)(c.ws + WS_MOD), (bf16*)(c.ws + WS_X1), (float*)(c.ws + WS_SSP)};
    pg8::gemm_phase<pg8::EpiOutProjB, OrderOutProj, false>(lds, g, S, E);
}
__device__ __forceinline__ void ph_gateup(const Ctx& c, LAS unsigned char* lds) {
    LAS int* mm = (LAS int*)(lds + LDS_MM_OFF); moe_build(mm, (const unsigned*)(c.ws + WS_CTL));
    pg8::Gemm g{1024, (const int*)(c.ws + WS_LIST), mm}; OrderGateUp S{(int)gridDim.x, (int)blockIdx.x, (const char*)(c.ws + WS_H2), (const char*)(c.ws + WS_WGU_T), mm};
    pg8::Epi8<EpiGateUp> E{EpiGateUp{(bf16*)(c.ws + WS_HMID)}};
    pg8::gemm_phase<pg8::Epi8<EpiGateUp>, OrderGateUp, true>(lds, g, S, E);
}
__device__ __forceinline__ void ph_down(const Ctx& c, LAS unsigned char* lds) {
    LAS int* mm = (LAS int*)(lds + LDS_MM_OFF); moe_build(mm, (const unsigned*)(c.ws + WS_CTL));
    pg8::Gemm g{512, nullptr, mm}; OrderDown S{(int)gridDim.x, (int)blockIdx.x, (const char*)(c.ws + WS_HMID), (const char*)(c.ws + WS_WD_T), mm};
    pg8::Epi8<EpiDown> E{EpiDown{(bf16*)(c.ws + WS_YB)}};
    pg8::gemm_phase<pg8::Epi8<EpiDown>, OrderDown, false>(lds, g, S, E);
}

__device__ __forceinline__ float da_lambda_full(const float* lp) {
    float s0 = 0.f, s1 = 0.f;
    for (int i = 0; i < 64; ++i) { s0 += lp[i] * lp[64 + i]; s1 += lp[128 + i] * lp[192 + i]; }
    return expf(s0) - expf(s1) + LAMBDA_INIT;
}
namespace da {
typedef short bf16x8 __attribute__((ext_vector_type(8)));
typedef short s16x4 __attribute__((ext_vector_type(4)));
typedef float f32x16 __attribute__((ext_vector_type(16)));
typedef float f32x2_t __attribute__((ext_vector_type(2))); typedef __bf16 bf16x2_t __attribute__((ext_vector_type(2)));
__device__ __forceinline__ unsigned cvtpk(float lo, float hi) { f32x2_t v = {lo, hi}; bf16x2_t b = __builtin_convertvector(v, bf16x2_t); return __builtin_bit_cast(unsigned, b); }
__device__ __forceinline__ bf16x8 pack_half(const f32x16& x, int s) {
    u32x4 p; p.x = cvtpk(x[8 * s], x[8 * s + 1]); p.y = cvtpk(x[8 * s + 2], x[8 * s + 3]); p.z = cvtpk(x[8 * s + 4], x[8 * s + 5]); p.w = cvtpk(x[8 * s + 6], x[8 * s + 7]);
    return __builtin_bit_cast(bf16x8, p); }
__device__ __forceinline__ s16x4 vtr(const LAS unsigned char* p) { return __builtin_bit_cast(s16x4, __builtin_amdgcn_ds_read_tr16_b64_v4i16((LAS s16x4*)p)); }
#define DA_MFMA(a, b, c) __builtin_amdgcn_mfma_f32_32x32x16_bf16((a), (b), (c), 0, 0, 0)
constexpr int NT = KVL / 64;
constexpr int QS_OFF = 81920;

template <int KB> __device__ __forceinline__ void qk_tile(const LAS unsigned char* kq, const bf16x8 (&qf)[4], const f32x16& negm, f32x16& s0, f32x16& s1) {
#pragma unroll
    for (int ks = 0; ks < 4; ++ks) {
        const bf16x8 k0 = *(const LAS bf16x8*)(kq + KB + ks * 2048), k1 = *(const LAS bf16x8*)(kq + KB + ks * 2048 + 512), qq = qf[ks];
        if (ks == 0) { s0 = DA_MFMA(k0, qq, negm); s1 = DA_MFMA(k1, qq, negm); } else { s0 = DA_MFMA(k0, qq, s0); s1 = DA_MFMA(k1, qq, s1); } }
}
__device__ __forceinline__ float max3f(float a, float b, float c) { return fmaxf(fmaxf(a, b), c); }
template <int VB> __device__ __forceinline__ void softmax_pv(const LAS unsigned char* lds, int vlane, f32x16& s0, f32x16& s1, f32x16 (&O)[4], f32x16& negm, float& lrun) {
    float ma = max3f(s0[0], s0[1], s1[0]), mb = max3f(s0[2], s0[3], s1[1]); ma = max3f(ma, s1[2], s1[3]);
#pragma unroll
    for (int r = 4; r < 16; r += 4) { ma = max3f(ma, s0[r], s0[r + 1]); mb = max3f(mb, s0[r + 2], s0[r + 3]); ma = max3f(ma, s1[r], s1[r + 1]); mb = max3f(mb, s1[r + 2], s1[r + 3]); }
    float mx = fmaxf(ma, mb);
    mx = fmaxf(mx, __shfl_xor(mx, 32));
    if (__any(mx > 8.0f)) {
        const float dl = fmaxf(mx, 0.f), alpha = __builtin_amdgcn_exp2f(-dl);
        lrun *= alpha;
#pragma unroll
        for (int r = 0; r < 16; ++r) { s0[r] -= dl; s1[r] -= dl; negm[r] -= dl; }
#pragma unroll
        for (int dt = 0; dt < 4; ++dt)
#pragma unroll
            for (int r = 0; r < 16; ++r) O[dt][r] *= alpha;
    }
    float ps = 0.f;
#pragma unroll
    for (int r = 0; r < 16; ++r) { s0[r] = __builtin_amdgcn_exp2f(s0[r]); s1[r] = __builtin_amdgcn_exp2f(s1[r]); ps += s0[r] + s1[r]; }
    lrun += ps;
    bf16x8 P[4];
    P[0] = pack_half(s0, 0); P[1] = pack_half(s0, 1); P[2] = pack_half(s1, 0); P[3] = pack_half(s1, 1);
    const unsigned vb = (unsigned)(size_t)(lds + VB + vlane);
    s16x4 fa[8], fb[8];
#define DA_VRD(dst, dt) do { _Pragma("unroll") for (int _k = 0; _k < 4; ++_k) { \
        asm volatile("ds_read_b64_tr_b16 %0, %1 offset:%2" : "=&v"(dst[2 * _k]) : "v"(vb), "n"(((dt) * 4 + _k) * 1024) : "memory"); \
        asm volatile("ds_read_b64_tr_b16 %0, %1 offset:%2" : "=&v"(dst[2 * _k + 1]) : "v"(vb), "n"(((dt) * 4 + _k) * 1024 + 512) : "memory"); } } while (0)
#define DA_VWAIT(N, f) asm volatile("s_waitcnt lgkmcnt(" #N ")" : "+v"(f[0]), "+v"(f[1]), "+v"(f[2]), "+v"(f[3]), "+v"(f[4]), "+v"(f[5]), "+v"(f[6]), "+v"(f[7]) :: "memory")
#define DA_PVM(f, dt) do { _Pragma("unroll") for (int _k = 0; _k < 4; ++_k) O[dt] = DA_MFMA(__builtin_shufflevector(f[2 * _k], f[2 * _k + 1], 0, 1, 2, 3, 4, 5, 6, 7), P[_k], O[dt]); } while (0)
    DA_VRD(fa, 0);
    DA_VRD(fb, 1); DA_VWAIT(8, fa); DA_PVM(fa, 0);
    DA_VRD(fa, 2); DA_VWAIT(8, fb); DA_PVM(fb, 1);
    DA_VRD(fb, 3); DA_VWAIT(8, fa); DA_PVM(fa, 2);
    DA_VWAIT(0, fb); DA_PVM(fb, 3);
#undef DA_VRD
#undef DA_VWAIT
#undef DA_PVM
}

template <int m> __device__ __forceinline__ void attn_body(const Ctx& c, LAS unsigned char* lds) {
    const int tid = threadIdx.x, lane = tid & 63, wid = __builtin_amdgcn_readfirstlane(tid >> 6), r32 = lane & 31, hi = lane >> 5;
    const int qsub = wid & 3;
    const bf16* Q = (const bf16*)(c.ws + WS_QDA); const bf16* K = (const bf16*)(c.ws + WS_KDA); const bf16* V = (const bf16*)(c.ws + WS_VDA); bf16* MIX = (bf16*)(c.ws + WS_MIX);
    const float lam = da_lambda_full(c.da_lambda);
    const int vlane = (4 * hi + ((lane & 15) >> 2)) * 64 + ((lane >> 4) & 1) * 32 + (lane & 3) * 8;
    const LAS unsigned char* kq = lds + (m * 8 + hi) * 1024 + r32 * 16;
    const unsigned kgo0 = (unsigned)(lane * 512 + (wid * 2) * 8) * 2u, kgo1 = kgo0 + 16u;
    const unsigned vgo0 = (unsigned)((((wid * 2) & 3) * 16 + (lane >> 2)) * 512 + ((wid * 2) >> 2) * 32 + (lane & 3) * 8) * 2u, vgo1 = vgo0 + 16u * 512u * 2u;
    for (int it = 0;; ++it) {
        const int L = it * (int)gridDim.x + (int)blockIdx.x; if (L >= 1024) break;
        const int wg = pg8::xcd_remap(L, 1024), bh = wg >> 4, qb = wg & 15, b = bh >> 2, h = bh & 3;
        const char* Kb = (const char*)(K + (size_t)b * KVL * 512 + h * 128); const char* Vb = (const char*)(V + (size_t)b * KVL * 512 + h * 128);
        const size_t qrow = (size_t)b * SEQ + qb * 128 + qsub * 32 + r32;
#define DA_DMA_K(t, bo) do { const size_t _to = (size_t)(t) * (64 * 512 * 2); \
            __builtin_amdgcn_global_load_lds((const unsigned*)(Kb + _to + kgo0), (LAS unsigned*)(lds + (bo) + (wid * 2) * 1024), 16, 0, 0); \
            __builtin_amdgcn_global_load_lds((const unsigned*)(Kb + _to + kgo1), (LAS unsigned*)(lds + (bo) + (wid * 2 + 1) * 1024), 16, 0, 0); } while (0)
#define DA_DMA_V(t, bo) do { const size_t _to = (size_t)(t) * (64 * 512 * 2); \
            __builtin_amdgcn_global_load_lds((const unsigned*)(Vb + _to + vgo0), (LAS unsigned*)(lds + (bo) + (wid * 2) * 1024), 16, 0, 0); \
            __builtin_amdgcn_global_load_lds((const unsigned*)(Vb + _to + vgo1), (LAS unsigned*)(lds + (bo) + (wid * 2 + 1) * 1024), 16, 0, 0); } while (0)
        DA_DMA_K(0, 0); DA_DMA_K(1, 16384); DA_DMA_K(2, 32768); DA_DMA_V(0, 65536); DA_DMA_V(1, 81920);
        bf16x8 qf[4];
#pragma unroll
        for (int ks = 0; ks < 4; ++ks) qf[ks] = *(const bf16x8*)(Q + qrow * 512 + h * 128 + m * 64 + ks * 16 + hi * 8);
        f32x16 O[4];
#pragma unroll
        for (int dt = 0; dt < 4; ++dt)
#pragma unroll
            for (int r = 0; r < 16; ++r) O[dt][r] = 0.f;
        float lrun = 0.f; f32x16 negm, s0, s1;
#pragma unroll
        for (int r = 0; r < 16; ++r) negm[r] = 0.f;
        asm volatile("s_waitcnt vmcnt(0) lgkmcnt(0)\n\ts_barrier" ::: "memory");
        if constexpr (m == 1) qk_tile<0>(kq, qf, negm, s0, s1);
#define DA_STEP(tt, KBC, KBN, KB3, VBC, VB2) do { \
            if ((tt) + 3 < NT) DA_DMA_K((tt) + 3, KB3); else DA_DMA_K(NT - 1, KB3); \
            if ((tt) + 2 < NT) DA_DMA_V((tt) + 2, VB2); else DA_DMA_V(NT - 1, VB2); \
            if constexpr (m == 0) { qk_tile<KBC>(kq, qf, negm, s0, s1); softmax_pv<VBC>(lds, vlane, s0, s1, O, negm, lrun); } \
            else { softmax_pv<VBC>(lds, vlane, s0, s1, O, negm, lrun); if ((tt) + 1 < NT) qk_tile<KBN>(kq, qf, negm, s0, s1); } \
            asm volatile("s_waitcnt vmcnt(4) lgkmcnt(0)\n\ts_barrier" ::: "memory"); } while (0)
        for (int t = 0; t < NT; t += 12) {
            DA_STEP(t + 0, 0, 16384, 49152, 65536, 98304);
            DA_STEP(t + 1, 16384, 32768, 0, 81920, 65536);
            DA_STEP(t + 2, 32768, 49152, 16384, 98304, 81920);
            DA_STEP(t + 3, 49152, 0, 32768, 65536, 98304);
            DA_STEP(t + 4, 0, 16384, 49152, 81920, 65536);
            DA_STEP(t + 5, 16384, 32768, 0, 98304, 81920);
            DA_STEP(t + 6, 32768, 49152, 16384, 65536, 98304);
            DA_STEP(t + 7, 49152, 0, 32768, 81920, 65536);
            DA_STEP(t + 8, 0, 16384, 49152, 98304, 81920);
            DA_STEP(t + 9, 16384, 32768, 0, 65536, 98304);
            DA_STEP(t + 10, 32768, 49152, 16384, 81920, 65536);
            DA_STEP(t + 11, 49152, 0, 32768, 98304, 81920);
        }
#undef DA_STEP
        asm volatile("s_waitcnt vmcnt(0) lgkmcnt(0)\n\ts_barrier" ::: "memory");
        const float lt = lrun + __shfl_xor(lrun, 32);
        LAS float* xch = (LAS float*)(lds + qsub * 16384) + lane;
        if (m == 1) { const float sc = lam / lt;
#pragma unroll
            for (int dt = 0; dt < 4; ++dt)
#pragma unroll
                for (int r = 0; r < 16; ++r) xch[(dt * 16 + r) * 64] = O[dt][r] * sc; }
        __syncthreads();
        if (m == 0) { const float i1 = 1.0f / lt; float ss = 0.f;
#pragma unroll
            for (int dt = 0; dt < 4; ++dt)
#pragma unroll
                for (int r = 0; r < 16; ++r) { const float a = O[dt][r] * i1 - xch[(dt * 16 + r) * 64]; O[dt][r] = a; ss += a * a; }
            ss += __shfl_xor(ss, 32);
            const float rstd = rsqrtf(ss * (1.0f / 128.0f) + NORM_EPS) * (1.0f - LAMBDA_INIT);
            bf16* orow = MIX + qrow * 1024 + h * 128;
#pragma unroll
            for (int dt = 0; dt < 4; ++dt)
#pragma unroll
                for (int g4 = 0; g4 < 4; ++g4) { const int d0 = 32 * dt + 8 * g4 + 4 * hi; const f32x4 gg = *(const f32x4*)(c.da_subln_g + d0);
                    u32x2 w; w.x = cvtpk(O[dt][4 * g4] * rstd * gg.x, O[dt][4 * g4 + 1] * rstd * gg.y); w.y = cvtpk(O[dt][4 * g4 + 2] * rstd * gg.z, O[dt][4 * g4 + 3] * rstd * gg.w);
                    *(u32x2*)(orow + d0) = w; } }
        __syncthreads();
#undef DA_DMA_K
#undef DA_DMA_V
    }
}
__device__ __forceinline__ void attn_phase(const Ctx& c, LAS unsigned char* lds) {
    if (__builtin_amdgcn_readfirstlane((int)threadIdx.x >> 8) == 0) attn_body<0>(c, lds); else attn_body<1>(c, lds);
}
#undef DA_MFMA
}

namespace gla {
using da::bf16x8; using da::s16x4; using da::f32x16; using da::cvtpk; using da::pack_half; using da::vtr;
#define GL_MFMA(a, b, c) __builtin_amdgcn_mfma_f32_32x32x16_bf16((a), (b), (c), 0, 0, 0)
constexpr int NTASK = NB * 4 * 2 * 36;
constexpr int PT64_BYTES = 8192;
constexpr int PTV_BYTES = 16384;

template <int CTRL, int RM, bool BC> __device__ __forceinline__ float dpp_get(float x) { return __builtin_bit_cast(float, __builtin_amdgcn_update_dpp(0, __builtin_bit_cast(int, x), CTRL, RM, 0xf, BC)); }
__device__ __forceinline__ float scan32(float x) {
    x += dpp_get<0x111, 0xf, true>(x); x += dpp_get<0x112, 0xf, true>(x); x += dpp_get<0x114, 0xf, true>(x); x += dpp_get<0x118, 0xf, true>(x);
    x += dpp_get<0x142, 0xa, false>(x);
    return x; }
__device__ __forceinline__ float last32(float x, int hi) {
    const float a = __builtin_bit_cast(float, __builtin_amdgcn_readlane(__builtin_bit_cast(int, x), 31)), b = __builtin_bit_cast(float, __builtin_amdgcn_readlane(__builtin_bit_cast(int, x), 63));
    return hi ? b : a; }
template <int DK0, int DK1> __device__ __forceinline__ void g0_task(const Ctx& c, const LAS unsigned char* w2f, const LAS float* gbs, int u, int lane, int r32, int hi) {
    bf16* KE = (bf16*)(c.ws + WS_KEND); bf16* QD = (bf16*)(c.ws + WS_QD); bf16* KI = (bf16*)(c.ws + WS_KI); float* DB = (float*)(c.ws + WS_DB);
        const int cc = u % 36, chain = u / 36, dir = chain & 1, h = (chain >> 1) & 3, b = chain >> 3, bh = chain >> 1;
        const bool lat = cc >= 4;
        const size_t row0 = (size_t)b * KVL + cc * 64 + r32;
        bf16x8 lrh[2], lrl[2];
#pragma unroll
        for (int T = 0; T < 2; ++T) { const float* lr = (const float*)(c.ws + WS_LR) + (row0 + 32 * T) * 32 + dir * 16 + 8 * hi;
            const f32x4 x0 = *(const f32x4*)lr, x1 = *(const f32x4*)(lr + 4);
            u32x4 ph; ph.x = pk2(x0.x, x0.y); ph.y = pk2(x0.z, x0.w); ph.z = pk2(x1.x, x1.y); ph.w = pk2(x1.z, x1.w);
            u32x4 pl; pl.x = pk2(x0.x - bflo(ph.x), x0.y - bfhi(ph.x)); pl.y = pk2(x0.z - bflo(ph.y), x0.w - bfhi(ph.y)); pl.z = pk2(x1.x - bflo(ph.z), x1.y - bfhi(ph.z)); pl.w = pk2(x1.z - bflo(ph.w), x1.w - bfhi(ph.w));
            lrh[T] = __builtin_bit_cast(bf16x8, ph); lrl[T] = __builtin_bit_cast(bf16x8, pl); }
        const bf16* kbase = (const bf16*)(c.ws + WS_GK) + row0 * 256 + h * 64;
        const bf16* qbase = (const bf16*)(c.ws + WS_GQ) + ((size_t)b * SEQ + (lat ? (cc - 4) * 64 + r32 : 0)) * 256 + h * 64;
        bf16* kebase = KE + ((size_t)u * 64 + r32) * 64;
        const size_t qo = (((size_t)(dir * 64 + bh) * 32 + (lat ? cc - 4 : 0)) * 64 + r32) * 64;
#pragma unroll
        for (int Dk = DK0; Dk < DK1; ++Dk) {
            const LAS unsigned char* wf = w2f + (((dir * 4 + h) * 2 + Dk) * 64 + lane) * 32;
            const bf16x8 wh = *(const LAS bf16x8*)wf, wl = *(const LAS bf16x8*)(wf + 16);
            f32x16 z[2];
#pragma unroll
            for (int T = 0; T < 2; ++T) {
#pragma unroll
                for (int r = 0; r < 16; ++r) z[T][r] = 0.f;
                z[T] = GL_MFMA(wh, lrh[T], z[T]); z[T] = GL_MFMA(wl, lrh[T], z[T]); z[T] = GL_MFMA(wh, lrl[T], z[T]); }
            u32x2 kv[2][4], qv[2][4];
#pragma unroll
            for (int T = 0; T < 2; ++T)
#pragma unroll
                for (int g4 = 0; g4 < 4; ++g4) { const int dko = 32 * Dk + 8 * g4 + 4 * hi; kv[T][g4] = *(const u32x2*)(kbase + (size_t)(32 * T) * 256 + dko); qv[T][g4] = *(const u32x2*)(qbase + (size_t)(lat ? 32 * T : 0) * 256 + dko); }
            float g[2][16], inc[2][16], dtot[16], tot[16];
#pragma unroll
            for (int g4 = 0; g4 < 4; ++g4) { const f32x4 bs = *(const LAS f32x4*)(gbs + dir * 256 + h * 64 + 32 * Dk + 8 * g4 + 4 * hi);
#pragma unroll
                for (int j = 0; j < 4; ++j)
#pragma unroll
                    for (int T = 0; T < 2; ++T) { const float zz = z[T][4 * g4 + j] + bs[j];
                        const float t = __builtin_amdgcn_exp2f(-fabsf(zz) * 1.4426950408889634f);
                        g[T][4 * g4 + j] = (fminf(zz, 0.f) - __builtin_amdgcn_logf(1.0f + t) * 0.6931471805599453f) * (1.0f / 16.0f); } }
#pragma unroll
            for (int r = 0; r < 16; ++r) { inc[0][r] = scan32(g[0][r]); const float l0 = last32(inc[0][r], hi); inc[1][r] = scan32(g[1][r]) + l0; tot[r] = last32(inc[1][r], hi); dtot[r] = __builtin_amdgcn_exp2f(tot[r] * 1.4426950408889634f); }
#pragma unroll
            for (int T = 0; T < 2; ++T)
#pragma unroll
                for (int g4 = 0; g4 < 4; ++g4) { const int dko = 32 * Dk + 8 * g4 + 4 * hi;
                    float eq[4], ek[4], ee[4];
#pragma unroll
                    for (int j = 0; j < 4; ++j) { const int r = 4 * g4 + j; const float bc = dir == 0 ? inc[T][r] : tot[r] - inc[T][r] + g[T][r];
                        eq[j] = __builtin_amdgcn_exp2f(bc * 1.4426950408889634f); ek[j] = __builtin_amdgcn_rcpf(eq[j]); ee[j] = ek[j] * dtot[r]; }
                    const float k0 = bflo(kv[T][g4].x), k1 = bfhi(kv[T][g4].x), k2 = bflo(kv[T][g4].y), k3 = bfhi(kv[T][g4].y);
                    u32x2 e2; e2.x = cvtpk(k0 * ee[0], k1 * ee[1]); e2.y = cvtpk(k2 * ee[2], k3 * ee[3]);
                    *(u32x2*)(kebase + (size_t)(32 * T) * 64 + dko) = e2;
                    if (lat) { const float q0 = bflo(qv[T][g4].x), q1 = bfhi(qv[T][g4].x), q2 = bflo(qv[T][g4].y), q3 = bfhi(qv[T][g4].y);
                        u32x2 a2, k2v; a2.x = cvtpk(q0 * eq[0], q1 * eq[1]); a2.y = cvtpk(q2 * eq[2], q3 * eq[3]); k2v.x = cvtpk(k0 * ek[0], k1 * ek[1]); k2v.y = cvtpk(k2 * ek[2], k3 * ek[3]);
                        *(u32x2*)(QD + qo + (size_t)(32 * T) * 64 + dko) = a2; *(u32x2*)(KI + qo + (size_t)(32 * T) * 64 + dko) = k2v; } }
            if (r32 == 0) {
#pragma unroll
                for (int g4 = 0; g4 < 4; ++g4) *(f32x4*)(DB + (size_t)u * 64 + 32 * Dk + 8 * g4 + 4 * hi) = (f32x4){dtot[4 * g4], dtot[4 * g4 + 1], dtot[4 * g4 + 2], dtot[4 * g4 + 3]}; }
        }
    }
__device__ __forceinline__ void g0_phase(const Ctx& c, LAS unsigned char* lds) {
    const int tid = threadIdx.x, lane = tid & 63, w = __builtin_amdgcn_readfirstlane(tid >> 6), r32 = lane & 31, hi = lane >> 5;
    LAS unsigned char* w2f = lds;
    LAS float* gbs = (LAS float*)(lds + 32768);
    for (int q = tid; q < 16 * 64; q += 512) { const int combo = q >> 6, l = q & 63, dir = combo >> 3, h = (combo >> 1) & 3, Dk = combo & 1, dk = h * 64 + 32 * Dk + (l & 31), hh = l >> 5;
        float v[8];
#pragma unroll
        for (int j = 0; j < 8; ++j) v[j] = c.gate_w2[(dir * 16 + 8 * hh + j) * 256 + dk];
        u32x4 ph; ph.x = pk2(v[0], v[1]); ph.y = pk2(v[2], v[3]); ph.z = pk2(v[4], v[5]); ph.w = pk2(v[6], v[7]);
        u32x4 pl; pl.x = pk2(v[0] - bflo(ph.x), v[1] - bfhi(ph.x)); pl.y = pk2(v[2] - bflo(ph.y), v[3] - bfhi(ph.y)); pl.z = pk2(v[4] - bflo(ph.z), v[5] - bfhi(ph.z)); pl.w = pk2(v[6] - bflo(ph.w), v[7] - bfhi(ph.w));
        *(LAS u32x4*)(w2f + q * 32) = ph; *(LAS u32x4*)(w2f + q * 32 + 16) = pl; }
    if (tid < 128) *(LAS f32x4*)(gbs + 4 * tid) = *(const f32x4*)(c.gate_b + 4 * tid);
    __syncthreads();
    const int gwv = blockIdx.x * 8 + w, ngw = gridDim.x * 8, nfull = (NTASK / ngw) * ngw;
    for (int u = gwv; u < nfull; u += ngw) g0_task<0, 2>(c, w2f, gbs, u, lane, r32, hi);
    for (int uh = gwv; uh < 2 * (NTASK - nfull); uh += ngw) { if (uh & 1) g0_task<1, 2>(c, w2f, gbs, nfull + (uh >> 1), lane, r32, hi); else g0_task<0, 1>(c, w2f, gbs, nfull + (uh >> 1), lane, r32, hi); }
    __syncthreads();
}
__device__ __forceinline__ void dma_piece(const bf16* base, int pitch, int p, LAS unsigned char* dst, int lane) {
    __builtin_amdgcn_global_load_lds((const unsigned*)(base + (size_t)((p & 3) * 16 + (lane >> 2)) * pitch + (p >> 2) * 32 + (lane & 3) * 8), (LAS unsigned*)(dst + p * 1024), 16, 0, 0);
}
__device__ __forceinline__ void dma_chunk(const bf16* tile, int row0, int ch, LAS unsigned char* dst, int lane) {
    __builtin_amdgcn_global_load_lds((const unsigned*)(tile + (size_t)(row0 + lane) * 64 + ch * 8), (LAS unsigned*)dst, 16, 0, 0);
}
__device__ __forceinline__ void g1_phase(const Ctx& c, LAS unsigned char* lds) {
    const int tid = threadIdx.x, lane = tid & 63, w = __builtin_amdgcn_readfirstlane(tid >> 6), hi = lane >> 5, dir = w >> 2, dvt = w & 3;
    const int vlane = (4 * hi + ((lane & 15) >> 2)) * 64 + ((lane >> 4) & 1) * 32 + (lane & 3) * 8;
    const bf16* KE = (const bf16*)(c.ws + WS_KEND); const bf16* GV = (const bf16*)(c.ws + WS_GV); bf16* UT = (bf16*)(c.ws + WS_UT);
    constexpr int BUF = 32768;
    const int nun = NB * 4 * 36;
#define G1_STAGE(un, bo) do { const int _cc = (un) % 36, _bh = (un) / 36, _b = _bh >> 2, _h = _bh & 3; \
        dma_piece(GV + ((size_t)_b * KVL + _cc * 64) * 512 + _h * 128, 512, w * 2, lds + (bo), lane); dma_piece(GV + ((size_t)_b * KVL + _cc * 64) * 512 + _h * 128, 512, w * 2 + 1, lds + (bo), lane); \
        dma_piece(KE + ((size_t)(_bh * 2) * 36 + _cc) * 4096, 64, w, lds + (bo) + 16384, lane); dma_piece(KE + ((size_t)(_bh * 2 + 1) * 36 + _cc) * 4096, 64, w, lds + (bo) + 24576, lane); } while (0)
    int un = blockIdx.x, par = 0;
    if (un < nun) G1_STAGE(un, 0);
    asm volatile("s_waitcnt vmcnt(0)" ::: "memory"); __syncthreads();
    for (; un < nun; un += gridDim.x, par ^= 1) {
        const int bo = par * BUF, nx = un + (int)gridDim.x;
        if (nx < nun) G1_STAGE(nx, BUF - bo);
        const int cc = un % 36, bh = un / 36;
        const LAS unsigned char* vpt = lds + bo; const LAS unsigned char* kend = lds + bo + 16384 + dir * 8192;
        f32x16 U[2];
#pragma unroll
        for (int dkt = 0; dkt < 2; ++dkt)
#pragma unroll
            for (int r = 0; r < 16; ++r) U[dkt][r] = 0.f;
#pragma unroll
        for (int ks = 0; ks < 4; ++ks) {
            const LAS unsigned char* bp = vpt + (dvt * 4 + ks) * 1024 + vlane; const s16x4 b0 = vtr(bp), b1 = vtr(bp + 512);
            const bf16x8 bfr = __builtin_shufflevector(b0, b1, 0, 1, 2, 3, 4, 5, 6, 7);
#pragma unroll
            for (int dkt = 0; dkt < 2; ++dkt) { const LAS unsigned char* ap = kend + (dkt * 4 + ks) * 1024 + vlane; const s16x4 a0 = vtr(ap), a1 = vtr(ap + 512);
                U[dkt] = GL_MFMA(__builtin_shufflevector(a0, a1, 0, 1, 2, 3, 4, 5, 6, 7), bfr, U[dkt]); } }
        const size_t task = ((size_t)(bh * 2 + dir)) * 36 + cc;
#pragma unroll
        for (int dkt = 0; dkt < 2; ++dkt) { bf16* up = UT + task * 8192 + (size_t)(dvt * 32 + (lane & 31)) * 64 + dkt * 32 + 4 * hi;
#pragma unroll
            for (int g4 = 0; g4 < 4; ++g4) { u32x2 wv; wv.x = cvtpk(U[dkt][4 * g4], U[dkt][4 * g4 + 1]); wv.y = cvtpk(U[dkt][4 * g4 + 2], U[dkt][4 * g4 + 3]); *(u32x2*)(up + 8 * g4) = wv; } }
        asm volatile("s_waitcnt vmcnt(0)" ::: "memory"); __syncthreads();
    }
#undef G1_STAGE
}
__device__ __forceinline__ void g2_phase(const Ctx& c) {
    const bf16* UT = (const bf16*)(c.ws + WS_UT); const float* DB = (const float*)(c.ws + WS_DB); bf16* ST = (bf16*)(c.ws + WS_ST);
    for (int i = blockIdx.x * blockDim.x + threadIdx.x; i < 128 * 1024; i += gridDim.x * blockDim.x) {
        const int chain = i >> 10, e8 = i & 1023, dk0 = (e8 & 7) * 8, dir = chain & 1, bh = chain >> 1;
        float S[8];
#pragma unroll
        for (int j = 0; j < 8; ++j) S[j] = 0.f;
#pragma unroll 4
        for (int s = 0; s < 36; ++s) {
            const int cc = dir == 0 ? s : (s < 4 ? 3 - s : 39 - s);
            if (cc >= 4) { u32x4 o; o.x = cvtpk(S[0], S[1]); o.y = cvtpk(S[2], S[3]); o.z = cvtpk(S[4], S[5]); o.w = cvtpk(S[6], S[7]);
                *(u32x4*)(ST + ((size_t)(dir * 64 + bh) * 32 + (cc - 4)) * 8192 + (size_t)e8 * 8) = o; }
            const size_t u = (size_t)chain * 36 + cc;
            const u32x4 uw = *(const u32x4*)(UT + u * 8192 + (size_t)e8 * 8); const f32x4 d0 = *(const f32x4*)(DB + u * 64 + dk0), d1 = *(const f32x4*)(DB + u * 64 + dk0 + 4);
            S[0] = S[0] * d0.x + bflo(uw.x); S[1] = S[1] * d0.y + bfhi(uw.x); S[2] = S[2] * d0.z + bflo(uw.y); S[3] = S[3] * d0.w + bfhi(uw.y);
            S[4] = S[4] * d1.x + bflo(uw.z); S[5] = S[5] * d1.y + bfhi(uw.z); S[6] = S[6] * d1.z + bflo(uw.w); S[7] = S[7] * d1.w + bfhi(uw.w);
        }
    }
}
__device__ __forceinline__ void g3_phase(const Ctx& c, LAS unsigned char* lds) {
    const int tid = threadIdx.x, lane = tid & 63, w = __builtin_amdgcn_readfirstlane(tid >> 6), r32 = lane & 31, hi = lane >> 5, ih = w >> 2, dq = w & 3;
    const int vlane = (4 * hi + ((lane & 15) >> 2)) * 64 + ((lane >> 4) & 1) * 32 + (lane & 3) * 8;
    const bf16* ST = (const bf16*)(c.ws + WS_ST); const bf16* GR = (const bf16*)(c.ws + WS_GR); const bf16* GV = (const bf16*)(c.ws + WS_GV); bf16* MIX = (bf16*)(c.ws + WS_MIX);
    const bf16* QD = (const bf16*)(c.ws + WS_QD); const bf16* KI = (const bf16*)(c.ws + WS_KI);
    constexpr int BUF = 49152;
    LAS float* ssx = (LAS float*)(lds + 2 * BUF);
    const int nun = NB * 4 * 32;
#define G3_STAGE(un, bo) do { const int _cl = (un) & 31, _bh = (un) >> 5, _b = _bh >> 2, _h = _bh & 3; \
        dma_piece(GV + ((size_t)_b * KVL + (_cl + 4) * 64) * 512 + _h * 128, 512, w * 2, lds + (bo), lane); dma_piece(GV + ((size_t)_b * KVL + (_cl + 4) * 64) * 512 + _h * 128, 512, w * 2 + 1, lds + (bo), lane); \
        _Pragma("unroll") for (int _d = 0; _d < 2; ++_d) { const size_t _tb = ((size_t)(_d * 64 + _bh) * 32 + _cl) * 4096; \
            dma_chunk(QD + _tb, 0, w, lds + (bo) + 16384 + _d * 8192 + w * 1024, lane); dma_chunk(KI + _tb, 0, w, lds + (bo) + 32768 + _d * 8192 + w * 1024, lane); } } while (0)
#define G3_LOADS(u_, sa_, gr_) do { const int _cl = (u_) & 31, _bh = (u_) >> 5, _b = _bh >> 2, _h = _bh & 3; const size_t _tl = (size_t)_b * SEQ + _cl * 64 + ih * 32 + r32; \
        _Pragma("unroll") for (int _d = 0; _d < 2; ++_d) _Pragma("unroll") for (int _k = 0; _k < 4; ++_k) sa_[_d][_k] = *(const bf16x8*)(ST + ((size_t)(_d * 64 + _bh) * 32 + _cl) * 8192 + (size_t)(dq * 32 + r32) * 64 + _k * 16 + hi * 8); \
        _Pragma("unroll") for (int _g = 0; _g < 4; ++_g) gr_[_g] = *(const u32x2*)(GR + _tl * 512 + _h * 128 + dq * 32 + 8 * _g + 4 * hi); } while (0)
    int un = blockIdx.x, par = 0;
    bf16x8 sa[2][4], san[2][4]; u32x2 gr[4], grn[4];
    if (un < nun) { G3_LOADS(un, sa, gr); G3_STAGE(un, 0); }
    asm volatile("s_waitcnt vmcnt(0)" ::: "memory"); __syncthreads();
    for (; un < nun; un += gridDim.x, par ^= 1) {
        const int bo = par * BUF, nx = un + (int)gridDim.x;
        const int cl = un & 31, bh = un >> 5, b = bh >> 2, h = bh & 3;
        const size_t tl = (size_t)b * SEQ + cl * 64 + ih * 32 + r32;
        if (nx < nun) { G3_LOADS(nx, san, grn); G3_STAGE(nx, BUF - bo); }
        const LAS unsigned char* vpt = lds + bo; const LAS unsigned char* qimg = lds + bo + 16384; const LAS unsigned char* kimg = lds + bo + 32768;
        f32x16 At[2];
#pragma unroll
        for (int jt = 0; jt < 2; ++jt)
#pragma unroll
            for (int r = 0; r < 16; ++r) At[jt][r] = 0.f;
        bf16x8 qf[2][4];
#pragma unroll
        for (int dir = 0; dir < 2; ++dir) {
#pragma unroll
            for (int ks = 0; ks < 4; ++ks) qf[dir][ks] = *(const LAS bf16x8*)(qimg + dir * 8192 + (2 * ks + hi) * 1024 + (ih * 32 + r32) * 16);
#pragma unroll
            for (int jt = 0; jt < 2; ++jt) { f32x16 T;
#pragma unroll
                for (int r = 0; r < 16; ++r) T[r] = 0.f;
#pragma unroll
                for (int ks = 0; ks < 4; ++ks) { const bf16x8 a = *(const LAS bf16x8*)(kimg + dir * 8192 + (2 * ks + hi) * 1024 + (jt * 32 + r32) * 16); T = GL_MFMA(a, qf[dir][ks], T); }
                const int icol = ih * 32 + r32;
#pragma unroll
                for (int r = 0; r < 16; ++r) { const int j = jt * 32 + (r & 3) + 8 * (r >> 2) + 4 * hi; const bool keep = dir == 0 ? (j <= icol) : (j >= icol); At[jt][r] += keep ? T[r] : 0.f; } }
        }
        bf16x8 P[4];
        P[0] = pack_half(At[0], 0); P[1] = pack_half(At[0], 1); P[2] = pack_half(At[1], 0); P[3] = pack_half(At[1], 1);
        f32x16 O;
#pragma unroll
        for (int r = 0; r < 16; ++r) O[r] = 0.f;
#pragma unroll
        for (int ks = 0; ks < 4; ++ks) { const LAS unsigned char* vp = vpt + (dq * 4 + ks) * 1024 + vlane; const s16x4 lo = vtr(vp), hh = vtr(vp + 512);
            O = GL_MFMA(__builtin_shufflevector(lo, hh, 0, 1, 2, 3, 4, 5, 6, 7), P[ks], O); }
#pragma unroll
        for (int dir = 0; dir < 2; ++dir)
#pragma unroll
            for (int ks = 0; ks < 4; ++ks) O = GL_MFMA(sa[dir][ks], qf[dir][ks], O);
        float ss = 0.f;
#pragma unroll
        for (int r = 0; r < 16; ++r) ss += O[r] * O[r];
        ss += __shfl_xor(ss, 32);
        if (hi == 0) ssx[dq * 64 + ih * 32 + r32] = ss;
        __syncthreads();
        const int tokl = ih * 32 + r32; const float tot = ssx[tokl] + ssx[64 + tokl] + ssx[128 + tokl] + ssx[192 + tokl];
        const float rstd = rsqrtf(tot * (1.0f / 128.0f) + NORM_EPS);
#pragma unroll
        for (int g4 = 0; g4 < 4; ++g4) { const int dv = dq * 32 + 8 * g4 + 4 * hi; const f32x4 gn = *(const f32x4*)(c.gla_norm_g + dv);
            u32x2 wv; wv.x = cvtpk(O[4 * g4] * rstd * gn.x * silu_f(bflo(gr[g4].x)), O[4 * g4 + 1] * rstd * gn.y * silu_f(bfhi(gr[g4].x)));
            wv.y = cvtpk(O[4 * g4 + 2] * rstd * gn.z * silu_f(bflo(gr[g4].y)), O[4 * g4 + 3] * rstd * gn.w * silu_f(bfhi(gr[g4].y)));
            *(u32x2*)(MIX + tl * 1024 + 512 + h * 128 + dv) = wv; }
        asm volatile("s_waitcnt vmcnt(0)" ::: "memory"); __syncthreads();
#pragma unroll
        for (int d = 0; d < 2; ++d)
#pragma unroll
            for (int k = 0; k < 4; ++k) sa[d][k] = san[d][k];
#pragma unroll
        for (int g4 = 0; g4 < 4; ++g4) gr[g4] = grn[g4];
    }
#undef G3_STAGE
#undef G3_LOADS
}
#undef GL_MFMA
}

template <bool DRY> __device__ __forceinline__ void ph_router(const Ctx& c, LAS unsigned char* lds) {
    typedef short bf16x8 __attribute__((ext_vector_type(8)));
    const int tid = threadIdx.x, lane = tid & 63, wave = tid >> 6, tk = lane & 15, kg = lane >> 4;
    const float* MOD = (const float*)(c.ws + WS_MOD); const bf16* X1 = (const bf16*)(c.ws + WS_X1); bf16* H2 = (bf16*)(c.ws + WS_H2);
    const bf16* WRT = (const bf16*)(c.ws + WS_WRT);
    int* ROUTE = (int*)(c.ws + WS_ROUTE); int* LIST = (int*)(c.ws + WS_LIST); unsigned* ctl = (unsigned*)(c.ws + WS_CTL);
    constexpr int WROW = 1040, WHALF = 36 * WROW;
    LAS unsigned char* whi = lds; LAS unsigned char* wlo = lds + WHALF;
    LAS int* bcnt = (LAS int*)(lds + 2 * WHALF);
    LAS int* rt = bcnt + 64;
    for (int base = blockIdx.x * 128; base < NTOK; base += gridDim.x * 128) {
        if (tid < 32) bcnt[tid] = 0;
        const int lt = wave * 16 + tk, tok = base + lt, bb = tok / SEQ;
        const bf16* xr = X1 + (size_t)tok * DM + 8 * kg; const float* gp = c.g_ffn + 8 * kg; const float* scp = MOD + bb * 6144 + 4096 + 8 * kg; const float* shp = MOD + bb * 6144 + 3072 + 8 * kg;
        f32x4 acc[3];
#pragma unroll
        for (int ct = 0; ct < 3; ++ct) acc[ct] = (f32x4){0.f, 0.f, 0.f, 0.f};
        const int arow0 = tk, arow1 = 16 + tk, arow2 = (32 + tk) < 36 ? 32 + tk : 35;
        float rstd; { const float* sp = (const float*)(c.ws + WS_SSP) + (size_t)tok * 16; const f32x4 p0 = *(const f32x4*)sp, p1 = *(const f32x4*)(sp + 4), p2 = *(const f32x4*)(sp + 8), p3 = *(const f32x4*)(sp + 12);
            const float ss = (((p0.x + p0.y) + (p0.z + p0.w)) + ((p1.x + p1.y) + (p1.z + p1.w))) + (((p2.x + p2.y) + (p2.z + p2.w)) + ((p3.x + p3.y) + (p3.z + p3.w)));
            rstd = rsqrtf(ss * (1.0f / DM) + NORM_EPS); }
        for (int kh = 0; kh < 2; ++kh) {
            __syncthreads();
            for (int q = tid; q < 2 * 36 * 64; q += 512) { const int which = q / 2304, r = (q % 2304) >> 6, ch = q & 63;
                *(LAS u32x4*)((which ? wlo : whi) + r * WROW + ch * 16) = *(const u32x4*)(WRT + (size_t)which * 36 * 1024 + r * 1024 + kh * 512 + ch * 8); }
            __syncthreads();
#pragma unroll 2
            for (int s = 0; s < 16; ++s) { const int ko = kh * 512 + 32 * s;
                const u32x4 xw = *(const u32x4*)(xr + ko); const f32x4 x0 = {bflo(xw.x), bfhi(xw.x), bflo(xw.y), bfhi(xw.y)}, x1 = {bflo(xw.z), bfhi(xw.z), bflo(xw.w), bfhi(xw.w)};
                const f32x4 g0 = *(const f32x4*)(gp + ko), g1 = *(const f32x4*)(gp + ko + 4), s0 = *(const f32x4*)(scp + ko), s1 = *(const f32x4*)(scp + ko + 4);
                const f32x4 h0 = *(const f32x4*)(shp + ko), h1 = *(const f32x4*)(shp + ko + 4);
                const f32x4 u0 = (x0 * rstd * g0) * (s0 + 1.0f) + h0, u1 = (x1 * rstd * g1) * (s1 + 1.0f) + h1;
                u32x4 hw; hw.x = pk2(u0.x, u0.y); hw.y = pk2(u0.z, u0.w); hw.z = pk2(u1.x, u1.y); hw.w = pk2(u1.z, u1.w);
                *(u32x4*)(H2 + (size_t)tok * DM + 8 * kg + ko) = hw;
                u32x4 lw; lw.x = pk2(u0.x - bflo(hw.x), u0.y - bfhi(hw.x)); lw.y = pk2(u0.z - bflo(hw.y), u0.w - bfhi(hw.y)); lw.z = pk2(u1.x - bflo(hw.z), u1.y - bfhi(hw.z)); lw.w = pk2(u1.z - bflo(hw.w), u1.w - bfhi(hw.w));
                const bf16x8 uh = __builtin_bit_cast(bf16x8, hw), ul = __builtin_bit_cast(bf16x8, lw);
                const int co = (32 * s + 8 * kg) * 2;
#pragma unroll
                for (int ct = 0; ct < 3; ++ct) { const int ar = ct == 0 ? arow0 : (ct == 1 ? arow1 : arow2);
                    const bf16x8 ah = *(const LAS bf16x8*)(whi + ar * WROW + co), al = *(const LAS bf16x8*)(wlo + ar * WROW + co);
                    acc[ct] = __builtin_amdgcn_mfma_f32_16x16x32_bf16(ah, uh, acc[ct], 0, 0, 0);
                    acc[ct] = __builtin_amdgcn_mfma_f32_16x16x32_bf16(al, uh, acc[ct], 0, 0, 0);
                    acc[ct] = __builtin_amdgcn_mfma_f32_16x16x32_bf16(ah, ul, acc[ct], 0, 0, 0); }
            }
        }
        float gl[4];
#pragma unroll
        for (int j = 0; j < 4; ++j) gl[j] = __shfl(acc[2][j] + c.b_rg[j], tk);
        int gs = 0; float gm = gl[0];
#pragma unroll
        for (int n = 1; n < 4; ++n) if (gl[n] > gm) { gm = gl[n]; gs = n; }
        float gden = 0.f;
#pragma unroll
        for (int n = 0; n < 4; ++n) gden += expf(gl[n] - gm);
        const float gw_ = 1.0f / gden;
        float cand[4];
#pragma unroll
        for (int j = 0; j < 4; ++j) { const int n = 16 * (gs >> 1) + 4 * kg + j; cand[j] = ((gs >> 1) ? acc[1][j] : acc[0][j]) + c.b_re[n]; }
        float el[8]; const int srcl = tk + 32 * (gs & 1);
#pragma unroll
        for (int j = 0; j < 4; ++j) { el[j] = __shfl(cand[j], srcl); el[4 + j] = __shfl(cand[j], srcl + 16); }
        int i0 = 0; float v0 = el[0];
#pragma unroll
        for (int n = 1; n < 8; ++n) if (el[n] > v0) { v0 = el[n]; i0 = n; }
        int i1 = i0 == 0 ? 1 : 0; float v1 = i0 == 0 ? el[1] : el[0];
#pragma unroll
        for (int n = 1; n < 8; ++n) if (n != i0 && el[n] > v1) { v1 = el[n]; i1 = n; }
        const float e1 = expf(v1 - v0), den = 1.0f + e1; const float w0 = gw_ / den, w1 = gw_ * e1 / den;
        if (DRY) { asm volatile("" :: "v"(w0), "v"(w1), "v"(i0), "v"(i1)); }
        if (kg == 0 && !DRY) { const int e0g = gs * 8 + i0, e1g = gs * 8 + i1; const int r0 = atomicAdd((int*)&bcnt[e0g], 1), r1 = atomicAdd((int*)&bcnt[e1g], 1);
            LAS int* r = rt + lt * 6; r[0] = e0g; r[1] = e1g; r[2] = r0; r[3] = r1; r[4] = __builtin_bit_cast(int, w0); r[5] = __builtin_bit_cast(int, w1); }
        __syncthreads();
        if (DRY) continue;
        if (tid < 32) bcnt[32 + tid] = (int)__hip_atomic_fetch_add(ctl + CW_CNT + 64 * tid, (unsigned)bcnt[tid], __ATOMIC_RELAXED, __HIP_MEMORY_SCOPE_AGENT);
        __syncthreads();
        if (tid < 128) { const LAS int* r = rt + tid * 6; const int tk2 = base + tid; const int e0g = r[0], e1g = r[1], p0 = bcnt[32 + e0g] + r[2], p1 = bcnt[32 + e1g] + r[3];
            int* ro = ROUTE + (size_t)tk2 * 8; ro[0] = e0g; ro[1] = e1g; ro[2] = p0; ro[3] = p1; ro[4] = r[4]; ro[5] = r[5];
            LIST[e0g * NTOK + p0] = tk2; LIST[e1g * NTOK + p1] = tk2; }
        __syncthreads();
    }
}

__device__ __forceinline__ void ph_final(const Ctx& c, LAS unsigned char* lds) {
    const int tid = threadIdx.x, lane = tid & 63, wave = tid >> 6, nw = blockDim.x >> 6;
    const float* MOD = (const float*)(c.ws + WS_MOD); const bf16* X1 = (const bf16*)(c.ws + WS_X1); const bf16* YB = (const bf16*)(c.ws + WS_YB);
    const int* ROUTE = (const int*)(c.ws + WS_ROUTE);
    LAS int* mm = (LAS int*)lds; moe_build(mm, (const unsigned*)(c.ws + WS_CTL));
    f32x4 g[4];
#pragma unroll
    for (int q = 0; q < 4; ++q) g[q] = *(const f32x4*)(c.g_final + 4 * lane + 256 * q);
    for (int tok = blockIdx.x * nw + wave; tok < NTOK; tok += gridDim.x * nw) {
        const int bb = tok / SEQ; const float* gt = MOD + bb * 6144 + 5120; const int* ro = ROUTE + (size_t)tok * 8;
        const int e0 = ro[0], e1 = ro[1]; const size_t r0 = ((size_t)mm[32 + e0] << 8) + ro[2], r1 = ((size_t)mm[32 + e1] << 8) + ro[3];
        const float w0 = __builtin_bit_cast(float, ro[4]), w1 = __builtin_bit_cast(float, ro[5]);
        f32x4 v[4]; float ss = 0.f;
#pragma unroll
        for (int q = 0; q < 4; ++q) { const int col = 4 * lane + 256 * q; const u32x2 xw = *(const u32x2*)(X1 + (size_t)tok * DM + col); const f32x4 xv = {bflo(xw.x), bfhi(xw.x), bflo(xw.y), bfhi(xw.y)}, gv = *(const f32x4*)(gt + col);
            const u32x2 ya = *(const u32x2*)(YB + r0 * DM + col), yb = *(const u32x2*)(YB + r1 * DM + col);
            f32x4 y; y.x = w0 * bflo(ya.x) + w1 * bflo(yb.x); y.y = w0 * bfhi(ya.x) + w1 * bfhi(yb.x); y.z = w0 * bflo(ya.y) + w1 * bflo(yb.y); y.w = w0 * bfhi(ya.y) + w1 * bfhi(yb.y);
            v[q] = xv + gv * y; ss += (v[q].x * v[q].x + v[q].y * v[q].y) + (v[q].z * v[q].z + v[q].w * v[q].w); }
        const float rstd = rsqrtf(wave_sum(ss) * (1.0f / DM) + NORM_EPS);
#pragma unroll
        for (int q = 0; q < 4; ++q) *(f32x4*)(c.out + (size_t)tok * DM + 4 * lane + 256 * q) = v[q] * rstd * g[q];
    }
}

#define XB_TMO      128
#define XB_XCNT(j)  (256  + 64 * (j))
#define XB_XSUB(j)  (1280 + 64 * (j))
#define XB_XGEN(j)  (2304 + 64 * (j))
#define XB_TOP      3328
#define XB_TOPGEN   3392
#define XCD_BAR_WORDS 3456
#define XB_SPIN_CAP (1u << 18)

__device__ __forceinline__ unsigned xb_ld(unsigned* p)              { return __hip_atomic_load(p, __ATOMIC_RELAXED, __HIP_MEMORY_SCOPE_AGENT); }
__device__ __forceinline__ unsigned xb_add(unsigned* p, unsigned v) { return __hip_atomic_fetch_add(p, v, __ATOMIC_RELAXED, __HIP_MEMORY_SCOPE_AGENT); }
__device__ __forceinline__ unsigned xb_xcc_id() { return (unsigned)__builtin_amdgcn_s_getreg((3 << 11) | 20) & 0xFu; }
#define XB_SPIN(cond, bar) do { unsigned _sp = 0; while (cond) { __builtin_amdgcn_s_sleep(1); \
    if ((++_sp & 255u) == 0u) { if (xb_ld(&(bar)[XB_TMO])) break; if (_sp > XB_SPIN_CAP) { atomicAdd(&(bar)[XB_TMO], 1u); break; } } } } while (0)

struct XcdBarrier {
    unsigned* bar; unsigned x;
    volatile LAS unsigned* st;
};
__device__ __forceinline__ XcdBarrier xcd_barrier_post(unsigned* bar, volatile LAS unsigned* st) {
    XcdBarrier b; b.bar = bar; b.x = xb_xcc_id(); b.st = st;
    if (threadIdx.x == 0) (void)xb_add(&bar[XB_XCNT(b.x)], 1u);
    return b;
}
__device__ __forceinline__ void xcd_barrier_complete(unsigned* bar, unsigned x, unsigned& nloc, unsigned& nx) {
    const unsigned G = gridDim.x * gridDim.y * gridDim.z;
    unsigned sum, cnt, mine, sp = 0u;
    for (;;) {
        sum = 0u; cnt = 0u; mine = 0u;
#pragma unroll
        for (unsigned j = 0; j < 16; ++j) { const unsigned c = xb_ld(&bar[XB_XCNT(j)]); sum += c; cnt += (c > 0u) ? 1u : 0u; mine = (j == x) ? c : mine; }
        if (sum == G) break;
        __builtin_amdgcn_s_sleep(1);
        if ((++sp & 255u) == 0u) { if (xb_ld(&bar[XB_TMO])) break; if (sp > XB_SPIN_CAP) { atomicAdd(&bar[XB_TMO], 1u); break; } }
    }
    nloc = mine > 0u ? mine : 1u; nx = cnt > 0u ? cnt : 1u;
}
__device__ __forceinline__ void xcd_barrier(const XcdBarrier& b) {
    asm volatile("s_waitcnt vmcnt(0)" ::: "memory");
    __syncthreads();
    if (threadIdx.x == 0) {
        unsigned* bar = b.bar;
        __builtin_amdgcn_s_waitcnt(0);
        unsigned nloc = b.st[0], nx = b.st[1];
        if (nloc == 0u) { xcd_barrier_complete(bar, b.x, nloc, nx); b.st[0] = nloc; b.st[1] = nx; }
        const unsigned old = xb_add(&bar[XB_XSUB(b.x)], 1u);
        const unsigned gen = old / nloc;
        if (old + 1u == (gen + 1u) * nloc) {
            __builtin_amdgcn_fence(__ATOMIC_RELEASE, "agent");
            asm volatile("s_waitcnt vmcnt(0)" ::: "memory");
            const unsigned og = xb_add(&bar[XB_TOP], 1u);
            const unsigned tg = og / nx;
            if (og + 1u == (tg + 1u) * nx) xb_add(&bar[XB_TOPGEN], 1u);
            else XB_SPIN(xb_ld(&bar[XB_TOPGEN]) == tg, bar);
            __builtin_amdgcn_fence(__ATOMIC_ACQUIRE, "agent");
            xb_add(&bar[XB_XGEN(b.x)], 1u);
            asm volatile("s_waitcnt vmcnt(0)" ::: "memory");
        } else {
            XB_SPIN(xb_ld(&bar[XB_XGEN(b.x)]) == gen, bar);
            __builtin_amdgcn_fence(__ATOMIC_ACQUIRE, "agent");
            asm volatile("s_waitcnt vmcnt(0)" ::: "memory");
        }
    }
    __syncthreads();
}

#ifndef PROBE_MASK
#define PROBE_MASK 0
#endif
constexpr int LDS_BYTES = 147456;
constexpr int LDS_BARW_OFF = LDS_BYTES - 16;
__global__ void __launch_bounds__(512, 2) mega_fwd(Ctx c) {
    extern __shared__ __attribute__((aligned(16))) unsigned char lds_raw[];
    LAS unsigned char* lds = (LAS unsigned char*)lds_raw;
    if (threadIdx.x == 0) *(LAS u32x4*)(lds + LDS_BARW_OFF) = (u32x4){0u, 0u, 0u, 0u};
    __syncthreads();
    const XcdBarrier bar = xcd_barrier_post((unsigned*)(c.ws + WS_CTL) + CW_BAR, (volatile LAS unsigned*)(lds + LDS_BARW_OFF));
#define RUN(k, call) do { call; xcd_barrier(bar); if (PROBE_MASK & (1 << (k))) { call; xcd_barrier(bar); } } while (0)
    if (PROBE_MASK & (1 << 14)) { for (int i = 0; i < 8; ++i) xcd_barrier(bar); }
    RUN(0, ph_prologue(c, lds));
    RUN(1, ph_norm1(c));
    RUN(2, ph_inproj(c, lds));
    if (PROBE_MASK & (1 << 12)) gla::g0_phase(c, lds);
    if (PROBE_MASK & (1 << 13)) { da::attn_phase(c, lds); }
    RUN(3, (gla::g0_phase(c, lds), da::attn_phase(c, lds)));
    RUN(4, gla::g1_phase(c, lds));
    RUN(5, gla::g2_phase(c));
    RUN(6, gla::g3_phase(c, lds));
    RUN(7, ph_outproj(c, lds));
    if (PROBE_MASK & (1 << 8)) { ph_router<true>(c, lds); xcd_barrier(bar); }
    ph_router<false>(c, lds); xcd_barrier(bar);
    RUN(9, ph_gateup(c, lds));
    RUN(10, ph_down(c, lds));
    if (PROBE_MASK & (1 << 11)) { ph_final(c, lds); xcd_barrier(bar); }
    ph_final(c, lds);
}

extern "C" void kernel_launch(void* const* d_in, const int* in_sizes, int n_in, void* d_out, int out_size, void* d_ws, size_t ws_size, hipStream_t stream) {
    static int grid = 0;
    if (grid == 0) {
        if (n_in != 23 || in_sizes[0] != NTOK * DM || out_size != NTOK * DM || ws_size < WS_END) { fprintf(stderr, "kernel_launch: unexpected problem shape (n_in %d, in0 %d, out %d, ws %zu)\n", n_in, n_in > 0 ? in_sizes[0] : -1, out_size, ws_size); grid = -1; return; }
        int dev = 0, cus = 0, per_cu = 0;
        if (hipGetDevice(&dev) != hipSuccess || hipDeviceGetAttribute(&cus, hipDeviceAttributeMultiprocessorCount, dev) != hipSuccess) { grid = -1; return; }
        if (hipFuncSetAttribute((const void*)mega_fwd, hipFuncAttributeMaxDynamicSharedMemorySize, LDS_BYTES) != hipSuccess) { fprintf(stderr, "kernel_launch: hipFuncSetAttribute failed\n"); grid = -1; return; }
        if (hipOccupancyMaxActiveBlocksPerMultiprocessor(&per_cu, (const void*)mega_fwd, 512, LDS_BYTES) != hipSuccess || per_cu < 1) fprintf(stderr, "kernel_launch: occupancy query reports %d workgroups per CU\n", per_cu);
        (void)hipGetLastError();
        grid = cus;
    }
    if (grid < 0) return;
    Ctx c{};
    const float** f = (const float**)&c;
    for (int i = 0; i < 23; ++i) f[i] = (const float*)d_in[i];
    c.out = (float*)d_out; c.ws = (unsigned char*)d_ws;
    if (hipMemsetAsync((unsigned char*)d_ws + WS_CTL, 0, CTL_ZERO_BYTES, stream) != hipSuccess) return;
    hipLaunchKernelGGL(mega_fwd, dim3(grid), dim3(512), LDS_BYTES, stream, c);
}
```

```cpp
#include <hip/hip_runtime.h>
#include <cstdint>
#include <cstdio>

#define GAS __attribute__((address_space(1)))
#define LAS __attribute__((address_space(3)))
typedef unsigned short bf16;
typedef float f32x4 __attribute__((ext_vector_type(4)));
typedef float f32x2 __attribute__((ext_vector_type(2)));
typedef unsigned u32x4 __attribute__((ext_vector_type(4)));
typedef unsigned u32x2 __attribute__((ext_vector_type(2)));

constexpr int NB = 16, SEQ = 2048, DM = 1024, CTXL = 256, KVL = CTXL + SEQ;
constexpr int NTOK = NB * SEQ;
constexpr int NROW = NB * KVL;
constexpr int NPROJ = 3104, NPROJ_PAD = 3328;
constexpr int NEXP = 32, EHID = 512;
constexpr int MOE_ROWS_MAX = 73728;
constexpr float NORM_EPS = 1e-6f;
constexpr float LAMBDA_INIT = 0.2f;
constexpr float QSCALE = 0.125f * 1.4426950408889634f;

constexpr int C_DAQ = 0, C_DAK = 512, C_DAV = 1024, C_GQ = 1536, C_GK = 1792, C_GV = 2048, C_GR = 2560, C_LR = 3072;

constexpr size_t MiB = 1u << 20;
constexpr size_t WS_CTL = 0, CTL_ZERO_BYTES = 1 * MiB;
constexpr size_t WS_MOD = 1 * MiB;
constexpr size_t WS_ROPE = 1 * MiB + 512 * 1024;
constexpr size_t WS_WRT = 462 * MiB;
constexpr size_t WS_ROUTE = 2 * MiB;
constexpr size_t WS_LIST = 3 * MiB;
constexpr size_t WS_WIN_T = 7 * MiB;
constexpr size_t WS_WOUT_T = 14 * MiB;
constexpr size_t WS_WGU_T = 16 * MiB;
constexpr size_t WS_WD_T = 80 * MiB;
constexpr size_t WS_H = 112 * MiB;
constexpr size_t WS_HMID = 112 * MiB;
constexpr size_t WS_QDA = 184 * MiB;
constexpr size_t WS_KDA = 216 * MiB;
constexpr size_t WS_VDA = 252 * MiB;
constexpr size_t WS_GQ = 288 * MiB;
constexpr size_t WS_GK = 304 * MiB;
constexpr size_t WS_GV = 322 * MiB;
constexpr size_t WS_GR = 358 * MiB;
constexpr size_t WS_LR = 390 * MiB;
constexpr size_t WS_X1 = 184 * MiB;
constexpr size_t WS_H2 = 312 * MiB;
constexpr size_t WS_YB = 312 * MiB;
constexpr size_t WS_MIX = 112 * MiB;
constexpr size_t WS_UT = 184 * MiB;
constexpr size_t WS_ST = 256 * MiB;
constexpr size_t WS_QD = 395 * MiB;
constexpr size_t WS_KI = 427 * MiB;
constexpr size_t WS_KEND = 464 * MiB;
constexpr size_t WS_DB = 460 * MiB;
constexpr size_t WS_SSP = 500 * MiB;
constexpr size_t WS_END = 502 * MiB;

constexpr int CW_BAR = 4096;
constexpr int CW_CNT = 16384;

struct Ctx {
    const float *x, *c, *ctx, *c_ctx, *w_ada, *b_ada, *g_mix, *g_ffn, *w_in, *da_lambda, *da_subln_g, *gate_w2, *gate_b, *gla_norm_g, *w_out,
        *w_rg, *b_rg, *w_re, *b_re, *w_gate, *w_up, *w_down, *g_final;
    float* out; unsigned char* ws;
};

__device__ __forceinline__ unsigned f2bf(float f) { unsigned u = __builtin_bit_cast(unsigned, f); return (u + 0x7fffu + ((u >> 16) & 1u)) >> 16; }
typedef float f32x2_c __attribute__((ext_vector_type(2))); typedef __bf16 bf16x2_c __attribute__((ext_vector_type(2)));
__device__ __forceinline__ unsigned pk2(float lo, float hi) { f32x2_c v = {lo, hi}; bf16x2_c b = __builtin_convertvector(v, bf16x2_c); return __builtin_bit_cast(unsigned, b); }
__device__ __forceinline__ float bf2f(unsigned b) { return __builtin_bit_cast(float, b << 16); }
__device__ __forceinline__ float bflo(unsigned w) { return __builtin_bit_cast(float, w << 16); }
__device__ __forceinline__ float bfhi(unsigned w) { return __builtin_bit_cast(float, w & 0xffff0000u); }
__device__ __forceinline__ float wave_sum(float v) {
#pragma unroll
    for (int o = 1; o < 64; o <<= 1) v += __shfl_xor(v, o);
    return v;
}
__device__ __forceinline__ float silu_f(float v) { return v / (1.0f + __expf(-v)); }
#define LDS_WAIT() asm volatile("s_waitcnt lgkmcnt(0)" ::: "memory")

template <class RowMap>
__device__ __forceinline__ void transpose_item(const float* W, int ldw, int k0, int n0, bf16* WT, int KT, const RowMap& rm, LAS float* scr, int lane) {
    float v[32];
#pragma unroll
    for (int i = 0; i < 32; ++i) v[i] = W[(size_t)(k0 + 2 * i + (lane >> 5)) * ldw + n0 + (lane & 31)];
#pragma unroll
    for (int i = 0; i < 32; ++i) scr[(2 * i + (lane >> 5)) * 33 + (lane & 31)] = v[i];
    LDS_WAIT(); asm volatile("" ::: "memory");
    const int c = lane & 7;
#pragma unroll
    for (int j = 0; j < 4; ++j) { const int n = (lane >> 3) + 8 * j; const LAS float* s = scr + (8 * c) * 33 + n;
        u32x4 o; o.x = pk2(s[0 * 33], s[1 * 33]); o.y = pk2(s[2 * 33], s[3 * 33]); o.z = pk2(s[4 * 33], s[5 * 33]); o.w = pk2(s[6 * 33], s[7 * 33]);
        *(u32x4*)(WT + (size_t)rm(n0 + n) * KT + k0 + 8 * c) = o; }
    LDS_WAIT(); asm volatile("" ::: "memory");
}
struct TItem { const float* src; bf16* dst; int ldw, KT, n0, mode; };
__device__ __forceinline__ int titem_row(const TItem& t, int n) { const int a = t.n0 + n;
    return t.mode == 0 ? a : (t.mode == 1 ? (a & ~31) + (((a & 31) & 15) << 1) + ((a & 31) >> 4) : 8 * (a >> 2) + (a & 3) + 4 * (t.mode - 2)); }
__device__ __forceinline__ void titem_load(const TItem& t, float (&v)[32], int lane) {
#pragma unroll
    for (int i = 0; i < 32; ++i) v[i] = t.src[(size_t)(2 * i + (lane >> 5)) * t.ldw + (lane & 31)];
}
__device__ __forceinline__ void titem_store(const TItem& t, const float (&v)[32], LAS float* scr, int lane) {
#pragma unroll
    for (int i = 0; i < 32; ++i) scr[(2 * i + (lane >> 5)) * 33 + (lane & 31)] = v[i];
    LDS_WAIT(); asm volatile("" ::: "memory");
    const int c = lane & 7;
#pragma unroll
    for (int j = 0; j < 4; ++j) { const int n = (lane >> 3) + 8 * j; const LAS float* s = scr + (8 * c) * 33 + n;
        u32x4 o; o.x = pk2(s[0 * 33], s[1 * 33]); o.y = pk2(s[2 * 33], s[3 * 33]); o.z = pk2(s[4 * 33], s[5 * 33]); o.w = pk2(s[6 * 33], s[7 * 33]);
        *(u32x4*)(t.dst + (size_t)titem_row(t, n) * t.KT + 8 * c) = o; }
    LDS_WAIT(); asm volatile("" ::: "memory");
}
struct RowId { int off; __device__ __forceinline__ int operator()(int n) const { return off + n; } };
struct RowRope { __device__ __forceinline__ int operator()(int n) const { const int l = n & 31; return (n & ~31) + ((l & 15) << 1) + (l >> 4); } };
struct RowGU { int up; __device__ __forceinline__ int operator()(int n) const { return 8 * (n >> 2) + (n & 3) + 4 * up; } };

__device__ __forceinline__ void ph_prologue(const Ctx& c, LAS unsigned char* lds) {
    const int tid = threadIdx.x, lane = tid & 63, wave = tid >> 6, nw = blockDim.x >> 6;
    unsigned char* ws = c.ws;
    if (blockIdx.x < 96 && nw == 8) {
        LAS float* sv = (LAS float*)lds;
        LAS float* red = sv + 17 * 1024;
        for (int i = tid; i < 17 * 1024; i += 512) { const int r = i >> 10, k = i & 1023; const float v = r < 16 ? c.c[r * 1024 + k] : c.c_ctx[k]; sv[i] = v / (1.0f + expf(-v)); }
        __syncthreads();
        const int col = blockIdx.x * 64 + lane;
        float acc[17];
#pragma unroll
        for (int r = 0; r < 17; ++r) acc[r] = 0.f;
        for (int k = wave * 128; k < wave * 128 + 128; ++k) { const float w = c.w_ada[(size_t)k * 6144 + col];
#pragma unroll
            for (int r = 0; r < 17; ++r) acc[r] += sv[r * 1024 + k] * w; }
#pragma unroll
        for (int r = 0; r < 17; ++r) red[(wave * 17 + r) * 64 + lane] = acc[r];
        __syncthreads();
        float* MOD = (float*)(ws + WS_MOD);
        for (int i = tid; i < 17 * 64; i += 512) { const int r = i >> 6, l = i & 63; float s = 0.f;
            for (int w = 0; w < 8; ++w) s += red[(w * 17 + r) * 64 + l];
            MOD[r * 6144 + blockIdx.x * 64 + l] = s + c.b_ada[blockIdx.x * 64 + l]; }
        __syncthreads();
    }
    { f32x2* ROPE = (f32x2*)(ws + WS_ROPE);
      for (int i = blockIdx.x * blockDim.x + tid; i < 2048 * 32; i += gridDim.x * blockDim.x) {
          const int t = i >> 5, a = (i >> 4) & 1, f = i & 15; const float pos = (float)(a == 0 ? (t >> 6) : (t & 63));
          const float inv = exp2f(-(float)f * (13.287712379549449f / 16.0f));
          const float ang = pos * inv; f32x2 cs; cs.x = __cosf(ang); cs.y = __sinf(ang); ROPE[i] = cs; } }
    { bf16* WRT = (bf16*)(ws + WS_WRT);
      for (int i = blockIdx.x * blockDim.x + tid; i < 36 * 1024; i += gridDim.x * blockDim.x) { const int n = i >> 10, k = i & 1023;
          const float wv = n < 32 ? c.w_re[k * 32 + n] : c.w_rg[k * 4 + (n - 32)]; const unsigned h = f2bf(wv); WRT[i] = (bf16)h; WRT[36 * 1024 + i] = (bf16)f2bf(wv - bf2f(h)); } }
    { u32x4* z = (u32x4*)(ws + WS_WIN_T + (size_t)NPROJ * 1024 * 2); const int n16 = (NPROJ_PAD - NPROJ) * 1024 * 2 / 16;
      for (int i = blockIdx.x * blockDim.x + tid; i < n16; i += gridDim.x * blockDim.x) z[i] = (u32x4){0u, 0u, 0u, 0u}; }
    LAS float* scr = (LAS float*)(lds + wave * 8704);
    const int gw = blockIdx.x * nw + wave, NGW = gridDim.x * nw;
    constexpr int I_IN = 16 * 97, I_OUT = 16 * 32, I_G = 32 * 16 * 16, I_U = I_G, I_D = 32 * 8 * 32;
    constexpr int NITEMS = I_IN + I_OUT + I_G + I_U + I_D;
    bf16* WIN_T = (bf16*)(ws + WS_WIN_T); bf16* WOUT_T = (bf16*)(ws + WS_WOUT_T); bf16* WGU_T = (bf16*)(ws + WS_WGU_T); bf16* WD_T = (bf16*)(ws + WS_WD_T);
    constexpr int NA_PER = 2; const int nfree = ((int)gridDim.x - 96) * nw, NA = gridDim.x > 96 ? nfree * NA_PER : 0;
    const int gfree = ((int)blockIdx.x - 96) * nw + wave;
    auto decode = [&](int it) -> TItem { TItem t; int r = it;
        if (r < I_IN) { const int kb = r / 97, nb = r % 97, n0 = nb * 32; t.src = c.w_in + (size_t)(kb * 64) * NPROJ + n0; t.dst = WIN_T + kb * 64; t.ldw = NPROJ; t.KT = 1024; t.n0 = n0; t.mode = n0 < 1024 ? 1 : 0; return t; }
        r -= I_IN;
        if (r < I_OUT) { const int kb = r / 32, nb = r % 32; t.src = c.w_out + (size_t)(kb * 64) * 1024 + nb * 32; t.dst = WOUT_T + kb * 64; t.ldw = 1024; t.KT = 1024; t.n0 = nb * 32; t.mode = 0; return t; }
        r -= I_OUT;
        if (r < I_G + I_U) { const int up = r >= I_G; if (up) r -= I_G; const int e = r / 256, q = r % 256, kb = q / 16, nb = q % 16;
            t.src = (up ? c.w_up : c.w_gate) + (size_t)e * 1024 * 512 + (size_t)(kb * 64) * 512 + nb * 32; t.dst = WGU_T + (size_t)e * 1024 * 1024 + kb * 64; t.ldw = 512; t.KT = 1024; t.n0 = nb * 32; t.mode = 2 + up; return t; }
        r -= I_G + I_U;
        { const int e = r / 256, q = r % 256, kb = q / 32, nb = q % 32; t.src = c.w_down + (size_t)e * 512 * 1024 + (size_t)(kb * 64) * 1024 + nb * 32; t.dst = WD_T + (size_t)e * 1024 * 512 + kb * 64; t.ldw = 1024; t.KT = 512; t.n0 = nb * 32; t.mode = 0; return t; } };
    for (int pass = 0; pass < 2; ++pass) {
        const int first = pass == 0 ? (blockIdx.x >= 96 ? gfree : NITEMS) : NA + gw, end = pass == 0 ? NA : NITEMS, stride = pass == 0 ? nfree : NGW;
        for (int it = first; it < end; it += 2 * stride) {
            const bool two = it + stride < end;
            const TItem ta = decode(it), tb = decode(two ? it + stride : it);
            float va[32], vb[32];
            titem_load(ta, va, lane); if (two) titem_load(tb, vb, lane);
            titem_store(ta, va, scr, lane); if (two) titem_store(tb, vb, scr, lane);
        }
    }
}

__device__ __forceinline__ void ph_norm1(const Ctx& c) {
    const int tid = threadIdx.x, lane = tid & 63, wave = tid >> 6, nw = blockDim.x >> 6;
    const int gw = blockIdx.x * nw + wave, NGW = gridDim.x * nw;
    const float* MOD = (const float*)(c.ws + WS_MOD); bf16* H = (bf16*)(c.ws + WS_H);
    f32x4 g[4];
#pragma unroll
    for (int j = 0; j < 4; ++j) g[j] = *(const f32x4*)(c.g_mix + 4 * lane + 256 * j);
    for (int r0 = gw * 2; r0 < NROW; r0 += NGW * 2) {
        f32x4 v[2][4];
#pragma unroll
        for (int t = 0; t < 2; ++t) { const int r = r0 + t, b = r / KVL, j = r % KVL; const bool isctx = j < CTXL;
            const float* src = isctx ? c.ctx + ((size_t)b * CTXL + j) * DM : c.x + ((size_t)b * SEQ + (j - CTXL)) * DM;
#pragma unroll
            for (int q = 0; q < 4; ++q) v[t][q] = *(const f32x4*)(src + 4 * lane + 256 * q); }
#pragma unroll
        for (int t = 0; t < 2; ++t) { const int r = r0 + t, b = r / KVL, j = r % KVL; const bool isctx = j < CTXL;
            const float* mod = MOD + (isctx ? 16 : b) * 6144; float ss = 0.f;
#pragma unroll
            for (int q = 0; q < 4; ++q) ss += (v[t][q].x * v[t][q].x + v[t][q].y * v[t][q].y) + (v[t][q].z * v[t][q].z + v[t][q].w * v[t][q].w);
            const float rstd = rsqrtf(wave_sum(ss) * (1.0f / DM) + NORM_EPS);
#pragma unroll
            for (int q = 0; q < 4; ++q) { const f32x4 sh = *(const f32x4*)(mod + 4 * lane + 256 * q), sc = *(const f32x4*)(mod + 1024 + 4 * lane + 256 * q);
                const f32x4 o = (v[t][q] * rstd * g[q]) * (sc + 1.0f) + sh;
                u32x2 w; w.x = pk2(o.x, o.y); w.y = pk2(o.z, o.w); *(u32x2*)(H + (size_t)r * DM + 4 * lane + 256 * q) = w; } }
    }
}

__device__ __forceinline__ u32x4 pack8(const f32x4& a, const f32x4& b) { u32x4 w; w.x = pk2(a.x, a.y); w.y = pk2(a.z, a.w); w.z = pk2(b.x, b.y); w.w = pk2(b.z, b.w); return w; }
struct EpiInProj {
    unsigned char* ws;
    __device__ __forceinline__ void rope8(int t, int i8, f32x4& a, f32x4& b, float scale) const {
        const f32x2* R = (const f32x2*)(ws + WS_ROPE) + (size_t)t * 32 + (i8 >> 5) * 16 + ((i8 & 31) >> 1);
        const f32x4 c0 = *(const f32x4*)R, c1 = *(const f32x4*)(R + 2);
        f32x4 oa, ob;
        oa.x = (a.x * c0.x - a.y * c0.y) * scale; oa.y = (a.y * c0.x + a.x * c0.y) * scale;
        oa.z = (a.z * c0.z - a.w * c0.w) * scale; oa.w = (a.w * c0.z + a.z * c0.w) * scale;
        ob.x = (b.x * c1.x - b.y * c1.y) * scale; ob.y = (b.y * c1.x + b.x * c1.y) * scale;
        ob.z = (b.z * c1.z - b.w * c1.w) * scale; ob.w = (b.w * c1.z + b.z * c1.w) * scale;
        a = oa; b = ob;
    }
    __device__ __forceinline__ void emit8(int row, int col, f32x4 a, f32x4 b) const {
        const int bb = row / KVL, j = row % KVL; const bool lat = j >= CTXL; const int t = j - CTXL; const size_t tl = (size_t)bb * SEQ + t;
        if (col < C_DAK) { if (!lat) return; rope8(t, col & 63, a, b, QSCALE); *(u32x4*)((bf16*)(ws + WS_QDA) + tl * 512 + col) = pack8(a, b); }
        else if (col < C_DAV) { if (lat) rope8(t, col & 63, a, b, 1.0f); *(u32x4*)((bf16*)(ws + WS_KDA) + (size_t)row * 512 + (col - C_DAK)) = pack8(a, b); }
        else if (col < C_GQ) { *(u32x4*)((bf16*)(ws + WS_VDA) + (size_t)row * 512 + (col - C_DAV)) = pack8(a, b); }
        else if (col < C_GK) { if (!lat) return; *(u32x4*)((bf16*)(ws + WS_GQ) + tl * 256 + (col - C_GQ)) = pack8(a * 0.125f, b * 0.125f); }
        else if (col < C_GV) { *(u32x4*)((bf16*)(ws + WS_GK) + (size_t)row * 256 + (col - C_GK)) = pack8(a, b); }
        else if (col < C_GR) { *(u32x4*)((bf16*)(ws + WS_GV) + (size_t)row * 512 + (col - C_GV)) = pack8(a, b); }
        else if (col < C_LR) { if (!lat) return; *(u32x4*)((bf16*)(ws + WS_GR) + tl * 512 + (col - C_GR)) = pack8(a, b); }
        else if (col < NPROJ) { float* p = (float*)(ws + WS_LR) + (size_t)row * 32 + (col - C_LR); *(f32x4*)p = a; *(f32x4*)(p + 4) = b; }
    }
};
struct EpiGateUp {
    bf16* HMID;
    __device__ __forceinline__ void emit8(int row, int col, f32x4 a, f32x4 b) const {
        f32x4 h; h.x = silu_f(a.x) * b.x; h.y = silu_f(a.y) * b.y; h.z = silu_f(a.z) * b.z; h.w = silu_f(a.w) * b.w;
        u32x2 w; w.x = pk2(h.x, h.y); w.y = pk2(h.z, h.w); *(u32x2*)(HMID + (size_t)row * EHID + (col >> 1)) = w;
    }
};
struct EpiDown {
    bf16* YB;
    __device__ __forceinline__ void emit8(int row, int col, f32x4 a, f32x4 b) const { *(u32x4*)(YB + (size_t)row * DM + col) = pack8(a, b); }
};

__device__ __forceinline__ void moe_build(LAS int* mm, const unsigned* ctl) {
    if (threadIdx.x < 64) { const int l = threadIdx.x, e = l & 31;
        const int cnt = (int)__hip_atomic_load((unsigned*)ctl + CW_CNT + 64 * e, __ATOMIC_RELAXED, __HIP_MEMORY_SCOPE_AGENT);
        const int tiles = (cnt + 255) >> 8; int incl = tiles;
#pragma unroll
        for (int o = 1; o < 32; o <<= 1) { const int v = __shfl_up(incl, o); if (e >= o) incl += v; }
        if (l < 32) { mm[e] = cnt; mm[32 + e] = incl - tiles; if (e == 31) mm[64] = incl; } }
    __syncthreads();
}
__device__ __forceinline__ int moe_tile_expert(const LAS int* mm, int tile) { int e = 0;
#pragma unroll 1
    for (int i = 1; i < NEXP; ++i) if (mm[32 + i] <= tile) e = i;
    return e; }

namespace pg8 {
typedef short bf16x8 __attribute__((ext_vector_type(8)));
constexpr int BM = 256, BK = 64, HALF = 128, HTB = HALF * BK * 2  , STAGE_BYTES = 8 * HTB;
__host__ __device__ __forceinline__ int lds_byte(int r, int c) { const int st = (r >> 4) * 2 + (c >> 5), rr = r & 15, cc = c & 31, ob = rr * 64 + cc * 2; return st * 1024 + (ob ^ (((ob >> 9) & 1) << 5)); }
__host__ __device__ __forceinline__ void stage_rc(int b, int& R, int& C) { const int st = b / 1024, sb = b % 1024, swz = sb ^ (((sb >> 9) & 1) << 5); R = (st >> 1) * 16 + swz / 64; C = (st & 1) * 32 + (swz % 64) / 2; }
__host__ __device__ __forceinline__ int perm32(int rho) { const int n = rho >> 4, i = rho & 15; return 8 * (i >> 2) + 4 * n + (i & 3); }

struct Unit { const char* A; const char* B; int row0, col0, ge, gp; };
struct Gemm { int K; const int* LIST; const LAS int* mm; };

template <class E8> struct Epi8 {
    E8 e;
    __device__ __forceinline__ void operator()(const f32x4 (&acc)[2][2][4][2], const Unit& u, int wr, int wc, int fr, int fq) const {
#pragma unroll
        for (int ai = 0; ai < 2; ++ai)
#pragma unroll
            for (int m = 0; m < 4; ++m)
#pragma unroll
                for (int bj = 0; bj < 2; ++bj) e.emit8(u.row0 + ai * HALF + wr * 64 + m * 16 + fr, u.col0 + bj * HALF + wc * 32 + 8 * fq, acc[ai][bj][m][0], acc[ai][bj][m][1]);
    }
};

struct EpiOutProjB {
    const float* x; const float* MOD; bf16* X1; float* SSP;
    __device__ __forceinline__ void operator()(const f32x4 (&acc)[2][2][4][2], const Unit& u, int wr, int wc, int fr, int fq) const {
        const int bb = u.row0 / SEQ; const int colb = u.col0 + wc * 32 + 8 * fq;
        f32x4 g[2][2];
#pragma unroll
        for (int bj = 0; bj < 2; ++bj) { const float* gp = MOD + bb * 6144 + 2048 + colb + bj * HALF; g[bj][0] = *(const f32x4*)gp; g[bj][1] = *(const f32x4*)(gp + 4); }
#pragma unroll
        for (int ai = 0; ai < 2; ++ai)
#pragma unroll
            for (int mh = 0; mh < 2; ++mh) {
                f32x4 xv[2][2][2]; float ssq[2] = {0.f, 0.f};
#pragma unroll
                for (int mm_ = 0; mm_ < 2; ++mm_)
#pragma unroll
                    for (int bj = 0; bj < 2; ++bj) { const float* xp = x + (size_t)(u.row0 + ai * HALF + wr * 64 + (2 * mh + mm_) * 16 + fr) * DM + colb + bj * HALF; xv[mm_][bj][0] = *(const f32x4*)xp; xv[mm_][bj][1] = *(const f32x4*)(xp + 4); }
#pragma unroll
                for (int mm_ = 0; mm_ < 2; ++mm_)
#pragma unroll
                    for (int bj = 0; bj < 2; ++bj) { const int m = 2 * mh + mm_; const size_t o = (size_t)(u.row0 + ai * HALF + wr * 64 + m * 16 + fr) * DM + colb + bj * HALF;
                        const u32x4 pw = pack8(xv[mm_][bj][0] + g[bj][0] * acc[ai][bj][m][0], xv[mm_][bj][1] + g[bj][1] * acc[ai][bj][m][1]);
                        *(u32x4*)(X1 + o) = pw;
                        const float q0 = bflo(pw.x), q1 = bfhi(pw.x), q2 = bflo(pw.y), q3 = bfhi(pw.y), q4 = bflo(pw.z), q5 = bfhi(pw.z), q6 = bflo(pw.w), q7 = bfhi(pw.w);
                        ssq[mm_] += (q0 * q0 + q1 * q1) + (q2 * q2 + q3 * q3) + (q4 * q4 + q5 * q5) + (q6 * q6 + q7 * q7); }
#pragma unroll
                for (int mm_ = 0; mm_ < 2; ++mm_) { float s = ssq[mm_]; s += __shfl_xor(s, 16); s += __shfl_xor(s, 32);
                    if (fq == 0) SSP[(size_t)(u.row0 + ai * HALF + wr * 64 + (2 * mh + mm_) * 16 + fr) * 16 + (u.col0 >> 8) * 4 + wc] = s; }
                asm volatile("" ::: "memory");
            }
    }
};

template <class Epi, class Sched, bool GATHER, bool ALIGN_EPI = true, bool SP2 = true>
__device__ __forceinline__ void gemm_phase(LAS unsigned char* lds, const Gemm g, const Sched& S, const Epi& E) {
    int tid = threadIdx.x; asm volatile("" : "+v"(tid));
    const int wid = __builtin_amdgcn_readfirstlane(tid >> 6), lane = tid & 63, wr = wid >> 2, wc = wid & 3, fr = lane & 15, fq = lane >> 4;
    const int K = g.K, nt = K / BK;
    int Rr[2], Cc[2]; unsigned voffB[2];
#pragma unroll
    for (int i = 0; i < 2; ++i) { stage_rc(tid * 16 + i * 8192, Rr[i], Cc[i]); const int Rb = (Rr[i] & ~31) + perm32(Rr[i] & 31); voffB[i] = (unsigned)(Rb * K + Cc[i]) * 2u; }
    const size_t kstep = (size_t)(BK * 2);
    const size_t hstep = (size_t)HALF * K * 2;
    const unsigned ldsw = (unsigned)wid * 1024u;
    const int aoff = lds_byte(wr * 64 + fr, fq * 8), boff = lds_byte(wc * 32 + fr, fq * 8);
#define PG8_MKOFF(u, vo) do { _Pragma("unroll") for (int _h = 0; _h < 2; ++_h) _Pragma("unroll") for (int _i = 0; _i < 2; ++_i) { \
        if (GATHER) { const int _pos = (u).gp + _h * HALF + Rr[_i]; const int _tok = g.LIST[(u).ge * NTOK + (_pos < g.mm[(u).ge] ? _pos : 0)]; (vo)[_h][_i] = (unsigned)(_tok * K + Cc[_i]) * 2u; } \
        else (vo)[_h][_i] = (unsigned)((_h * HALF + Rr[_i]) * K + Cc[_i]) * 2u; } } while (0)
#define PG8_SA(b, h) (((b) * 2 + (h)) * HTB)
#define PG8_SB(b, h) ((4 + (b) * 2 + (h)) * HTB)
#define PG8_STAGE(bufoff, gbase, voff) do { _Pragma("unroll") for (int _i = 0; _i < 2; ++_i) \
        __builtin_amdgcn_global_load_lds((const unsigned*)((const char*)(gbase) + (voff)[_i]), (LAS unsigned*)(lds + (bufoff) + ldsw + _i * 8192), 16, 0, 0); } while (0)
#define PG8_LDA(dst, b, h) do { _Pragma("unroll") for (int m = 0; m < 4; ++m) _Pragma("unroll") for (int k = 0; k < 2; ++k) dst[m][k] = *(const LAS bf16x8*)(lds + PG8_SA(b, h) + aoff + m * 2048 + k * 1024); } while (0)
#define PG8_LDB(dst, b, h) do { _Pragma("unroll") for (int n = 0; n < 2; ++n) _Pragma("unroll") for (int k = 0; k < 2; ++k) dst[n][k] = *(const LAS bf16x8*)(lds + PG8_SB(b, h) + boff + n * 2048 + k * 1024); } while (0)
#define PG8_MMA(ai, bj, At, Bt) do { __builtin_amdgcn_s_setprio(1); _Pragma("unroll") for (int m = 0; m < 4; ++m) _Pragma("unroll") for (int n = 0; n < 2; ++n) _Pragma("unroll") for (int k = 0; k < 2; ++k) \
        acc[ai][bj][m][n] = __builtin_amdgcn_mfma_f32_16x16x32_bf16(Bt[n][k], At[m][k], acc[ai][bj][m][n], 0, 0, 0); __builtin_amdgcn_s_setprio(0); } while (0)
#define PG8_WAIT_V(n) asm volatile("s_waitcnt vmcnt(" #n ")" ::: "memory")
#define PG8_WAIT_L(n) asm volatile("s_waitcnt lgkmcnt(" #n ")" ::: "memory")
#define PG8_BAR __builtin_amdgcn_s_barrier()
#define PG8_SCHED __builtin_amdgcn_sched_barrier(0)
    Unit cur, nxt; int ui = 0;
    if (!S.next(0, cur)) return;
    f32x4 acc[2][2][4][2];
#pragma unroll
    for (int a = 0; a < 2; ++a)
#pragma unroll
        for (int b = 0; b < 2; ++b)
#pragma unroll
            for (int m = 0; m < 4; ++m)
#pragma unroll
                for (int n = 0; n < 2; ++n) acc[a][b][m][n] = (f32x4){0.f, 0.f, 0.f, 0.f};
    bf16x8 At[4][2], B0[2][2], B1[2][2];
    unsigned voffA[2][2], nvoffA[2][2];
    PG8_MKOFF(cur, voffA);
    const char* cA = cur.A; const char* cB = cur.B;
    if constexpr (SP2) {
        PG8_STAGE(PG8_SB(0, 0), cB, voffB); PG8_STAGE(PG8_SB(0, 1), cB + hstep, voffB); PG8_STAGE(PG8_SA(0, 0), cA, voffA[0]); PG8_STAGE(PG8_SA(0, 1), cA, voffA[1]);
        if (wr == 1) PG8_BAR;
        PG8_WAIT_V(2); PG8_BAR;
        PG8_STAGE(PG8_SB(1, 0), cB + kstep, voffB); PG8_STAGE(PG8_SA(1, 0), cA + kstep, voffA[0]); PG8_STAGE(PG8_SB(1, 1), cB + hstep + kstep, voffB);
        PG8_WAIT_V(6); PG8_BAR;
    } else {
        PG8_STAGE(PG8_SB(0, 0), cB, voffB); PG8_STAGE(PG8_SA(0, 0), cA, voffA[0]); PG8_STAGE(PG8_SB(0, 1), cB + hstep, voffB); PG8_STAGE(PG8_SA(0, 1), cA, voffA[1]);
        if (wr == 1) PG8_BAR;
        PG8_WAIT_V(4); PG8_BAR;
        PG8_STAGE(PG8_SB(1, 0), cB + kstep, voffB); PG8_STAGE(PG8_SA(1, 0), cA + kstep, voffA[0]); PG8_STAGE(PG8_SB(1, 1), cB + hstep + kstep, voffB);
        PG8_WAIT_V(6); PG8_BAR;
    }
    for (;;) {
        const bool has_next = S.next(ui + 1, nxt);
        if (has_next) { PG8_MKOFF(nxt, nvoffA); }
        else {
#pragma unroll
            for (int h = 0; h < 2; ++h)
#pragma unroll
                for (int i = 0; i < 2; ++i) nvoffA[h][i] = voffA[h][i]; }
        const char* nA = has_next ? nxt.A : cA; const char* nB = has_next ? nxt.B : cB;
        for (int t = 0; t < nt; t += 2) {
            const bool last = (t == nt - 2);
            const char* a1 = cA + (size_t)(t + 1) * kstep;
            const char* a2 = last ? nA : cA + (size_t)(t + 2) * kstep; const char* b2 = last ? nB : cB + (size_t)(t + 2) * kstep;
            const char* a3 = a2 + kstep; const char* b3 = b2 + kstep;
            unsigned v2[2][2];
#pragma unroll
            for (int h = 0; h < 2; ++h)
#pragma unroll
                for (int i = 0; i < 2; ++i) v2[h][i] = last ? nvoffA[h][i] : voffA[h][i];
            if constexpr (SP2) {
            PG8_LDB(B0, 0, 0); PG8_LDB(B1, 0, 1); PG8_SCHED; PG8_LDA(At, 0, 0); PG8_STAGE(PG8_SA(1, 1), a1, voffA[1]);
            PG8_WAIT_V(8); PG8_WAIT_L(0); PG8_BAR; PG8_MMA(0, 0, At, B0); PG8_MMA(0, 1, At, B1); PG8_BAR; PG8_SCHED;
            PG8_LDA(At, 0, 1); PG8_STAGE(PG8_SB(0, 0), b2, voffB); PG8_STAGE(PG8_SB(0, 1), b2 + hstep, voffB); PG8_STAGE(PG8_SA(0, 0), a2, v2[0]);
            PG8_WAIT_V(8); PG8_WAIT_L(0); PG8_BAR; PG8_MMA(1, 0, At, B0); PG8_MMA(1, 1, At, B1); PG8_BAR; PG8_SCHED;
            PG8_LDB(B0, 1, 0); PG8_LDB(B1, 1, 1); PG8_SCHED; PG8_LDA(At, 1, 0); PG8_STAGE(PG8_SA(0, 1), a2, v2[1]);
            PG8_WAIT_V(8); PG8_WAIT_L(0); PG8_BAR; PG8_MMA(0, 0, At, B0); PG8_MMA(0, 1, At, B1); PG8_BAR; PG8_SCHED;
            PG8_LDA(At, 1, 1); PG8_STAGE(PG8_SB(1, 0), b3, voffB); PG8_STAGE(PG8_SB(1, 1), b3 + hstep, voffB); PG8_STAGE(PG8_SA(1, 0), a3, v2[0]);
            PG8_WAIT_V(8); PG8_WAIT_L(0); PG8_BAR; PG8_MMA(1, 0, At, B0); PG8_MMA(1, 1, At, B1); PG8_BAR; PG8_SCHED;
            } else {
            PG8_LDB(B0, 0, 0); PG8_SCHED; PG8_LDA(At, 0, 0); PG8_STAGE(PG8_SA(1, 1), a1, voffA[1]);
            PG8_WAIT_L(8); PG8_BAR; PG8_WAIT_L(0); PG8_MMA(0, 0, At, B0); PG8_BAR; PG8_SCHED;
            PG8_LDB(B1, 0, 1); PG8_STAGE(PG8_SB(0, 0), b2, voffB);
            PG8_BAR; PG8_WAIT_L(0); PG8_MMA(0, 1, At, B1); PG8_BAR;
            PG8_LDA(At, 0, 1); PG8_STAGE(PG8_SA(0, 0), a2, v2[0]);
            PG8_BAR; PG8_WAIT_L(0); PG8_MMA(1, 0, At, B0); PG8_BAR; PG8_SCHED;
            PG8_STAGE(PG8_SB(0, 1), b2 + hstep, voffB);
            PG8_WAIT_V(6); PG8_BAR; PG8_MMA(1, 1, At, B1); PG8_BAR;
            PG8_LDB(B0, 1, 0); PG8_SCHED; PG8_LDA(At, 1, 0); PG8_STAGE(PG8_SA(0, 1), a2, v2[1]);
            PG8_WAIT_L(8); PG8_BAR; PG8_WAIT_L(0); PG8_MMA(0, 0, At, B0); PG8_BAR; PG8_SCHED;
            PG8_LDB(B1, 1, 1); PG8_STAGE(PG8_SB(1, 0), b3, voffB);
            PG8_BAR; PG8_WAIT_L(0); PG8_MMA(0, 1, At, B1); PG8_BAR;
            PG8_LDA(At, 1, 1); PG8_STAGE(PG8_SA(1, 0), a3, v2[0]);
            PG8_BAR; PG8_WAIT_L(0); PG8_MMA(1, 0, At, B0); PG8_BAR; PG8_SCHED;
            PG8_STAGE(PG8_SB(1, 1), b3 + hstep, voffB);
            PG8_WAIT_V(6); PG8_BAR; PG8_MMA(1, 1, At, B1); PG8_BAR;
            }
        }
        if constexpr (ALIGN_EPI) { if (wr == 0) PG8_BAR; }
        E(acc, cur, wr, wc, fr, fq);
        if (!has_next) break;
#pragma unroll
        for (int a = 0; a < 2; ++a)
#pragma unroll
            for (int b = 0; b < 2; ++b)
#pragma unroll
                for (int m = 0; m < 4; ++m)
#pragma unroll
                    for (int n = 0; n < 2; ++n) acc[a][b][m][n] = (f32x4){0.f, 0.f, 0.f, 0.f};
        cur = nxt; cA = nA; cB = nB; ++ui;
#pragma unroll
        for (int h = 0; h < 2; ++h)
#pragma unroll
            for (int i = 0; i < 2; ++i) voffA[h][i] = nvoffA[h][i];
        if constexpr (ALIGN_EPI) { if (wr == 1) PG8_BAR; }
    }
    PG8_WAIT_V(0);
    if constexpr (!ALIGN_EPI) { if (wr == 0) PG8_BAR; }
    PG8_BAR;
#undef PG8_MKOFF
#undef PG8_SA
#undef PG8_SB
#undef PG8_STAGE
#undef PG8_LDA
#undef PG8_LDB
#undef PG8_MMA
#undef PG8_WAIT_V
#undef PG8_WAIT_L
#undef PG8_BAR
#undef PG8_SCHED
}
__device__ __forceinline__ int xcd_remap(int L, int nwg) { const int q = nwg / 8, r = nwg % 8, xcd = L % 8, off = L / 8; return (xcd < r ? xcd * (q + 1) : r * (q + 1) + (xcd - r) * q) + off; }
}

constexpr int LDS_MM_OFF = 131072;

struct OrderInProj { int G, c; const char* H; const char* W;
    __device__ __forceinline__ bool next(int i, pg8::Unit& u) const {
        const int L = i * G + c; if (L >= 1792) return false;
        int pmg, pn;
        if (L < 1664) { const int wgid = pg8::xcd_remap(L, 1664); const int nig = 8 * 13, gid = wgid / nig, p = gid * 8 + ((wgid % nig) & 7); pn = (wgid % nig) >> 3; pmg = (p >> 3) * 9 + 1 + (p & 7); }
        else { const int idx = L - 1664, p = idx & 15, ci = idx >> 4; pmg = p * 9; pn = ci < 4 ? 2 + ci : (ci < 7 ? 3 + ci : 12); }
        u.A = H + (size_t)pmg * 256 * 2048; u.B = W + (size_t)pn * 256 * 2048; u.row0 = pmg * 256; u.col0 = pn * 256; u.ge = -1; u.gp = 0; return true; } };
struct OrderOutProj { int G, c; const char* A; const char* W;
    __device__ __forceinline__ bool next(int i, pg8::Unit& u) const {
        const int L = i * G + c; if (L >= 512) return false;
        const int wgid = pg8::xcd_remap(L, 512); const int nig = 8 * 4, gid = wgid / nig, pm = gid * 8 + ((wgid % nig) & 7), pn = (wgid % nig) >> 3;
        u.A = A + (size_t)pm * 256 * 2048; u.B = W + (size_t)pn * 256 * 2048; u.row0 = pm * 256; u.col0 = pn * 256; u.ge = -1; u.gp = 0; return true; } };
struct OrderGateUp { int G, c; const char* H2; const char* W; const LAS int* mm;
    __device__ __forceinline__ bool next(int i, pg8::Unit& u) const {
        const int nwg = mm[64] * 4, L = i * G + c; if (L >= nwg) return false;
        const int wgid = pg8::xcd_remap(L, nwg), tt = wgid >> 2, pn = wgid & 3, e = moe_tile_expert(mm, tt);
        u.A = H2; u.B = W + ((size_t)e * 1024 + pn * 256) * 2048; u.row0 = tt * 256; u.col0 = pn * 256; u.ge = e; u.gp = (tt - mm[32 + e]) * 256; return true; } };
struct OrderDown { int G, c; const char* HM; const char* W; const LAS int* mm;
    __device__ __forceinline__ bool next(int i, pg8::Unit& u) const {
        const int nwg = mm[64] * 4, L = i * G + c; if (L >= nwg) return false;
        const int wgid = pg8::xcd_remap(L, nwg), tt = wgid >> 2, pn = wgid & 3, e = moe_tile_expert(mm, tt);
        u.A = HM + (size_t)tt * 256 * 1024; u.B = W + ((size_t)e * 1024 + pn * 256) * 1024; u.row0 = tt * 256; u.col0 = pn * 256; u.ge = -1; u.gp = 0; return true; } };

__device__ __forceinline__ void ph_inproj(const Ctx& c, LAS unsigned char* lds) {
    pg8::Gemm g{1024, nullptr, nullptr}; OrderInProj S{(int)gridDim.x, (int)blockIdx.x, (const char*)(c.ws + WS_H), (const char*)(c.ws + WS_WIN_T)};
    pg8::Epi8<EpiInProj> E{EpiInProj{c.ws}};
    pg8::gemm_phase<pg8::Epi8<EpiInProj>, OrderInProj, false>(lds, g, S, E);
}
__device__ __forceinline__ void ph_outproj(const Ctx& c, LAS unsigned char* lds) {
    pg8::Gemm g{1024, nullptr, nullptr}; OrderOutProj S{(int)gridDim.x, (int)blockIdx.x, (const char*)(c.ws + WS_MIX), (const char*)(c.ws + WS_WOUT_T)};
    pg8::EpiOutProjB E{c.x, (const float*)(c.ws + WS_MOD), (bf16*)(c.ws + WS_X1), (float*)(c.ws + WS_SSP)};
    pg8::gemm_phase<pg8::EpiOutProjB, OrderOutProj, false>(lds, g, S, E);
}
__device__ __forceinline__ void ph_gateup(const Ctx& c, LAS unsigned char* lds) {
    LAS int* mm = (LAS int*)(lds + LDS_MM_OFF); moe_build(mm, (const unsigned*)(c.ws + WS_CTL));
    pg8::Gemm g{1024, (const int*)(c.ws + WS_LIST), mm}; OrderGateUp S{(int)gridDim.x, (int)blockIdx.x, (const char*)(c.ws + WS_H2), (const char*)(c.ws + WS_WGU_T), mm};
    pg8::Epi8<EpiGateUp> E{EpiGateUp{(bf16*)(c.ws + WS_HMID)}};
    pg8::gemm_phase<pg8::Epi8<EpiGateUp>, OrderGateUp, true>(lds, g, S, E);
}
__device__ __forceinline__ void ph_down(const Ctx& c, LAS unsigned char* lds) {
    LAS int* mm = (LAS int*)(lds + LDS_MM_OFF); moe_build(mm, (const unsigned*)(c.ws + WS_CTL));
    pg8::Gemm g{512, nullptr, mm}; OrderDown S{(int)gridDim.x, (int)blockIdx.x, (const char*)(c.ws + WS_HMID), (const char*)(c.ws + WS_WD_T), mm};
    pg8::Epi8<EpiDown> E{EpiDown{(bf16*)(c.ws + WS_YB)}};
    pg8::gemm_phase<pg8::Epi8<EpiDown>, OrderDown, false>(lds, g, S, E);
}

__device__ __forceinline__ float da_lambda_full(const float* lp) {
    float s0 = 0.f, s1 = 0.f;
    for (int i = 0; i < 64; ++i) { s0 += lp[i] * lp[64 + i]; s1 += lp[128 + i] * lp[192 + i]; }
    return expf(s0) - expf(s1) + LAMBDA_INIT;
}
namespace da {
typedef short bf16x8 __attribute__((ext_vector_type(8)));
typedef short s16x4 __attribute__((ext_vector_type(4)));
typedef float f32x16 __attribute__((ext_vector_type(16)));
typedef float f32x2_t __attribute__((ext_vector_type(2))); typedef __bf16 bf16x2_t __attribute__((ext_vector_type(2)));
__device__ __forceinline__ unsigned cvtpk(float lo, float hi) { f32x2_t v = {lo, hi}; bf16x2_t b = __builtin_convertvector(v, bf16x2_t); return __builtin_bit_cast(unsigned, b); }
__device__ __forceinline__ bf16x8 pack_half(const f32x16& x, int s) {
    u32x4 p; p.x = cvtpk(x[8 * s], x[8 * s + 1]); p.y = cvtpk(x[8 * s + 2], x[8 * s + 3]); p.z = cvtpk(x[8 * s + 4], x[8 * s + 5]); p.w = cvtpk(x[8 * s + 6], x[8 * s + 7]);
    return __builtin_bit_cast(bf16x8, p); }
__device__ __forceinline__ s16x4 vtr(const LAS unsigned char* p) { return __builtin_bit_cast(s16x4, __builtin_amdgcn_ds_read_tr16_b64_v4i16((LAS s16x4*)p)); }
#define DA_MFMA(a, b, c) __builtin_amdgcn_mfma_f32_32x32x16_bf16((a), (b), (c), 0, 0, 0)
constexpr int NT = KVL / 64;
constexpr int QS_OFF = 81920;

template <int KB> __device__ __forceinline__ void qk_tile(const LAS unsigned char* kq, const bf16x8 (&qf)[4], const f32x16& negm, f32x16& s0, f32x16& s1) {
#pragma unroll
    for (int ks = 0; ks < 4; ++ks) {
        const bf16x8 k0 = *(const LAS bf16x8*)(kq + KB + ks * 2048), k1 = *(const LAS bf16x8*)(kq + KB + ks * 2048 + 512), qq = qf[ks];
        if (ks == 0) { s0 = DA_MFMA(k0, qq, negm); s1 = DA_MFMA(k1, qq, negm); } else { s0 = DA_MFMA(k0, qq, s0); s1 = DA_MFMA(k1, qq, s1); } }
}
__device__ __forceinline__ float max3f(float a, float b, float c) { return fmaxf(fmaxf(a, b), c); }
template <int VB> __device__ __forceinline__ void softmax_pv(const LAS unsigned char* lds, int vlane, f32x16& s0, f32x16& s1, f32x16 (&O)[4], f32x16& negm, float& lrun) {
    float ma = max3f(s0[0], s0[1], s1[0]), mb = max3f(s0[2], s0[3], s1[1]); ma = max3f(ma, s1[2], s1[3]);
#pragma unroll
    for (int r = 4; r < 16; r += 4) { ma = max3f(ma, s0[r], s0[r + 1]); mb = max3f(mb, s0[r + 2], s0[r + 3]); ma = max3f(ma, s1[r], s1[r + 1]); mb = max3f(mb, s1[r + 2], s1[r + 3]); }
    float mx = fmaxf(ma, mb);
    mx = fmaxf(mx, __shfl_xor(mx, 32));
    if (__any(mx > 8.0f)) {
        const float dl = fmaxf(mx, 0.f), alpha = __builtin_amdgcn_exp2f(-dl);
        lrun *= alpha;
#pragma unroll
        for (int r = 0; r < 16; ++r) { s0[r] -= dl; s1[r] -= dl; negm[r] -= dl; }
#pragma unroll
        for (int dt = 0; dt < 4; ++dt)
#pragma unroll
            for (int r = 0; r < 16; ++r) O[dt][r] *= alpha;
    }
    const unsigned vb = (unsigned)(size_t)(lds + VB + vlane);
    s16x4 fa[8], fb[8]; bf16x8 Pa, Pb; float ps = 0.f;
#define DA_VRDK(dst, ks) do { _Pragma("unroll") for (int _d = 0; _d < 4; ++_d) { \
        asm volatile("ds_read_b64_tr_b16 %0, %1 offset:%2" : "=&v"(dst[2 * _d]) : "v"(vb), "n"((_d * 4 + (ks)) * 1024) : "memory"); \
        asm volatile("ds_read_b64_tr_b16 %0, %1 offset:%2" : "=&v"(dst[2 * _d + 1]) : "v"(vb), "n"((_d * 4 + (ks)) * 1024 + 512) : "memory"); } } while (0)
#define DA_VWAIT(N, f) asm volatile("s_waitcnt lgkmcnt(" #N ")" : "+v"(f[0]), "+v"(f[1]), "+v"(f[2]), "+v"(f[3]), "+v"(f[4]), "+v"(f[5]), "+v"(f[6]), "+v"(f[7]) :: "memory")
#define DA_EXP2(S, r0) do { S[r0] = __builtin_amdgcn_exp2f(S[r0]); S[(r0) + 1] = __builtin_amdgcn_exp2f(S[(r0) + 1]); ps += S[r0] + S[(r0) + 1]; } while (0)
#define DA_MX(f, Pcur, d, S, r0) do { O[d] = DA_MFMA(__builtin_shufflevector(f[2 * (d)], f[2 * (d) + 1], 0, 1, 2, 3, 4, 5, 6, 7), Pcur, O[d]); DA_EXP2(S, r0); __builtin_amdgcn_sched_barrier(0); } while (0)
    DA_VRDK(fa, 0); DA_VRDK(fb, 1);
    DA_EXP2(s0, 0); DA_EXP2(s0, 2); DA_EXP2(s0, 4); DA_EXP2(s0, 6); Pa = pack_half(s0, 0);
    DA_VWAIT(8, fa); __builtin_amdgcn_sched_barrier(0);
    DA_MX(fa, Pa, 0, s0, 8); DA_MX(fa, Pa, 1, s0, 10); DA_MX(fa, Pa, 2, s0, 12); DA_MX(fa, Pa, 3, s0, 14); Pb = pack_half(s0, 1);
    DA_VRDK(fa, 2); DA_VWAIT(8, fb); __builtin_amdgcn_sched_barrier(0);
    DA_MX(fb, Pb, 0, s1, 0); DA_MX(fb, Pb, 1, s1, 2); DA_MX(fb, Pb, 2, s1, 4); DA_MX(fb, Pb, 3, s1, 6); Pa = pack_half(s1, 0);
    DA_VRDK(fb, 3); DA_VWAIT(8, fa); __builtin_amdgcn_sched_barrier(0);
    DA_MX(fa, Pa, 0, s1, 8); DA_MX(fa, Pa, 1, s1, 10); DA_MX(fa, Pa, 2, s1, 12); DA_MX(fa, Pa, 3, s1, 14); Pb = pack_half(s1, 1);
    DA_VWAIT(0, fb); __builtin_amdgcn_sched_barrier(0);
#pragma unroll
    for (int d = 0; d < 4; ++d) O[d] = DA_MFMA(__builtin_shufflevector(fb[2 * d], fb[2 * d + 1], 0, 1, 2, 3, 4, 5, 6, 7), Pb, O[d]);
    lrun += ps;
#undef DA_VRDK
#undef DA_VWAIT
#undef DA_EXP2
#undef DA_MX
}

template <int m> __device__ __forceinline__ void attn_body(const Ctx& c, LAS unsigned char* lds) {
    const int tid = threadIdx.x, lane = tid & 63, wid = __builtin_amdgcn_readfirstlane(tid >> 6), r32 = lane & 31, hi = lane >> 5;
    const int qsub = wid & 3;
    const bf16* Q = (const bf16*)(c.ws + WS_QDA); const bf16* K = (const bf16*)(c.ws + WS_KDA); const bf16* V = (const bf16*)(c.ws + WS_VDA); bf16* MIX = (bf16*)(c.ws + WS_MIX);
    const float lam = da_lambda_full(c.da_lambda);
    const int vlane = (4 * hi + ((lane & 15) >> 2)) * 64 + ((lane >> 4) & 1) * 32 + (lane & 3) * 8;
    const LAS unsigned char* kq = lds + (m * 8 + hi) * 1024 + r32 * 16;
    const unsigned kgo0 = (unsigned)(lane * 512 + (wid * 2) * 8) * 2u, kgo1 = kgo0 + 16u;
    const unsigned vgo0 = (unsigned)((((wid * 2) & 3) * 16 + (lane >> 2)) * 512 + ((wid * 2) >> 2) * 32 + (lane & 3) * 8) * 2u, vgo1 = vgo0 + 16u * 512u * 2u;
    for (int it = 0;; ++it) {
        const int L = it * (int)gridDim.x + (int)blockIdx.x; if (L >= 1024) break;
        const int wg = pg8::xcd_remap(L, 1024), bh = wg >> 4, qb = wg & 15, b = bh >> 2, h = bh & 3;
        const char* Kb = (const char*)(K + (size_t)b * KVL * 512 + h * 128); const char* Vb = (const char*)(V + (size_t)b * KVL * 512 + h * 128);
        const size_t qrow = (size_t)b * SEQ + qb * 128 + qsub * 32 + r32;
#define DA_DMA_K(t, bo) do { const size_t _to = (size_t)(t) * (64 * 512 * 2); \
            __builtin_amdgcn_global_load_lds((const unsigned*)(Kb + _to + kgo0), (LAS unsigned*)(lds + (bo) + (wid * 2) * 1024), 16, 0, 0); \
            __builtin_amdgcn_global_load_lds((const unsigned*)(Kb + _to + kgo1), (LAS unsigned*)(lds + (bo) + (wid * 2 + 1) * 1024), 16, 0, 0); } while (0)
#define DA_DMA_V(t, bo) do { const size_t _to = (size_t)(t) * (64 * 512 * 2); \
            __builtin_amdgcn_global_load_lds((const unsigned*)(Vb + _to + vgo0), (LAS unsigned*)(lds + (bo) + (wid * 2) * 1024), 16, 0, 0); \
            __builtin_amdgcn_global_load_lds((const unsigned*)(Vb + _to + vgo1), (LAS unsigned*)(lds + (bo) + (wid * 2 + 1) * 1024), 16, 0, 0); } while (0)
        DA_DMA_K(0, 0); DA_DMA_K(1, 16384); DA_DMA_K(2, 32768); DA_DMA_V(0, 65536); DA_DMA_V(1, 81920);
        bf16x8 qf[4];
#pragma unroll
        for (int ks = 0; ks < 4; ++ks) qf[ks] = *(const bf16x8*)(Q + qrow * 512 + h * 128 + m * 64 + ks * 16 + hi * 8);
        f32x16 O[4];
#pragma unroll
        for (int dt = 0; dt < 4; ++dt)
#pragma unroll
            for (int r = 0; r < 16; ++r) O[dt][r] = 0.f;
        float lrun = 0.f; f32x16 negm, s0, s1;
#pragma unroll
        for (int r = 0; r < 16; ++r) negm[r] = 0.f;
        asm volatile("s_waitcnt vmcnt(0) lgkmcnt(0)\n\ts_barrier" ::: "memory");
        if constexpr (m == 1) qk_tile<0>(kq, qf, negm, s0, s1);
#define DA_STEP(tt, KBC, KBN, KB3, VBC, VB2) do { \
            if ((tt) + 3 < NT) DA_DMA_K((tt) + 3, KB3); else DA_DMA_K(NT - 1, KB3); \
            if ((tt) + 2 < NT) DA_DMA_V((tt) + 2, VB2); else DA_DMA_V(NT - 1, VB2); \
            if constexpr (m == 0) { qk_tile<KBC>(kq, qf, negm, s0, s1); softmax_pv<VBC>(lds, vlane, s0, s1, O, negm, lrun); } \
            else { softmax_pv<VBC>(lds, vlane, s0, s1, O, negm, lrun); if ((tt) + 1 < NT) qk_tile<KBN>(kq, qf, negm, s0, s1); } \
            asm volatile("s_waitcnt vmcnt(4) lgkmcnt(0)\n\ts_barrier" ::: "memory"); } while (0)
        for (int t = 0; t < NT; t += 12) {
            DA_STEP(t + 0, 0, 16384, 49152, 65536, 98304);
            DA_STEP(t + 1, 16384, 32768, 0, 81920, 65536);
            DA_STEP(t + 2, 32768, 49152, 16384, 98304, 81920);
            DA_STEP(t + 3, 49152, 0, 32768, 65536, 98304);
            DA_STEP(t + 4, 0, 16384, 49152, 81920, 65536);
            DA_STEP(t + 5, 16384, 32768, 0, 98304, 81920);
            DA_STEP(t + 6, 32768, 49152, 16384, 65536, 98304);
            DA_STEP(t + 7, 49152, 0, 32768, 81920, 65536);
            DA_STEP(t + 8, 0, 16384, 49152, 98304, 81920);
            DA_STEP(t + 9, 16384, 32768, 0, 65536, 98304);
            DA_STEP(t + 10, 32768, 49152, 16384, 81920, 65536);
            DA_STEP(t + 11, 49152, 0, 32768, 98304, 81920);
        }
#undef DA_STEP
        asm volatile("s_waitcnt vmcnt(0) lgkmcnt(0)\n\ts_barrier" ::: "memory");
        const float lt = lrun + __shfl_xor(lrun, 32);
        LAS float* xch = (LAS float*)(lds + qsub * 16384) + lane;
        if (m == 1) { const float sc = lam / lt;
#pragma unroll
            for (int dt = 0; dt < 4; ++dt)
#pragma unroll
                for (int r = 0; r < 16; ++r) xch[(dt * 16 + r) * 64] = O[dt][r] * sc; }
        __syncthreads();
        if (m == 0) { const float i1 = 1.0f / lt; float ss = 0.f;
#pragma unroll
            for (int dt = 0; dt < 4; ++dt)
#pragma unroll
                for (int r = 0; r < 16; ++r) { const float a = O[dt][r] * i1 - xch[(dt * 16 + r) * 64]; O[dt][r] = a; ss += a * a; }
            ss += __shfl_xor(ss, 32);
            const float rstd = rsqrtf(ss * (1.0f / 128.0f) + NORM_EPS) * (1.0f - LAMBDA_INIT);
            bf16* orow = MIX + qrow * 1024 + h * 128;
#pragma unroll
            for (int dt = 0; dt < 4; ++dt)
#pragma unroll
                for (int g4 = 0; g4 < 4; ++g4) { const int d0 = 32 * dt + 8 * g4 + 4 * hi; const f32x4 gg = *(const f32x4*)(c.da_subln_g + d0);
                    u32x2 w; w.x = cvtpk(O[dt][4 * g4] * rstd * gg.x, O[dt][4 * g4 + 1] * rstd * gg.y); w.y = cvtpk(O[dt][4 * g4 + 2] * rstd * gg.z, O[dt][4 * g4 + 3] * rstd * gg.w);
                    *(u32x2*)(orow + d0) = w; } }
        __syncthreads();
#undef DA_DMA_K
#undef DA_DMA_V
    }
}
__device__ __forceinline__ void attn_phase(const Ctx& c, LAS unsigned char* lds) {
    if (__builtin_amdgcn_readfirstlane((int)threadIdx.x >> 8) == 0) attn_body<0>(c, lds); else attn_body<1>(c, lds);
}
#undef DA_MFMA
}

namespace gla {
using da::bf16x8; using da::s16x4; using da::f32x16; using da::cvtpk; using da::pack_half; using da::vtr;
#define GL_MFMA(a, b, c) __builtin_amdgcn_mfma_f32_32x32x16_bf16((a), (b), (c), 0, 0, 0)
constexpr int NTASK = NB * 4 * 2 * 36;
constexpr int PT64_BYTES = 8192;
constexpr int PTV_BYTES = 16384;

template <int CTRL, int RM, bool BC> __device__ __forceinline__ float dpp_get(float x) { return __builtin_bit_cast(float, __builtin_amdgcn_update_dpp(0, __builtin_bit_cast(int, x), CTRL, RM, 0xf, BC)); }
__device__ __forceinline__ float scan32(float x) {
    x += dpp_get<0x111, 0xf, true>(x); x += dpp_get<0x112, 0xf, true>(x); x += dpp_get<0x114, 0xf, true>(x); x += dpp_get<0x118, 0xf, true>(x);
    x += dpp_get<0x142, 0xa, false>(x);
    return x; }
__device__ __forceinline__ float last32(float x, int hi) {
    const float a = __builtin_bit_cast(float, __builtin_amdgcn_readlane(__builtin_bit_cast(int, x), 31)), b = __builtin_bit_cast(float, __builtin_amdgcn_readlane(__builtin_bit_cast(int, x), 63));
    return hi ? b : a; }
template <int DK0, int DK1> __device__ __forceinline__ void g0_task(const Ctx& c, const LAS unsigned char* w2f, const LAS float* gbs, int u, int lane, int r32, int hi) {
    bf16* KE = (bf16*)(c.ws + WS_KEND); bf16* QD = (bf16*)(c.ws + WS_QD); bf16* KI = (bf16*)(c.ws + WS_KI); float* DB = (float*)(c.ws + WS_DB);
        const int cc = u % 36, chain = u / 36, dir = chain & 1, h = (chain >> 1) & 3, b = chain >> 3, bh = chain >> 1;
        const bool lat = cc >= 4;
        const size_t row0 = (size_t)b * KVL + cc * 64 + r32;
        bf16x8 lrh[2], lrl[2];
#pragma unroll
        for (int T = 0; T < 2; ++T) { const float* lr = (const float*)(c.ws + WS_LR) + (row0 + 32 * T) * 32 + dir * 16 + 8 * hi;
            const f32x4 x0 = *(const f32x4*)lr, x1 = *(const f32x4*)(lr + 4);
            u32x4 ph; ph.x = pk2(x0.x, x0.y); ph.y = pk2(x0.z, x0.w); ph.z = pk2(x1.x, x1.y); ph.w = pk2(x1.z, x1.w);
            u32x4 pl; pl.x = pk2(x0.x - bflo(ph.x), x0.y - bfhi(ph.x)); pl.y = pk2(x0.z - bflo(ph.y), x0.w - bfhi(ph.y)); pl.z = pk2(x1.x - bflo(ph.z), x1.y - bfhi(ph.z)); pl.w = pk2(x1.z - bflo(ph.w), x1.w - bfhi(ph.w));
            lrh[T] = __builtin_bit_cast(bf16x8, ph); lrl[T] = __builtin_bit_cast(bf16x8, pl); }
        const bf16* kbase = (const bf16*)(c.ws + WS_GK) + row0 * 256 + h * 64;
        const bf16* qbase = (const bf16*)(c.ws + WS_GQ) + ((size_t)b * SEQ + (lat ? (cc - 4) * 64 + r32 : 0)) * 256 + h * 64;
        bf16* kebase = KE + ((size_t)u * 64 + r32) * 64;
        const size_t qo = (((size_t)(dir * 64 + bh) * 32 + (lat ? cc - 4 : 0)) * 64 + r32) * 64;
#pragma unroll
        for (int Dk = DK0; Dk < DK1; ++Dk) {
            const LAS unsigned char* wf = w2f + (((dir * 4 + h) * 2 + Dk) * 64 + lane) * 32;
            const bf16x8 wh = *(const LAS bf16x8*)wf, wl = *(const LAS bf16x8*)(wf + 16);
            f32x16 z[2];
#pragma unroll
            for (int T = 0; T < 2; ++T) {
#pragma unroll
                for (int r = 0; r < 16; ++r) z[T][r] = 0.f;
                z[T] = GL_MFMA(wh, lrh[T], z[T]); z[T] = GL_MFMA(wl, lrh[T], z[T]); z[T] = GL_MFMA(wh, lrl[T], z[T]); }
            u32x2 kv[2][4], qv[2][4];
#pragma unroll
            for (int T = 0; T < 2; ++T)
#pragma unroll
                for (int g4 = 0; g4 < 4; ++g4) { const int dko = 32 * Dk + 8 * g4 + 4 * hi; kv[T][g4] = *(const u32x2*)(kbase + (size_t)(32 * T) * 256 + dko); qv[T][g4] = *(const u32x2*)(qbase + (size_t)(lat ? 32 * T : 0) * 256 + dko); }
            float g[2][16], inc[2][16], dtot[16], tot[16];
#pragma unroll
            for (int g4 = 0; g4 < 4; ++g4) { const f32x4 bs = *(const LAS f32x4*)(gbs + dir * 256 + h * 64 + 32 * Dk + 8 * g4 + 4 * hi);
#pragma unroll
                for (int j = 0; j < 4; ++j)
#pragma unroll
                    for (int T = 0; T < 2; ++T) { const float zz = z[T][4 * g4 + j] + bs[j];
                        const float t = __builtin_amdgcn_exp2f(-fabsf(zz) * 1.4426950408889634f);
                        g[T][4 * g4 + j] = (fminf(zz, 0.f) - __builtin_amdgcn_logf(1.0f + t) * 0.6931471805599453f) * (1.0f / 16.0f); } }
#pragma unroll
            for (int r = 0; r < 16; ++r) { inc[0][r] = scan32(g[0][r]); const float l0 = last32(inc[0][r], hi); inc[1][r] = scan32(g[1][r]) + l0; tot[r] = last32(inc[1][r], hi); dtot[r] = __builtin_amdgcn_exp2f(tot[r] * 1.4426950408889634f); }
#pragma unroll
            for (int T = 0; T < 2; ++T)
#pragma unroll
                for (int g4 = 0; g4 < 4; ++g4) { const int dko = 32 * Dk + 8 * g4 + 4 * hi;
                    float eq[4], ek[4], ee[4];
#pragma unroll
                    for (int j = 0; j < 4; ++j) { const int r = 4 * g4 + j; const float bc = dir == 0 ? inc[T][r] : tot[r] - inc[T][r] + g[T][r];
                        eq[j] = __builtin_amdgcn_exp2f(bc * 1.4426950408889634f); ek[j] = __builtin_amdgcn_rcpf(eq[j]); ee[j] = ek[j] * dtot[r]; }
                    const float k0 = bflo(kv[T][g4].x), k1 = bfhi(kv[T][g4].x), k2 = bflo(kv[T][g4].y), k3 = bfhi(kv[T][g4].y);
                    u32x2 e2; e2.x = cvtpk(k0 * ee[0], k1 * ee[1]); e2.y = cvtpk(k2 * ee[2], k3 * ee[3]);
                    *(u32x2*)(kebase + (size_t)(32 * T) * 64 + dko) = e2;
                    if (lat) { const float q0 = bflo(qv[T][g4].x), q1 = bfhi(qv[T][g4].x), q2 = bflo(qv[T][g4].y), q3 = bfhi(qv[T][g4].y);
                        u32x2 a2, k2v; a2.x = cvtpk(q0 * eq[0], q1 * eq[1]); a2.y = cvtpk(q2 * eq[2], q3 * eq[3]); k2v.x = cvtpk(k0 * ek[0], k1 * ek[1]); k2v.y = cvtpk(k2 * ek[2], k3 * ek[3]);
                        *(u32x2*)(QD + qo + (size_t)(32 * T) * 64 + dko) = a2; *(u32x2*)(KI + qo + (size_t)(32 * T) * 64 + dko) = k2v; } }
            if (r32 == 0) {
#pragma unroll
                for (int g4 = 0; g4 < 4; ++g4) *(f32x4*)(DB + (size_t)u * 64 + 32 * Dk + 8 * g4 + 4 * hi) = (f32x4){dtot[4 * g4], dtot[4 * g4 + 1], dtot[4 * g4 + 2], dtot[4 * g4 + 3]}; }
        }
    }
__device__ __forceinline__ void g0_phase(const Ctx& c, LAS unsigned char* lds) {
    const int tid = threadIdx.x, lane = tid & 63, w = __builtin_amdgcn_readfirstlane(tid >> 6), r32 = lane & 31, hi = lane >> 5;
    LAS unsigned char* w2f = lds;
    LAS float* gbs = (LAS float*)(lds + 32768);
    for (int q = tid; q < 16 * 64; q += 512) { const int combo = q >> 6, l = q & 63, dir = combo >> 3, h = (combo >> 1) & 3, Dk = combo & 1, dk = h * 64 + 32 * Dk + (l & 31), hh = l >> 5;
        float v[8];
#pragma unroll
        for (int j = 0; j < 8; ++j) v[j] = c.gate_w2[(dir * 16 + 8 * hh + j) * 256 + dk];
        u32x4 ph; ph.x = pk2(v[0], v[1]); ph.y = pk2(v[2], v[3]); ph.z = pk2(v[4], v[5]); ph.w = pk2(v[6], v[7]);
        u32x4 pl; pl.x = pk2(v[0] - bflo(ph.x), v[1] - bfhi(ph.x)); pl.y = pk2(v[2] - bflo(ph.y), v[3] - bfhi(ph.y)); pl.z = pk2(v[4] - bflo(ph.z), v[5] - bfhi(ph.z)); pl.w = pk2(v[6] - bflo(ph.w), v[7] - bfhi(ph.w));
        *(LAS u32x4*)(w2f + q * 32) = ph; *(LAS u32x4*)(w2f + q * 32 + 16) = pl; }
    if (tid < 128) *(LAS f32x4*)(gbs + 4 * tid) = *(const f32x4*)(c.gate_b + 4 * tid);
    __syncthreads();
    const int gwv = blockIdx.x * 8 + w, ngw = gridDim.x * 8, nfull = (NTASK / ngw) * ngw;
    for (int u = gwv; u < nfull; u += ngw) g0_task<0, 2>(c, w2f, gbs, u, lane, r32, hi);
    for (int uh = gwv; uh < 2 * (NTASK - nfull); uh += ngw) { if (uh & 1) g0_task<1, 2>(c, w2f, gbs, nfull + (uh >> 1), lane, r32, hi); else g0_task<0, 1>(c, w2f, gbs, nfull + (uh >> 1), lane, r32, hi); }
    __syncthreads();
}
__device__ __forceinline__ void dma_piece(const bf16* base, int pitch, int p, LAS unsigned char* dst, int lane) {
    __builtin_amdgcn_global_load_lds((const unsigned*)(base + (size_t)((p & 3) * 16 + (lane >> 2)) * pitch + (p >> 2) * 32 + (lane & 3) * 8), (LAS unsigned*)(dst + p * 1024), 16, 0, 0);
}
__device__ __forceinline__ void dma_chunk(const bf16* tile, int row0, int ch, LAS unsigned char* dst, int lane) {
    __builtin_amdgcn_global_load_lds((const unsigned*)(tile + (size_t)(row0 + lane) * 64 + ch * 8), (LAS unsigned*)dst, 16, 0, 0);
}
__device__ __forceinline__ void g1_phase(const Ctx& c, LAS unsigned char* lds) {
    const int tid = threadIdx.x, lane = tid & 63, w = __builtin_amdgcn_readfirstlane(tid >> 6), hi = lane >> 5, dir = w >> 2, dvt = w & 3;
    const int vlane = (4 * hi + ((lane & 15) >> 2)) * 64 + ((lane >> 4) & 1) * 32 + (lane & 3) * 8;
    const bf16* KE = (const bf16*)(c.ws + WS_KEND); const bf16* GV = (const bf16*)(c.ws + WS_GV); bf16* UT = (bf16*)(c.ws + WS_UT);
    constexpr int BUF = 32768;
    const int nun = NB * 4 * 36;
#define G1_STAGE(un, bo) do { const int _cc = (un) % 36, _bh = (un) / 36, _b = _bh >> 2, _h = _bh & 3; \
        dma_piece(GV + ((size_t)_b * KVL + _cc * 64) * 512 + _h * 128, 512, w * 2, lds + (bo), lane); dma_piece(GV + ((size_t)_b * KVL + _cc * 64) * 512 + _h * 128, 512, w * 2 + 1, lds + (bo), lane); \
        dma_piece(KE + ((size_t)(_bh * 2) * 36 + _cc) * 4096, 64, w, lds + (bo) + 16384, lane); dma_piece(KE + ((size_t)(_bh * 2 + 1) * 36 + _cc) * 4096, 64, w, lds + (bo) + 24576, lane); } while (0)
    int un = blockIdx.x, par = 0;
    if (un < nun) G1_STAGE(un, 0);
    asm volatile("s_waitcnt vmcnt(0)" ::: "memory"); __syncthreads();
    for (; un < nun; un += gridDim.x, par ^= 1) {
        const int bo = par * BUF, nx = un + (int)gridDim.x;
        if (nx < nun) G1_STAGE(nx, BUF - bo);
        const int cc = un % 36, bh = un / 36;
        const LAS unsigned char* vpt = lds + bo; const LAS unsigned char* kend = lds + bo + 16384 + dir * 8192;
        f32x16 U[2];
#pragma unroll
        for (int dkt = 0; dkt < 2; ++dkt)
#pragma unroll
            for (int r = 0; r < 16; ++r) U[dkt][r] = 0.f;
#pragma unroll
        for (int ks = 0; ks < 4; ++ks) {
            const LAS unsigned char* bp = vpt + (dvt * 4 + ks) * 1024 + vlane; const s16x4 b0 = vtr(bp), b1 = vtr(bp + 512);
            const bf16x8 bfr = __builtin_shufflevector(b0, b1, 0, 1, 2, 3, 4, 5, 6, 7);
#pragma unroll
            for (int dkt = 0; dkt < 2; ++dkt) { const LAS unsigned char* ap = kend + (dkt * 4 + ks) * 1024 + vlane; const s16x4 a0 = vtr(ap), a1 = vtr(ap + 512);
                U[dkt] = GL_MFMA(__builtin_shufflevector(a0, a1, 0, 1, 2, 3, 4, 5, 6, 7), bfr, U[dkt]); } }
        const size_t task = ((size_t)(bh * 2 + dir)) * 36 + cc;
#pragma unroll
        for (int dkt = 0; dkt < 2; ++dkt) { bf16* up = UT + task * 8192 + (size_t)(dvt * 32 + (lane & 31)) * 64 + dkt * 32 + 4 * hi;
#pragma unroll
            for (int g4 = 0; g4 < 4; ++g4) { u32x2 wv; wv.x = cvtpk(U[dkt][4 * g4], U[dkt][4 * g4 + 1]); wv.y = cvtpk(U[dkt][4 * g4 + 2], U[dkt][4 * g4 + 3]); *(u32x2*)(up + 8 * g4) = wv; } }
        asm volatile("s_waitcnt vmcnt(0)" ::: "memory"); __syncthreads();
    }
#undef G1_STAGE
}
__device__ __forceinline__ void g2_phase(const Ctx& c) {
    const bf16* UT = (const bf16*)(c.ws + WS_UT); const float* DB = (const float*)(c.ws + WS_DB); bf16* ST = (bf16*)(c.ws + WS_ST);
    for (int i = blockIdx.x * blockDim.x + threadIdx.x; i < 128 * 1024; i += gridDim.x * blockDim.x) {
        const int chain = i >> 10, e8 = i & 1023, dk0 = (e8 & 7) * 8, dir = chain & 1, bh = chain >> 1;
        float S[8];
#pragma unroll
        for (int j = 0; j < 8; ++j) S[j] = 0.f;
#pragma unroll 4
        for (int s = 0; s < 36; ++s) {
            const int cc = dir == 0 ? s : (s < 4 ? 3 - s : 39 - s);
            if (cc >= 4) { u32x4 o; o.x = cvtpk(S[0], S[1]); o.y = cvtpk(S[2], S[3]); o.z = cvtpk(S[4], S[5]); o.w = cvtpk(S[6], S[7]);
                *(u32x4*)(ST + ((size_t)(dir * 64 + bh) * 32 + (cc - 4)) * 8192 + (size_t)e8 * 8) = o; }
            const size_t u = (size_t)chain * 36 + cc;
            const u32x4 uw = *(const u32x4*)(UT + u * 8192 + (size_t)e8 * 8); const f32x4 d0 = *(const f32x4*)(DB + u * 64 + dk0), d1 = *(const f32x4*)(DB + u * 64 + dk0 + 4);
            S[0] = S[0] * d0.x + bflo(uw.x); S[1] = S[1] * d0.y + bfhi(uw.x); S[2] = S[2] * d0.z + bflo(uw.y); S[3] = S[3] * d0.w + bfhi(uw.y);
            S[4] = S[4] * d1.x + bflo(uw.z); S[5] = S[5] * d1.y + bfhi(uw.z); S[6] = S[6] * d1.z + bflo(uw.w); S[7] = S[7] * d1.w + bfhi(uw.w);
        }
    }
}
__device__ __forceinline__ void g3_phase(const Ctx& c, LAS unsigned char* lds) {
    const int tid = threadIdx.x, lane = tid & 63, w = __builtin_amdgcn_readfirstlane(tid >> 6), r32 = lane & 31, hi = lane >> 5, ih = w >> 2, dq = w & 3;
    const int vlane = (4 * hi + ((lane & 15) >> 2)) * 64 + ((lane >> 4) & 1) * 32 + (lane & 3) * 8;
    const bf16* ST = (const bf16*)(c.ws + WS_ST); const bf16* GR = (const bf16*)(c.ws + WS_GR); const bf16* GV = (const bf16*)(c.ws + WS_GV); bf16* MIX = (bf16*)(c.ws + WS_MIX);
    const bf16* QD = (const bf16*)(c.ws + WS_QD); const bf16* KI = (const bf16*)(c.ws + WS_KI);
    constexpr int BUF = 49152;
    LAS float* ssx = (LAS float*)(lds + 2 * BUF);
    const int nun = NB * 4 * 32;
#define G3_STAGE(un, bo) do { const int _cl = (un) & 31, _bh = (un) >> 5, _b = _bh >> 2, _h = _bh & 3; \
        dma_piece(GV + ((size_t)_b * KVL + (_cl + 4) * 64) * 512 + _h * 128, 512, w * 2, lds + (bo), lane); dma_piece(GV + ((size_t)_b * KVL + (_cl + 4) * 64) * 512 + _h * 128, 512, w * 2 + 1, lds + (bo), lane); \
        _Pragma("unroll") for (int _d = 0; _d < 2; ++_d) { const size_t _tb = ((size_t)(_d * 64 + _bh) * 32 + _cl) * 4096; \
            dma_chunk(QD + _tb, 0, w, lds + (bo) + 16384 + _d * 8192 + w * 1024, lane); dma_chunk(KI + _tb, 0, w, lds + (bo) + 32768 + _d * 8192 + w * 1024, lane); } } while (0)
#define G3_LOADS(u_, sa_, gr_) do { const int _cl = (u_) & 31, _bh = (u_) >> 5, _b = _bh >> 2, _h = _bh & 3; const size_t _tl = (size_t)_b * SEQ + _cl * 64 + ih * 32 + r32; \
        _Pragma("unroll") for (int _d = 0; _d < 2; ++_d) _Pragma("unroll") for (int _k = 0; _k < 4; ++_k) sa_[_d][_k] = *(const bf16x8*)(ST + ((size_t)(_d * 64 + _bh) * 32 + _cl) * 8192 + (size_t)(dq * 32 + r32) * 64 + _k * 16 + hi * 8); \
        _Pragma("unroll") for (int _g = 0; _g < 4; ++_g) gr_[_g] = *(const u32x2*)(GR + _tl * 512 + _h * 128 + dq * 32 + 8 * _g + 4 * hi); } while (0)
    int un = blockIdx.x, par = 0;
    bf16x8 sa[2][4], san[2][4]; u32x2 gr[4], grn[4];
    if (un < nun) { G3_LOADS(un, sa, gr); G3_STAGE(un, 0); }
    asm volatile("s_waitcnt vmcnt(0)" ::: "memory"); __syncthreads();
    for (; un < nun; un += gridDim.x, par ^= 1) {
        const int bo = par * BUF, nx = un + (int)gridDim.x;
        const int cl = un & 31, bh = un >> 5, b = bh >> 2, h = bh & 3;
        const size_t tl = (size_t)b * SEQ + cl * 64 + ih * 32 + r32;
        if (nx < nun) { G3_LOADS(nx, san, grn); G3_STAGE(nx, BUF - bo); }
        const LAS unsigned char* vpt = lds + bo; const LAS unsigned char* qimg = lds + bo + 16384; const LAS unsigned char* kimg = lds + bo + 32768;
        f32x16 At[2];
#pragma unroll
        for (int jt = 0; jt < 2; ++jt)
#pragma unroll
            for (int r = 0; r < 16; ++r) At[jt][r] = 0.f;
        bf16x8 qf[2][4];
#pragma unroll
        for (int dir = 0; dir < 2; ++dir) {
#pragma unroll
            for (int ks = 0; ks < 4; ++ks) qf[dir][ks] = *(const LAS bf16x8*)(qimg + dir * 8192 + (2 * ks + hi) * 1024 + (ih * 32 + r32) * 16);
#pragma unroll
            for (int jt = 0; jt < 2; ++jt) { f32x16 T;
#pragma unroll
                for (int r = 0; r < 16; ++r) T[r] = 0.f;
#pragma unroll
                for (int ks = 0; ks < 4; ++ks) { const bf16x8 a = *(const LAS bf16x8*)(kimg + dir * 8192 + (2 * ks + hi) * 1024 + (jt * 32 + r32) * 16); T = GL_MFMA(a, qf[dir][ks], T); }
                const int icol = ih * 32 + r32;
#pragma unroll
                for (int r = 0; r < 16; ++r) { const int j = jt * 32 + (r & 3) + 8 * (r >> 2) + 4 * hi; const bool keep = dir == 0 ? (j <= icol) : (j >= icol); At[jt][r] += keep ? T[r] : 0.f; } }
        }
        bf16x8 P[4];
        P[0] = pack_half(At[0], 0); P[1] = pack_half(At[0], 1); P[2] = pack_half(At[1], 0); P[3] = pack_half(At[1], 1);
        f32x16 O;
#pragma unroll
        for (int r = 0; r < 16; ++r) O[r] = 0.f;
#pragma unroll
        for (int ks = 0; ks < 4; ++ks) { const LAS unsigned char* vp = vpt + (dq * 4 + ks) * 1024 + vlane; const s16x4 lo = vtr(vp), hh = vtr(vp + 512);
            O = GL_MFMA(__builtin_shufflevector(lo, hh, 0, 1, 2, 3, 4, 5, 6, 7), P[ks], O); }
#pragma unroll
        for (int dir = 0; dir < 2; ++dir)
#pragma unroll
            for (int ks = 0; ks < 4; ++ks) O = GL_MFMA(sa[dir][ks], qf[dir][ks], O);
        float ss = 0.f;
#pragma unroll
        for (int r = 0; r < 16; ++r) ss += O[r] * O[r];
        ss += __shfl_xor(ss, 32);
        if (hi == 0) ssx[dq * 64 + ih * 32 + r32] = ss;
        __syncthreads();
        const int tokl = ih * 32 + r32; const float tot = ssx[tokl] + ssx[64 + tokl] + ssx[128 + tokl] + ssx[192 + tokl];
        const float rstd = rsqrtf(tot * (1.0f / 128.0f) + NORM_EPS);
#pragma unroll
        for (int g4 = 0; g4 < 4; ++g4) { const int dv = dq * 32 + 8 * g4 + 4 * hi; const f32x4 gn = *(const f32x4*)(c.gla_norm_g + dv);
            u32x2 wv; wv.x = cvtpk(O[4 * g4] * rstd * gn.x * silu_f(bflo(gr[g4].x)), O[4 * g4 + 1] * rstd * gn.y * silu_f(bfhi(gr[g4].x)));
            wv.y = cvtpk(O[4 * g4 + 2] * rstd * gn.z * silu_f(bflo(gr[g4].y)), O[4 * g4 + 3] * rstd * gn.w * silu_f(bfhi(gr[g4].y)));
            *(u32x2*)(MIX + tl * 1024 + 512 + h * 128 + dv) = wv; }
        asm volatile("s_waitcnt vmcnt(0)" ::: "memory"); __syncthreads();
#pragma unroll
        for (int d = 0; d < 2; ++d)
#pragma unroll
            for (int k = 0; k < 4; ++k) sa[d][k] = san[d][k];
#pragma unroll
        for (int g4 = 0; g4 < 4; ++g4) gr[g4] = grn[g4];
    }
#undef G3_STAGE
#undef G3_LOADS
}
#undef GL_MFMA
}

template <bool DRY> __device__ __forceinline__ void ph_router(const Ctx& c, LAS unsigned char* lds) {
    typedef short bf16x8 __attribute__((ext_vector_type(8)));
    const int tid = threadIdx.x, lane = tid & 63, wave = tid >> 6, tk = lane & 15, kg = lane >> 4;
    const float* MOD = (const float*)(c.ws + WS_MOD); const bf16* X1 = (const bf16*)(c.ws + WS_X1); bf16* H2 = (bf16*)(c.ws + WS_H2);
    const bf16* WRT = (const bf16*)(c.ws + WS_WRT);
    int* ROUTE = (int*)(c.ws + WS_ROUTE); int* LIST = (int*)(c.ws + WS_LIST); unsigned* ctl = (unsigned*)(c.ws + WS_CTL);
    constexpr int WROW = 1040, WHALF = 36 * WROW;
    LAS unsigned char* whi = lds; LAS unsigned char* wlo = lds + WHALF;
    LAS int* bcnt = (LAS int*)(lds + 2 * WHALF);
    LAS int* rt = bcnt + 64;
    for (int base = blockIdx.x * 128; base < NTOK; base += gridDim.x * 128) {
        if (tid < 32) bcnt[tid] = 0;
        const int lt = wave * 16 + tk, tok = base + lt, bb = tok / SEQ;
        const bf16* xr = X1 + (size_t)tok * DM + 8 * kg; const float* gp = c.g_ffn + 8 * kg; const float* scp = MOD + bb * 6144 + 4096 + 8 * kg; const float* shp = MOD + bb * 6144 + 3072 + 8 * kg;
        f32x4 acc[3];
#pragma unroll
        for (int ct = 0; ct < 3; ++ct) acc[ct] = (f32x4){0.f, 0.f, 0.f, 0.f};
        const int arow0 = tk, arow1 = 16 + tk, arow2 = (32 + tk) < 36 ? 32 + tk : 35;
        float rstd; { const float* sp = (const float*)(c.ws + WS_SSP) + (size_t)tok * 16; const f32x4 p0 = *(const f32x4*)sp, p1 = *(const f32x4*)(sp + 4), p2 = *(const f32x4*)(sp + 8), p3 = *(const f32x4*)(sp + 12);
            const float ss = (((p0.x + p0.y) + (p0.z + p0.w)) + ((p1.x + p1.y) + (p1.z + p1.w))) + (((p2.x + p2.y) + (p2.z + p2.w)) + ((p3.x + p3.y) + (p3.z + p3.w)));
            rstd = rsqrtf(ss * (1.0f / DM) + NORM_EPS); }
        for (int kh = 0; kh < 2; ++kh) {
            __syncthreads();
            for (int q = tid; q < 2 * 36 * 64; q += 512) { const int which = q / 2304, r = (q % 2304) >> 6, ch = q & 63;
                *(LAS u32x4*)((which ? wlo : whi) + r * WROW + ch * 16) = *(const u32x4*)(WRT + (size_t)which * 36 * 1024 + r * 1024 + kh * 512 + ch * 8); }
            __syncthreads();
#pragma unroll 2
            for (int s = 0; s < 16; ++s) { const int ko = kh * 512 + 32 * s;
                const u32x4 xw = *(const u32x4*)(xr + ko); const f32x4 x0 = {bflo(xw.x), bfhi(xw.x), bflo(xw.y), bfhi(xw.y)}, x1 = {bflo(xw.z), bfhi(xw.z), bflo(xw.w), bfhi(xw.w)};
                const f32x4 g0 = *(const f32x4*)(gp + ko), g1 = *(const f32x4*)(gp + ko + 4), s0 = *(const f32x4*)(scp + ko), s1 = *(const f32x4*)(scp + ko + 4);
                const f32x4 h0 = *(const f32x4*)(shp + ko), h1 = *(const f32x4*)(shp + ko + 4);
                const f32x4 u0 = (x0 * rstd * g0) * (s0 + 1.0f) + h0, u1 = (x1 * rstd * g1) * (s1 + 1.0f) + h1;
                u32x4 hw; hw.x = pk2(u0.x, u0.y); hw.y = pk2(u0.z, u0.w); hw.z = pk2(u1.x, u1.y); hw.w = pk2(u1.z, u1.w);
                *(u32x4*)(H2 + (size_t)tok * DM + 8 * kg + ko) = hw;
                u32x4 lw; lw.x = pk2(u0.x - bflo(hw.x), u0.y - bfhi(hw.x)); lw.y = pk2(u0.z - bflo(hw.y), u0.w - bfhi(hw.y)); lw.z = pk2(u1.x - bflo(hw.z), u1.y - bfhi(hw.z)); lw.w = pk2(u1.z - bflo(hw.w), u1.w - bfhi(hw.w));
                const bf16x8 uh = __builtin_bit_cast(bf16x8, hw), ul = __builtin_bit_cast(bf16x8, lw);
                const int co = (32 * s + 8 * kg) * 2;
#pragma unroll
                for (int ct = 0; ct < 3; ++ct) { const int ar = ct == 0 ? arow0 : (ct == 1 ? arow1 : arow2);
                    const bf16x8 ah = *(const LAS bf16x8*)(whi + ar * WROW + co), al = *(const LAS bf16x8*)(wlo + ar * WROW + co);
                    acc[ct] = __builtin_amdgcn_mfma_f32_16x16x32_bf16(ah, uh, acc[ct], 0, 0, 0);
                    acc[ct] = __builtin_amdgcn_mfma_f32_16x16x32_bf16(al, uh, acc[ct], 0, 0, 0);
                    acc[ct] = __builtin_amdgcn_mfma_f32_16x16x32_bf16(ah, ul, acc[ct], 0, 0, 0); }
            }
        }
        float gl[4];
#pragma unroll
        for (int j = 0; j < 4; ++j) gl[j] = __shfl(acc[2][j] + c.b_rg[j], tk);
        int gs = 0; float gm = gl[0];
#pragma unroll
        for (int n = 1; n < 4; ++n) if (gl[n] > gm) { gm = gl[n]; gs = n; }
        float gden = 0.f;
#pragma unroll
        for (int n = 0; n < 4; ++n) gden += expf(gl[n] - gm);
        const float gw_ = 1.0f / gden;
        float cand[4];
#pragma unroll
        for (int j = 0; j < 4; ++j) { const int n = 16 * (gs >> 1) + 4 * kg + j; cand[j] = ((gs >> 1) ? acc[1][j] : acc[0][j]) + c.b_re[n]; }
        float el[8]; const int srcl = tk + 32 * (gs & 1);
#pragma unroll
        for (int j = 0; j < 4; ++j) { el[j] = __shfl(cand[j], srcl); el[4 + j] = __shfl(cand[j], srcl + 16); }
        int i0 = 0; float v0 = el[0];
#pragma unroll
        for (int n = 1; n < 8; ++n) if (el[n] > v0) { v0 = el[n]; i0 = n; }
        int i1 = i0 == 0 ? 1 : 0; float v1 = i0 == 0 ? el[1] : el[0];
#pragma unroll
        for (int n = 1; n < 8; ++n) if (n != i0 && el[n] > v1) { v1 = el[n]; i1 = n; }
        const float e1 = expf(v1 - v0), den = 1.0f + e1; const float w0 = gw_ / den, w1 = gw_ * e1 / den;
        if (DRY) { asm volatile("" :: "v"(w0), "v"(w1), "v"(i0), "v"(i1)); }
        if (kg == 0 && !DRY) { const int e0g = gs * 8 + i0, e1g = gs * 8 + i1; const int r0 = atomicAdd((int*)&bcnt[e0g], 1), r1 = atomicAdd((int*)&bcnt[e1g], 1);
            LAS int* r = rt + lt * 6; r[0] = e0g; r[1] = e1g; r[2] = r0; r[3] = r1; r[4] = __builtin_bit_cast(int, w0); r[5] = __builtin_bit_cast(int, w1); }
        __syncthreads();
        if (DRY) continue;
        if (tid < 32) bcnt[32 + tid] = (int)__hip_atomic_fetch_add(ctl + CW_CNT + 64 * tid, (unsigned)bcnt[tid], __ATOMIC_RELAXED, __HIP_MEMORY_SCOPE_AGENT);
        __syncthreads();
        if (tid < 128) { const LAS int* r = rt + tid * 6; const int tk2 = base + tid; const int e0g = r[0], e1g = r[1], p0 = bcnt[32 + e0g] + r[2], p1 = bcnt[32 + e1g] + r[3];
            int* ro = ROUTE + (size_t)tk2 * 8; ro[0] = e0g; ro[1] = e1g; ro[2] = p0; ro[3] = p1; ro[4] = r[4]; ro[5] = r[5];
            LIST[e0g * NTOK + p0] = tk2; LIST[e1g * NTOK + p1] = tk2; }
        __syncthreads();
    }
}

__device__ __forceinline__ void ph_final(const Ctx& c, LAS unsigned char* lds) {
    const int tid = threadIdx.x, lane = tid & 63, wave = tid >> 6, nw = blockDim.x >> 6;
    const float* MOD = (const float*)(c.ws + WS_MOD); const bf16* X1 = (const bf16*)(c.ws + WS_X1); const bf16* YB = (const bf16*)(c.ws + WS_YB);
    const int* ROUTE = (const int*)(c.ws + WS_ROUTE);
    LAS int* mm = (LAS int*)lds; moe_build(mm, (const unsigned*)(c.ws + WS_CTL));
    f32x4 g[4];
#pragma unroll
    for (int q = 0; q < 4; ++q) g[q] = *(const f32x4*)(c.g_final + 4 * lane + 256 * q);
    for (int tok = blockIdx.x * nw + wave; tok < NTOK; tok += gridDim.x * nw) {
        const int bb = tok / SEQ; const float* gt = MOD + bb * 6144 + 5120; const int* ro = ROUTE + (size_t)tok * 8;
        const int e0 = ro[0], e1 = ro[1]; const size_t r0 = ((size_t)mm[32 + e0] << 8) + ro[2], r1 = ((size_t)mm[32 + e1] << 8) + ro[3];
        const float w0 = __builtin_bit_cast(float, ro[4]), w1 = __builtin_bit_cast(float, ro[5]);
        f32x4 v[4]; float ss = 0.f;
#pragma unroll
        for (int q = 0; q < 4; ++q) { const int col = 4 * lane + 256 * q; const u32x2 xw = *(const u32x2*)(X1 + (size_t)tok * DM + col); const f32x4 xv = {bflo(xw.x), bfhi(xw.x), bflo(xw.y), bfhi(xw.y)}, gv = *(const f32x4*)(gt + col);
            const u32x2 ya = *(const u32x2*)(YB + r0 * DM + col), yb = *(const u32x2*)(YB + r1 * DM + col);
            f32x4 y; y.x = w0 * bflo(ya.x) + w1 * bflo(yb.x); y.y = w0 * bfhi(ya.x) + w1 * bfhi(yb.x); y.z = w0 * bflo(ya.y) + w1 * bflo(yb.y); y.w = w0 * bfhi(ya.y) + w1 * bfhi(yb.y);
            v[q] = xv + gv * y; ss += (v[q].x * v[q].x + v[q].y * v[q].y) + (v[q].z * v[q].z + v[q].w * v[q].w); }
        const float rstd = rsqrtf(wave_sum(ss) * (1.0f / DM) + NORM_EPS);
#pragma unroll
        for (int q = 0; q < 4; ++q) *(f32x4*)(c.out + (size_t)tok * DM + 4 * lane + 256 * q) = v[q] * rstd * g[q];
    }
}

#define XB_TMO      128
#define XB_XCNT(j)  (256  + 64 * (j))
#define XB_XSUB(j)  (1280 + 64 * (j))
#define XB_XGEN(j)  (2304 + 64 * (j))
#define XB_TOP      3328
#define XB_TOPGEN   3392
#define XCD_BAR_WORDS 3456
#define XB_SPIN_CAP (1u << 18)

__device__ __forceinline__ unsigned xb_ld(unsigned* p)              { return __hip_atomic_load(p, __ATOMIC_RELAXED, __HIP_MEMORY_SCOPE_AGENT); }
__device__ __forceinline__ unsigned xb_add(unsigned* p, unsigned v) { return __hip_atomic_fetch_add(p, v, __ATOMIC_RELAXED, __HIP_MEMORY_SCOPE_AGENT); }
__device__ __forceinline__ unsigned xb_xcc_id() { return (unsigned)__builtin_amdgcn_s_getreg((3 << 11) | 20) & 0xFu; }
#define XB_SPIN(cond, bar) do { unsigned _sp = 0; while (cond) { __builtin_amdgcn_s_sleep(1); \
    if ((++_sp & 255u) == 0u) { if (xb_ld(&(bar)[XB_TMO])) break; if (_sp > XB_SPIN_CAP) { atomicAdd(&(bar)[XB_TMO], 1u); break; } } } } while (0)

struct XcdBarrier {
    unsigned* bar; unsigned x;
    volatile LAS unsigned* st;
};
__device__ __forceinline__ XcdBarrier xcd_barrier_post(unsigned* bar, volatile LAS unsigned* st) {
    XcdBarrier b; b.bar = bar; b.x = xb_xcc_id(); b.st = st;
    if (threadIdx.x == 0) (void)xb_add(&bar[XB_XCNT(b.x)], 1u);
    return b;
}
__device__ __forceinline__ void xcd_barrier_complete(unsigned* bar, unsigned x, unsigned& nloc, unsigned& nx) {
    const unsigned G = gridDim.x * gridDim.y * gridDim.z;
    unsigned sum, cnt, mine, sp = 0u;
    for (;;) {
        sum = 0u; cnt = 0u; mine = 0u;
#pragma unroll
        for (unsigned j = 0; j < 16; ++j) { const unsigned c = xb_ld(&bar[XB_XCNT(j)]); sum += c; cnt += (c > 0u) ? 1u : 0u; mine = (j == x) ? c : mine; }
        if (sum == G) break;
        __builtin_amdgcn_s_sleep(1);
        if ((++sp & 255u) == 0u) { if (xb_ld(&bar[XB_TMO])) break; if (sp > XB_SPIN_CAP) { atomicAdd(&bar[XB_TMO], 1u); break; } }
    }
    nloc = mine > 0u ? mine : 1u; nx = cnt > 0u ? cnt : 1u;
}
__device__ __forceinline__ void xcd_barrier(const XcdBarrier& b) {
    asm volatile("s_waitcnt vmcnt(0)" ::: "memory");
    __syncthreads();
    if (threadIdx.x == 0) {
        unsigned* bar = b.bar;
        __builtin_amdgcn_s_waitcnt(0);
        unsigned nloc = b.st[0], nx = b.st[1];
        if (nloc == 0u) { xcd_barrier_complete(bar, b.x, nloc, nx); b.st[0] = nloc; b.st[1] = nx; }
        const unsigned old = xb_add(&bar[XB_XSUB(b.x)], 1u);
        const unsigned gen = old / nloc;
        if (old + 1u == (gen + 1u) * nloc) {
            __builtin_amdgcn_fence(__ATOMIC_RELEASE, "agent");
            asm volatile("s_waitcnt vmcnt(0)" ::: "memory");
            const unsigned og = xb_add(&bar[XB_TOP], 1u);
            const unsigned tg = og / nx;
            if (og + 1u == (tg + 1u) * nx) xb_add(&bar[XB_TOPGEN], 1u);
            else XB_SPIN(xb_ld(&bar[XB_TOPGEN]) == tg, bar);
            __builtin_amdgcn_fence(__ATOMIC_ACQUIRE, "agent");
            xb_add(&bar[XB_XGEN(b.x)], 1u);
            asm volatile("s_waitcnt vmcnt(0)" ::: "memory");
        } else {
            XB_SPIN(xb_ld(&bar[XB_XGEN(b.x)]) == gen, bar);
            __builtin_amdgcn_fence(__ATOMIC_ACQUIRE, "agent");
            asm volatile("s_waitcnt vmcnt(0)" ::: "memory");
        }
    }
    __syncthreads();
}

#ifndef PROBE_MASK
#define PROBE_MASK 0
#endif
constexpr int LDS_BYTES = 147456;
constexpr int LDS_BARW_OFF = LDS_BYTES - 16;
__global__ void __launch_bounds__(512, 2) mega_fwd(Ctx c) {
    extern __shared__ __attribute__((aligned(16))) unsigned char lds_raw[];
    LAS unsigned char* lds = (LAS unsigned char*)lds_raw;
    if (threadIdx.x == 0) *(LAS u32x4*)(lds + LDS_BARW_OFF) = (u32x4){0u, 0u, 0u, 0u};
    __syncthreads();
    const XcdBarrier bar = xcd_barrier_post((unsigned*)(c.ws + WS_CTL) + CW_BAR, (volatile LAS unsigned*)(lds + LDS_BARW_OFF));
#define RUN(k, call) do { call; xcd_barrier(bar); if (PROBE_MASK & (1 << (k))) { call; xcd_barrier(bar); } } while (0)
    if (PROBE_MASK & (1 << 14)) { for (int i = 0; i < 8; ++i) xcd_barrier(bar); }
    RUN(0, ph_prologue(c, lds));
    RUN(1, ph_norm1(c));
    RUN(2, ph_inproj(c, lds));
    if (PROBE_MASK & (1 << 12)) gla::g0_phase(c, lds);
    if (PROBE_MASK & (1 << 13)) { da::attn_phase(c, lds); }
    RUN(3, (gla::g0_phase(c, lds), da::attn_phase(c, lds)));
    RUN(4, gla::g1_phase(c, lds));
    RUN(5, gla::g2_phase(c));
    RUN(6, gla::g3_phase(c, lds));
    RUN(7, ph_outproj(c, lds));
    if (PROBE_MASK & (1 << 8)) { ph_router<true>(c, lds); xcd_barrier(bar); }
    ph_router<false>(c, lds); xcd_barrier(bar);
    RUN(9, ph_gateup(c, lds));
    RUN(10, ph_down(c, lds));
    if (PROBE_MASK & (1 << 11)) { ph_final(c, lds); xcd_barrier(bar); }
    ph_final(c, lds);
}

extern "C" void kernel_launch(void* const* d_in, const int* in_sizes, int n_in, void* d_out, int out_size, void* d_ws, size_t ws_size, hipStream_t stream) {
    static int grid = 0;
    if (grid == 0) {
        if (n_in != 23 || in_sizes[0] != NTOK * DM || out_size != NTOK * DM || ws_size < WS_END) { fprintf(stderr, "kernel_launch: unexpected problem shape (n_in %d, in0 %d, out %d, ws %zu)\n", n_in, n_in > 0 ? in_sizes[0] : -1, out_size, ws_size); grid = -1; return; }
        int dev = 0, cus = 0, per_cu = 0;
        if (hipGetDevice(&dev) != hipSuccess || hipDeviceGetAttribute(&cus, hipDeviceAttributeMultiprocessorCount, dev) != hipSuccess) { grid = -1; return; }
        if (hipFuncSetAttribute((const void*)mega_fwd, hipFuncAttributeMaxDynamicSharedMemorySize, LDS_BYTES) != hipSuccess) { fprintf(stderr, "kernel_launch: hipFuncSetAttribute failed\n"); grid = -1; return; }
        if (hipOccupancyMaxActiveBlocksPerMultiprocessor(&per_cu, (const void*)mega_fwd, 512, LDS_BYTES) != hipSuccess || per_cu < 1) fprintf(stderr, "kernel_launch: occupancy query reports %d workgroups per CU\n", per_cu);
        (void)hipGetLastError();
        grid = cus;
    }
    if (grid < 0) return;
    Ctx c{};
    const float** f = (const float**)&c;
    for (int i = 0; i < 23; ++i) f[i] = (const float*)d_in[i];
    c.out = (float*)d_out; c.ws = (unsigned char*)d_ws;
    if (hipMemsetAsync((unsigned char*)d_ws + WS_CTL, 0, CTL_ZERO_BYTES, stream) != hipSuccess) return;
    hipLaunchKernelGGL(mega_fwd, dim3(grid), dim3(512), LDS_BYTES, stream, c);
}
```

```cpp
#include <hip/hip_runtime.h>
#include <cstdint>
#include <cstdio>

#define GAS __attribute__((address_space(1)))
#define LAS __attribute__((address_space(3)))
typedef unsigned short bf16;
typedef float f32x4 __attribute__((ext_vector_type(4)));
typedef float f32x2 __attribute__((ext_vector_type(2)));
typedef unsigned u32x4 __attribute__((ext_vector_type(4)));
typedef unsigned u32x2 __attribute__((ext_vector_type(2)));

constexpr int NB = 16, SEQ = 2048, DM = 1024, CTXL = 256, KVL = CTXL + SEQ;
constexpr int NTOK = NB * SEQ;
constexpr int NROW = NB * KVL;
constexpr int NPROJ = 3104, NPROJ_PAD = 3328;
constexpr int NEXP = 32, EHID = 512;
constexpr int MOE_ROWS_MAX = 73728;
constexpr float NORM_EPS = 1e-6f;
constexpr float LAMBDA_INIT = 0.2f;
constexpr float QSCALE = 0.125f * 1.4426950408889634f;

constexpr int C_DAQ = 0, C_DAK = 512, C_DAV = 1024, C_GQ = 1536, C_GK = 1792, C_GV = 2048, C_GR = 2560, C_LR = 3072;

constexpr size_t MiB = 1u << 20;
constexpr size_t WS_CTL = 0, CTL_ZERO_BYTES = 1 * MiB;
constexpr size_t WS_MOD = 1 * MiB;
constexpr size_t WS_ROPE = 1 * MiB + 512 * 1024;
constexpr size_t WS_WRT = 462 * MiB;
constexpr size_t WS_ROUTE = 2 * MiB;
constexpr size_t WS_LIST = 3 * MiB;
constexpr size_t WS_WIN_T = 7 * MiB;
constexpr size_t WS_WOUT_T = 14 * MiB;
constexpr size_t WS_WGU_T = 16 * MiB;
constexpr size_t WS_WD_T = 80 * MiB;
constexpr size_t WS_H = 112 * MiB;
constexpr size_t WS_HMID = 112 * MiB;
constexpr size_t WS_QDA = 184 * MiB;
constexpr size_t WS_KDA = 216 * MiB;
constexpr size_t WS_VDA = 252 * MiB;
constexpr size_t WS_GQ = 288 * MiB;
constexpr size_t WS_GK = 304 * MiB;
constexpr size_t WS_GV = 322 * MiB;
constexpr size_t WS_GR = 358 * MiB;
constexpr size_t WS_LR = 390 * MiB;
constexpr size_t WS_X1 = 184 * MiB;
constexpr size_t WS_H2 = 312 * MiB;
constexpr size_t WS_YB = 312 * MiB;
constexpr size_t WS_MIX = 112 * MiB;
constexpr size_t WS_UT = 184 * MiB;
constexpr size_t WS_ST = 256 * MiB;
constexpr size_t WS_QD = 395 * MiB;
constexpr size_t WS_KI = 427 * MiB;
constexpr size_t WS_KEND = 464 * MiB;
constexpr size_t WS_DB = 460 * MiB;
constexpr size_t WS_SSP = 500 * MiB;
constexpr size_t WS_END = 502 * MiB;

constexpr int CW_BAR = 4096;
constexpr int CW_CNT = 16384;

struct Ctx {
    const float *x, *c, *ctx, *c_ctx, *w_ada, *b_ada, *g_mix, *g_ffn, *w_in, *da_lambda, *da_subln_g, *gate_w2, *gate_b, *gla_norm_g, *w_out,
        *w_rg, *b_rg, *w_re, *b_re, *w_gate, *w_up, *w_down, *g_final;
    float* out; unsigned char* ws;
};

__device__ __forceinline__ unsigned f2bf(float f) { unsigned u = __builtin_bit_cast(unsigned, f); return (u + 0x7fffu + ((u >> 16) & 1u)) >> 16; }
typedef float f32x2_c __attribute__((ext_vector_type(2))); typedef __bf16 bf16x2_c __attribute__((ext_vector_type(2)));
__device__ __forceinline__ unsigned pk2(float lo, float hi) { f32x2_c v = {lo, hi}; bf16x2_c b = __builtin_convertvector(v, bf16x2_c); return __builtin_bit_cast(unsigned, b); }
__device__ __forceinline__ float bf2f(unsigned b) { return __builtin_bit_cast(float, b << 16); }
__device__ __forceinline__ float bflo(unsigned w) { return __builtin_bit_cast(float, w << 16); }
__device__ __forceinline__ float bfhi(unsigned w) { return __builtin_bit_cast(float, w & 0xffff0000u); }
__device__ __forceinline__ float wave_sum(float v) {
#pragma unroll
    for (int o = 1; o < 64; o <<= 1) v += __shfl_xor(v, o);
    return v;
}
__device__ __forceinline__ float silu_f(float v) { return v / (1.0f + __expf(-v)); }
#define LDS_WAIT() asm volatile("s_waitcnt lgkmcnt(0)" ::: "memory")

template <class RowMap>
__device__ __forceinline__ void transpose_item(const float* W, int ldw, int k0, int n0, bf16* WT, int KT, const RowMap& rm, LAS float* scr, int lane) {
    float v[32];
#pragma unroll
    for (int i = 0; i < 32; ++i) v[i] = W[(size_t)(k0 + 2 * i + (lane >> 5)) * ldw + n0 + (lane & 31)];
#pragma unroll
    for (int i = 0; i < 32; ++i) scr[(2 * i + (lane >> 5)) * 33 + (lane & 31)] = v[i];
    LDS_WAIT(); asm volatile("" ::: "memory");
    const int c = lane & 7;
#pragma unroll
    for (int j = 0; j < 4; ++j) { const int n = (lane >> 3) + 8 * j; const LAS float* s = scr + (8 * c) * 33 + n;
        u32x4 o; o.x = pk2(s[0 * 33], s[1 * 33]); o.y = pk2(s[2 * 33], s[3 * 33]); o.z = pk2(s[4 * 33], s[5 * 33]); o.w = pk2(s[6 * 33], s[7 * 33]);
        *(u32x4*)(WT + (size_t)rm(n0 + n) * KT + k0 + 8 * c) = o; }
    LDS_WAIT(); asm volatile("" ::: "memory");
}
struct TItem { const float* src; bf16* dst; int ldw, KT, n0, mode; };
__device__ __forceinline__ int titem_row(const TItem& t, int n) { const int a = t.n0 + n;
    return t.mode == 0 ? a : (t.mode == 1 ? (a & ~31) + (((a & 31) & 15) << 1) + ((a & 31) >> 4) : 8 * (a >> 2) + (a & 3) + 4 * (t.mode - 2)); }
__device__ __forceinline__ void titem_load(const TItem& t, float (&v)[32], int lane) {
#pragma unroll
    for (int i = 0; i < 32; ++i) v[i] = t.src[(size_t)(2 * i + (lane >> 5)) * t.ldw + (lane & 31)];
}
__device__ __forceinline__ void titem_store(const TItem& t, const float (&v)[32], LAS float* scr, int lane) {
#pragma unroll
    for (int i = 0; i < 32; ++i) scr[(2 * i + (lane >> 5)) * 33 + (lane & 31)] = v[i];
    LDS_WAIT(); asm volatile("" ::: "memory");
    const int c = lane & 7;
#pragma unroll
    for (int j = 0; j < 4; ++j) { const int n = (lane >> 3) + 8 * j; const LAS float* s = scr + (8 * c) * 33 + n;
        u32x4 o; o.x = pk2(s[0 * 33], s[1 * 33]); o.y = pk2(s[2 * 33], s[3 * 33]); o.z = pk2(s[4 * 33], s[5 * 33]); o.w = pk2(s[6 * 33], s[7 * 33]);
        *(u32x4*)(t.dst + (size_t)titem_row(t, n) * t.KT + 8 * c) = o; }
    LDS_WAIT(); asm volatile("" ::: "memory");
}
struct RowId { int off; __device__ __forceinline__ int operator()(int n) const { return off + n; } };
struct RowRope { __device__ __forceinline__ int operator()(int n) const { const int l = n & 31; return (n & ~31) + ((l & 15) << 1) + (l >> 4); } };
struct RowGU { int up; __device__ __forceinline__ int operator()(int n) const { return 8 * (n >> 2) + (n & 3) + 4 * up; } };

__device__ __forceinline__ void ph_prologue(const Ctx& c, LAS unsigned char* lds) {
    const int tid = threadIdx.x, lane = tid & 63, wave = tid >> 6, nw = blockDim.x >> 6;
    unsigned char* ws = c.ws;
    if (blockIdx.x < 96 && nw == 8) {
        LAS float* sv = (LAS float*)lds;
        LAS float* red = sv + 17 * 1024;
        const int col = blockIdx.x * 64 + lane;
        float cv[34];
#pragma unroll
        for (int j = 0; j < 34; ++j) cv[j] = j < 32 ? c.c[tid + 512 * j] : c.c_ctx[tid + 512 * (j - 32)];
        float w[128];
#pragma unroll
        for (int i = 0; i < 128; ++i) w[i] = c.w_ada[(size_t)(wave * 128 + i) * 6144 + col];
#pragma unroll
        for (int j = 0; j < 34; ++j) { const float v = cv[j]; sv[tid + 512 * j] = v / (1.0f + __expf(-v)); }
        __syncthreads();
        float acc[17];
#pragma unroll
        for (int r = 0; r < 17; ++r) acc[r] = 0.f;
#pragma unroll
        for (int k4 = 0; k4 < 32; ++k4) {
#pragma unroll
            for (int r = 0; r < 17; ++r) { const f32x4 s = *(const LAS f32x4*)(sv + r * 1024 + wave * 128 + 4 * k4);
                acc[r] += (s.x * w[4 * k4] + s.y * w[4 * k4 + 1]) + (s.z * w[4 * k4 + 2] + s.w * w[4 * k4 + 3]); } }
#pragma unroll
        for (int r = 0; r < 17; ++r) red[(wave * 17 + r) * 64 + lane] = acc[r];
        __syncthreads();
        float* MOD = (float*)(ws + WS_MOD);
        for (int i = tid; i < 17 * 64; i += 512) { const int r = i >> 6, l = i & 63; float s = 0.f;
            for (int w = 0; w < 8; ++w) s += red[(w * 17 + r) * 64 + l];
            MOD[r * 6144 + blockIdx.x * 64 + l] = s + c.b_ada[blockIdx.x * 64 + l]; }
        __syncthreads();
    }
    { f32x2* ROPE = (f32x2*)(ws + WS_ROPE);
      for (int i = blockIdx.x * blockDim.x + tid; i < 2048 * 32; i += gridDim.x * blockDim.x) {
          const int t = i >> 5, a = (i >> 4) & 1, f = i & 15; const float pos = (float)(a == 0 ? (t >> 6) : (t & 63));
          const float inv = exp2f(-(float)f * (13.287712379549449f / 16.0f));
          const float ang = pos * inv; f32x2 cs; cs.x = __cosf(ang); cs.y = __sinf(ang); ROPE[i] = cs; } }
    { bf16* WRT = (bf16*)(ws + WS_WRT);
      for (int i = blockIdx.x * blockDim.x + tid; i < 36 * 1024; i += gridDim.x * blockDim.x) { const int n = i >> 10, k = i & 1023;
          const float wv = n < 32 ? c.w_re[k * 32 + n] : c.w_rg[k * 4 + (n - 32)]; const unsigned h = f2bf(wv); WRT[i] = (bf16)h; WRT[36 * 1024 + i] = (bf16)f2bf(wv - bf2f(h)); } }
    { u32x4* z = (u32x4*)(ws + WS_WIN_T + (size_t)NPROJ * 1024 * 2); const int n16 = (NPROJ_PAD - NPROJ) * 1024 * 2 / 16;
      for (int i = blockIdx.x * blockDim.x + tid; i < n16; i += gridDim.x * blockDim.x) z[i] = (u32x4){0u, 0u, 0u, 0u}; }
    LAS float* scr = (LAS float*)(lds + wave * 8704);
    const int gw = blockIdx.x * nw + wave, NGW = gridDim.x * nw;
    constexpr int I_IN = 16 * 97, I_OUT = 16 * 32, I_G = 32 * 16 * 16, I_U = I_G, I_D = 32 * 8 * 32;
    constexpr int NITEMS = I_IN + I_OUT + I_G + I_U + I_D;
    bf16* WIN_T = (bf16*)(ws + WS_WIN_T); bf16* WOUT_T = (bf16*)(ws + WS_WOUT_T); bf16* WGU_T = (bf16*)(ws + WS_WGU_T); bf16* WD_T = (bf16*)(ws + WS_WD_T);
    constexpr int NA_PER = 5; const int nfree = ((int)gridDim.x - 96) * nw, NA = gridDim.x > 96 ? nfree * NA_PER : 0;
    const int gfree = ((int)blockIdx.x - 96) * nw + wave;
    auto decode = [&](int it) -> TItem { TItem t; int r = it;
        if (r < I_IN) { const int kb = r / 97, nb = r % 97, n0 = nb * 32; t.src = c.w_in + (size_t)(kb * 64) * NPROJ + n0; t.dst = WIN_T + kb * 64; t.ldw = NPROJ; t.KT = 1024; t.n0 = n0; t.mode = n0 < 1024 ? 1 : 0; return t; }
        r -= I_IN;
        if (r < I_OUT) { const int kb = r / 32, nb = r % 32; t.src = c.w_out + (size_t)(kb * 64) * 1024 + nb * 32; t.dst = WOUT_T + kb * 64; t.ldw = 1024; t.KT = 1024; t.n0 = nb * 32; t.mode = 0; return t; }
        r -= I_OUT;
        if (r < I_G + I_U) { const int up = r >= I_G; if (up) r -= I_G; const int e = r / 256, q = r % 256, kb = q / 16, nb = q % 16;
            t.src = (up ? c.w_up : c.w_gate) + (size_t)e * 1024 * 512 + (size_t)(kb * 64) * 512 + nb * 32; t.dst = WGU_T + (size_t)e * 1024 * 1024 + kb * 64; t.ldw = 512; t.KT = 1024; t.n0 = nb * 32; t.mode = 2 + up; return t; }
        r -= I_G + I_U;
        { const int e = r / 256, q = r % 256, kb = q / 32, nb = q % 32; t.src = c.w_down + (size_t)e * 512 * 1024 + (size_t)(kb * 64) * 1024 + nb * 32; t.dst = WD_T + (size_t)e * 1024 * 512 + kb * 64; t.ldw = 1024; t.KT = 512; t.n0 = nb * 32; t.mode = 0; return t; } };
    for (int pass = 0; pass < 2; ++pass) {
        const int first = pass == 0 ? (blockIdx.x >= 96 ? gfree : NITEMS) : NA + gw, end = pass == 0 ? NA : NITEMS, stride = pass == 0 ? nfree : NGW;
        for (int it = first; it < end; it += 2 * stride) {
            const bool two = it + stride < end;
            const TItem ta = decode(it), tb = decode(two ? it + stride : it);
            float va[32], vb[32];
            titem_load(ta, va, lane); if (two) titem_load(tb, vb, lane);
            titem_store(ta, va, scr, lane); if (two) titem_store(tb, vb, scr, lane);
        }
    }
}

__device__ __forceinline__ void ph_norm1(const Ctx& c) {
    const int tid = threadIdx.x, lane = tid & 63, wave = tid >> 6, nw = blockDim.x >> 6;
    const int gw = blockIdx.x * nw + wave, NGW = gridDim.x * nw;
    const float* MOD = (const float*)(c.ws + WS_MOD); bf16* H = (bf16*)(c.ws + WS_H);
    f32x4 g[4];
#pragma unroll
    for (int j = 0; j < 4; ++j) g[j] = *(const f32x4*)(c.g_mix + 4 * lane + 256 * j);
    for (int r0 = gw * 2; r0 < NROW; r0 += NGW * 2) {
        f32x4 v[2][4];
#pragma unroll
        for (int t = 0; t < 2; ++t) { const int r = r0 + t, b = r / KVL, j = r % KVL; const bool isctx = j < CTXL;
            const float* src = isctx ? c.ctx + ((size_t)b * CTXL + j) * DM : c.x + ((size_t)b * SEQ + (j - CTXL)) * DM;
#pragma unroll
            for (int q = 0; q < 4; ++q) v[t][q] = *(const f32x4*)(src + 4 * lane + 256 * q); }
#pragma unroll
        for (int t = 0; t < 2; ++t) { const int r = r0 + t, b = r / KVL, j = r % KVL; const bool isctx = j < CTXL;
            const float* mod = MOD + (isctx ? 16 : b) * 6144; float ss = 0.f;
#pragma unroll
            for (int q = 0; q < 4; ++q) ss += (v[t][q].x * v[t][q].x + v[t][q].y * v[t][q].y) + (v[t][q].z * v[t][q].z + v[t][q].w * v[t][q].w);
            const float rstd = rsqrtf(wave_sum(ss) * (1.0f / DM) + NORM_EPS);
#pragma unroll
            for (int q = 0; q < 4; ++q) { const f32x4 sh = *(const f32x4*)(mod + 4 * lane + 256 * q), sc = *(const f32x4*)(mod + 1024 + 4 * lane + 256 * q);
                const f32x4 o = (v[t][q] * rstd * g[q]) * (sc + 1.0f) + sh;
                u32x2 w; w.x = pk2(o.x, o.y); w.y = pk2(o.z, o.w); *(u32x2*)(H + (size_t)r * DM + 4 * lane + 256 * q) = w; } }
    }
}

__device__ __forceinline__ u32x4 pack8(const f32x4& a, const f32x4& b) { u32x4 w; w.x = pk2(a.x, a.y); w.y = pk2(a.z, a.w); w.z = pk2(b.x, b.y); w.w = pk2(b.z, b.w); return w; }
struct EpiInProj {
    unsigned char* ws;
    __device__ __forceinline__ void rope8(int t, int i8, f32x4& a, f32x4& b, float scale) const {
        const f32x2* R = (const f32x2*)(ws + WS_ROPE) + (size_t)t * 32 + (i8 >> 5) * 16 + ((i8 & 31) >> 1);
        const f32x4 c0 = *(const f32x4*)R, c1 = *(const f32x4*)(R + 2);
        f32x4 oa, ob;
        oa.x = (a.x * c0.x - a.y * c0.y) * scale; oa.y = (a.y * c0.x + a.x * c0.y) * scale;
        oa.z = (a.z * c0.z - a.w * c0.w) * scale; oa.w = (a.w * c0.z + a.z * c0.w) * scale;
        ob.x = (b.x * c1.x - b.y * c1.y) * scale; ob.y = (b.y * c1.x + b.x * c1.y) * scale;
        ob.z = (b.z * c1.z - b.w * c1.w) * scale; ob.w = (b.w * c1.z + b.z * c1.w) * scale;
        a = oa; b = ob;
    }
    __device__ __forceinline__ void emit8(int row, int col, f32x4 a, f32x4 b) const {
        const int bb = row / KVL, j = row % KVL; const bool lat = j >= CTXL; const int t = j - CTXL; const size_t tl = (size_t)bb * SEQ + t;
        if (col < C_DAK) { if (!lat) return; rope8(t, col & 63, a, b, QSCALE); *(u32x4*)((bf16*)(ws + WS_QDA) + tl * 512 + col) = pack8(a, b); }
        else if (col < C_DAV) { if (lat) rope8(t, col & 63, a, b, 1.0f); *(u32x4*)((bf16*)(ws + WS_KDA) + (size_t)row * 512 + (col - C_DAK)) = pack8(a, b); }
        else if (col < C_GQ) { *(u32x4*)((bf16*)(ws + WS_VDA) + (size_t)row * 512 + (col - C_DAV)) = pack8(a, b); }
        else if (col < C_GK) { if (!lat) return; *(u32x4*)((bf16*)(ws + WS_GQ) + tl * 256 + (col - C_GQ)) = pack8(a * 0.125f, b * 0.125f); }
        else if (col < C_GV) { *(u32x4*)((bf16*)(ws + WS_GK) + (size_t)row * 256 + (col - C_GK)) = pack8(a, b); }
        else if (col < C_GR) { *(u32x4*)((bf16*)(ws + WS_GV) + (size_t)row * 512 + (col - C_GV)) = pack8(a, b); }
        else if (col < C_LR) { if (!lat) return; *(u32x4*)((bf16*)(ws + WS_GR) + tl * 512 + (col - C_GR)) = pack8(a, b); }
        else if (col < NPROJ) { float* p = (float*)(ws + WS_LR) + (size_t)row * 32 + (col - C_LR); *(f32x4*)p = a; *(f32x4*)(p + 4) = b; }
    }
};
struct EpiGateUp {
    bf16* HMID;
    __device__ __forceinline__ void emit8(int row, int col, f32x4 a, f32x4 b) const {
        f32x4 h; h.x = silu_f(a.x) * b.x; h.y = silu_f(a.y) * b.y; h.z = silu_f(a.z) * b.z; h.w = silu_f(a.w) * b.w;
        u32x2 w; w.x = pk2(h.x, h.y); w.y = pk2(h.z, h.w); *(u32x2*)(HMID + (size_t)row * EHID + (col >> 1)) = w;
    }
};
struct EpiDown {
    bf16* YB;
    __device__ __forceinline__ void emit8(int row, int col, f32x4 a, f32x4 b) const { *(u32x4*)(YB + (size_t)row * DM + col) = pack8(a, b); }
};

__device__ __forceinline__ void moe_build(LAS int* mm, const unsigned* ctl) {
    if (threadIdx.x < 64) { const int l = threadIdx.x, e = l & 31;
        const int cnt = (int)__hip_atomic_load((unsigned*)ctl + CW_CNT + 64 * e, __ATOMIC_RELAXED, __HIP_MEMORY_SCOPE_AGENT);
        const int tiles = (cnt + 255) >> 8; int incl = tiles;
#pragma unroll
        for (int o = 1; o < 32; o <<= 1) { const int v = __shfl_up(incl, o); if (e >= o) incl += v; }
        if (l < 32) { mm[e] = cnt; mm[32 + e] = incl - tiles; if (e == 31) mm[64] = incl; } }
    __syncthreads();
}
__device__ __forceinline__ int moe_tile_expert(const LAS int* mm, int tile) { int e = 0;
#pragma unroll 1
    for (int i = 1; i < NEXP; ++i) if (mm[32 + i] <= tile) e = i;
    return e; }

namespace pg8 {
typedef short bf16x8 __attribute__((ext_vector_type(8)));
constexpr int BM = 256, BK = 64, HALF = 128, HTB = HALF * BK * 2  , STAGE_BYTES = 8 * HTB;
__host__ __device__ __forceinline__ int lds_byte(int r, int c) { const int st = (r >> 4) * 2 + (c >> 5), rr = r & 15, cc = c & 31, ob = rr * 64 + cc * 2; return st * 1024 + (ob ^ (((ob >> 9) & 1) << 5)); }
__host__ __device__ __forceinline__ void stage_rc(int b, int& R, int& C) { const int st = b / 1024, sb = b % 1024, swz = sb ^ (((sb >> 9) & 1) << 5); R = (st >> 1) * 16 + swz / 64; C = (st & 1) * 32 + (swz % 64) / 2; }
__host__ __device__ __forceinline__ int perm32(int rho) { const int n = rho >> 4, i = rho & 15; return 8 * (i >> 2) + 4 * n + (i & 3); }

struct Unit { const char* A; const char* B; int row0, col0, ge, gp; };
struct Gemm { int K; const int* LIST; const LAS int* mm; };

template <class E8> struct Epi8 {
    E8 e;
    __device__ __forceinline__ void operator()(const f32x4 (&acc)[2][2][4][2], const Unit& u, int wr, int wc, int fr, int fq) const {
#pragma unroll
        for (int ai = 0; ai < 2; ++ai)
#pragma unroll
            for (int m = 0; m < 4; ++m)
#pragma unroll
                for (int bj = 0; bj < 2; ++bj) e.emit8(u.row0 + ai * HALF + wr * 64 + m * 16 + fr, u.col0 + bj * HALF + wc * 32 + 8 * fq, acc[ai][bj][m][0], acc[ai][bj][m][1]);
    }
};

struct EpiInProjF {
    unsigned char* ws;
    template <int PITCH, int MODE  > __device__ __forceinline__ void plain_tile(bf16* p, const f32x4 (&acc)[2][2][4][2]) const {
#pragma unroll
        for (int ai = 0; ai < 2; ++ai)
#pragma unroll
            for (int m = 0; m < 4; ++m)
#pragma unroll
                for (int bj = 0; bj < 2; ++bj) { f32x4 a = acc[ai][bj][m][0], b = acc[ai][bj][m][1]; if (MODE == 1) { a = a * 0.125f; b = b * 0.125f; }
                    *(u32x4*)(p + (ai * HALF + m * 16) * PITCH + bj * HALF) = pack8(a, b); }
    }
    template <int MODE  > __device__ __forceinline__ void rope_tile(bf16* p, int tseq, int cl, const f32x4 (&acc)[2][2][4][2]) const {
        const int i8 = cl & 63; const float scale = MODE == 2 ? QSCALE : 1.0f;
        const f32x2* R = (const f32x2*)(ws + WS_ROPE) + (size_t)tseq * 32 + (i8 >> 5) * 16 + ((i8 & 31) >> 1);
        f32x4 rc[4][2]; u32x4 w[4][2];
#define IPR_LOAD(ai) _Pragma("unroll") for (int m = 0; m < 4; ++m) { rc[m][0] = *(const f32x4*)(R + ((ai) * HALF + m * 16) * 32); rc[m][1] = *(const f32x4*)(R + ((ai) * HALF + m * 16) * 32 + 2); }
#define IPR_CALC(ai) _Pragma("unroll") for (int m = 0; m < 4; ++m) _Pragma("unroll") for (int bj = 0; bj < 2; ++bj) { const f32x4 a = acc[ai][bj][m][0], b = acc[ai][bj][m][1], c0 = rc[m][0], c1 = rc[m][1]; f32x4 oa, ob; \
            oa.x = (a.x * c0.x - a.y * c0.y) * scale; oa.y = (a.y * c0.x + a.x * c0.y) * scale; oa.z = (a.z * c0.z - a.w * c0.w) * scale; oa.w = (a.w * c0.z + a.z * c0.w) * scale; \
            ob.x = (b.x * c1.x - b.y * c1.y) * scale; ob.y = (b.y * c1.x + b.x * c1.y) * scale; ob.z = (b.z * c1.z - b.w * c1.w) * scale; ob.w = (b.w * c1.z + b.z * c1.w) * scale; w[m][bj] = pack8(oa, ob); }
#define IPR_STORE(ai) _Pragma("unroll") for (int m = 0; m < 4; ++m) _Pragma("unroll") for (int bj = 0; bj < 2; ++bj) *(u32x4*)(p + ((ai) * HALF + m * 16) * 512 + bj * HALF) = w[m][bj];
        IPR_LOAD(0) IPR_CALC(0) IPR_LOAD(1) IPR_STORE(0) IPR_CALC(1) IPR_STORE(1)
#undef IPR_LOAD
#undef IPR_CALC
#undef IPR_STORE
    }
    __device__ __forceinline__ void operator()(const f32x4 (&acc)[2][2][4][2], const Unit& u, int wr, int wc, int fr, int fq) const {
        const int pn = __builtin_amdgcn_readfirstlane(u.col0) >> 8, row0 = __builtin_amdgcn_readfirstlane(u.row0);
        const int bb = row0 / KVL, j0 = row0 - bb * KVL; const bool lat = j0 >= CTXL;
        const int rl = wr * 64 + fr, cl = wc * 32 + 8 * fq;
        const size_t gr = (size_t)(row0 + rl), tl = (size_t)(bb * SEQ + j0 - CTXL + rl);
        if (pn < 2) { if (lat) rope_tile<2>((bf16*)(ws + WS_QDA) + tl * 512 + pn * 256 + cl, j0 - CTXL + rl, cl, acc); }
        else if (pn < 4) { bf16* p = (bf16*)(ws + WS_KDA) + gr * 512 + (pn - 2) * 256 + cl; if (lat) rope_tile<3>(p, j0 - CTXL + rl, cl, acc); else plain_tile<512, 0>(p, acc); }
        else if (pn < 6) plain_tile<512, 0>((bf16*)(ws + WS_VDA) + gr * 512 + (pn - 4) * 256 + cl, acc);
        else if (pn == 6) { if (lat) plain_tile<256, 1>((bf16*)(ws + WS_GQ) + tl * 256 + cl, acc); }
        else if (pn == 7) plain_tile<256, 0>((bf16*)(ws + WS_GK) + gr * 256 + cl, acc);
        else if (pn < 10) plain_tile<512, 0>((bf16*)(ws + WS_GV) + gr * 512 + (pn - 8) * 256 + cl, acc);
        else if (pn < 12) { if (lat) plain_tile<512, 0>((bf16*)(ws + WS_GR) + tl * 512 + (pn - 10) * 256 + cl, acc); }
        else if (cl < NPROJ - C_LR) { float* p = (float*)(ws + WS_LR) + gr * 32 + cl;
#pragma unroll
            for (int ai = 0; ai < 2; ++ai)
#pragma unroll
                for (int m = 0; m < 4; ++m) { *(f32x4*)(p + (ai * HALF + m * 16) * 32) = acc[ai][0][m][0]; *(f32x4*)(p + (ai * HALF + m * 16) * 32 + 4) = acc[ai][0][m][1]; } }
    }
};

struct EpiOutProjB {
    const float* x; const float* MOD; bf16* X1; float* SSP;
    __device__ __forceinline__ void operator()(const f32x4 (&acc)[2][2][4][2], const Unit& u, int wr, int wc, int fr, int fq) const {
        const int bb = u.row0 / SEQ; const int colb = u.col0 + wc * 32 + 8 * fq;
        f32x4 g[2][2];
#pragma unroll
        for (int bj = 0; bj < 2; ++bj) { const float* gp = MOD + bb * 6144 + 2048 + colb + bj * HALF; g[bj][0] = *(const f32x4*)gp; g[bj][1] = *(const f32x4*)(gp + 4); }
#pragma unroll
        for (int ai = 0; ai < 2; ++ai)
#pragma unroll
            for (int mh = 0; mh < 2; ++mh) {
                f32x4 xv[2][2][2]; float ssq[2] = {0.f, 0.f};
#pragma unroll
                for (int mm_ = 0; mm_ < 2; ++mm_)
#pragma unroll
                    for (int bj = 0; bj < 2; ++bj) { const float* xp = x + (size_t)(u.row0 + ai * HALF + wr * 64 + (2 * mh + mm_) * 16 + fr) * DM + colb + bj * HALF; xv[mm_][bj][0] = *(const f32x4*)xp; xv[mm_][bj][1] = *(const f32x4*)(xp + 4); }
#pragma unroll
                for (int mm_ = 0; mm_ < 2; ++mm_)
#pragma unroll
                    for (int bj = 0; bj < 2; ++bj) { const int m = 2 * mh + mm_; const size_t o = (size_t)(u.row0 + ai * HALF + wr * 64 + m * 16 + fr) * DM + colb + bj * HALF;
                        const u32x4 pw = pack8(xv[mm_][bj][0] + g[bj][0] * acc[ai][bj][m][0], xv[mm_][bj][1] + g[bj][1] * acc[ai][bj][m][1]);
                        *(u32x4*)(X1 + o) = pw;
                        const float q0 = bflo(pw.x), q1 = bfhi(pw.x), q2 = bflo(pw.y), q3 = bfhi(pw.y), q4 = bflo(pw.z), q5 = bfhi(pw.z), q6 = bflo(pw.w), q7 = bfhi(pw.w);
                        ssq[mm_] += (q0 * q0 + q1 * q1) + (q2 * q2 + q3 * q3) + (q4 * q4 + q5 * q5) + (q6 * q6 + q7 * q7); }
#pragma unroll
                for (int mm_ = 0; mm_ < 2; ++mm_) { float s = ssq[mm_]; s += __shfl_xor(s, 16); s += __shfl_xor(s, 32);
                    if (fq == 0) SSP[(size_t)(u.row0 + ai * HALF + wr * 64 + (2 * mh + mm_) * 16 + fr) * 16 + (u.col0 >> 8) * 4 + wc] = s; }
                asm volatile("" ::: "memory");
            }
    }
};

template <class Epi, class Sched, bool GATHER, bool ALIGN_EPI = true, bool SP2 = true>
__device__ __forceinline__ void gemm_phase(LAS unsigned char* lds, const Gemm g, const Sched& S, const Epi& E) {
    int tid = threadIdx.x; asm volatile("" : "+v"(tid));
    const int wid = __builtin_amdgcn_readfirstlane(tid >> 6), lane = tid & 63, wr = wid >> 2, wc = wid & 3, fr = lane & 15, fq = lane >> 4;
    const int K = g.K, nt = K / BK;
    int Rr[2], Cc[2]; unsigned voffB[2];
#pragma unroll
    for (int i = 0; i < 2; ++i) { stage_rc(tid * 16 + i * 8192, Rr[i], Cc[i]); const int Rb = (Rr[i] & ~31) + perm32(Rr[i] & 31); voffB[i] = (unsigned)(Rb * K + Cc[i]) * 2u; }
    const size_t kstep = (size_t)(BK * 2);
    const size_t hstep = (size_t)HALF * K * 2;
    const unsigned ldsw = (unsigned)wid * 1024u;
    const int aoff = lds_byte(wr * 64 + fr, fq * 8), boff = lds_byte(wc * 32 + fr, fq * 8);
#define PG8_MKOFF(u, vo) do { _Pragma("unroll") for (int _h = 0; _h < 2; ++_h) _Pragma("unroll") for (int _i = 0; _i < 2; ++_i) { \
        if (GATHER) { const int _pos = (u).gp + _h * HALF + Rr[_i]; const int _tok = g.LIST[(u).ge * NTOK + (_pos < g.mm[(u).ge] ? _pos : 0)]; (vo)[_h][_i] = (unsigned)(_tok * K + Cc[_i]) * 2u; } \
        else (vo)[_h][_i] = (unsigned)((_h * HALF + Rr[_i]) * K + Cc[_i]) * 2u; } } while (0)
#define PG8_SA(b, h) (((b) * 2 + (h)) * HTB)
#define PG8_SB(b, h) ((4 + (b) * 2 + (h)) * HTB)
#define PG8_STAGE(bufoff, gbase, voff) do { _Pragma("unroll") for (int _i = 0; _i < 2; ++_i) \
        __builtin_amdgcn_global_load_lds((const unsigned*)((const char*)(gbase) + (voff)[_i]), (LAS unsigned*)(lds + (bufoff) + ldsw + _i * 8192), 16, 0, 0); } while (0)
#define PG8_LDA(dst, b, h) do { _Pragma("unroll") for (int m = 0; m < 4; ++m) _Pragma("unroll") for (int k = 0; k < 2; ++k) dst[m][k] = *(const LAS bf16x8*)(lds + PG8_SA(b, h) + aoff + m * 2048 + k * 1024); } while (0)
#define PG8_LDB(dst, b, h) do { _Pragma("unroll") for (int n = 0; n < 2; ++n) _Pragma("unroll") for (int k = 0; k < 2; ++k) dst[n][k] = *(const LAS bf16x8*)(lds + PG8_SB(b, h) + boff + n * 2048 + k * 1024); } while (0)
#define PG8_MMA(ai, bj, At, Bt) do { __builtin_amdgcn_s_setprio(1); _Pragma("unroll") for (int m = 0; m < 4; ++m) _Pragma("unroll") for (int n = 0; n < 2; ++n) _Pragma("unroll") for (int k = 0; k < 2; ++k) \
        acc[ai][bj][m][n] = __builtin_amdgcn_mfma_f32_16x16x32_bf16(Bt[n][k], At[m][k], acc[ai][bj][m][n], 0, 0, 0); __builtin_amdgcn_s_setprio(0); } while (0)
#define PG8_WAIT_V(n) asm volatile("s_waitcnt vmcnt(" #n ")" ::: "memory")
#define PG8_WAIT_L(n) asm volatile("s_waitcnt lgkmcnt(" #n ")" ::: "memory")
#define PG8_BAR __builtin_amdgcn_s_barrier()
#define PG8_SCHED __builtin_amdgcn_sched_barrier(0)
    Unit cur, nxt; int ui = 0;
    if (!S.next(0, cur)) return;
    f32x4 acc[2][2][4][2];
#pragma unroll
    for (int a = 0; a < 2; ++a)
#pragma unroll
        for (int b = 0; b < 2; ++b)
#pragma unroll
            for (int m = 0; m < 4; ++m)
#pragma unroll
                for (int n = 0; n < 2; ++n) acc[a][b][m][n] = (f32x4){0.f, 0.f, 0.f, 0.f};
    bf16x8 At[4][2], B0[2][2], B1[2][2];
    unsigned voffA[2][2], nvoffA[2][2];
    PG8_MKOFF(cur, voffA);
    const char* cA = cur.A; const char* cB = cur.B;
    if constexpr (SP2) {
        PG8_STAGE(PG8_SB(0, 0), cB, voffB); PG8_STAGE(PG8_SB(0, 1), cB + hstep, voffB); PG8_STAGE(PG8_SA(0, 0), cA, voffA[0]); PG8_STAGE(PG8_SA(0, 1), cA, voffA[1]);
        if (wr == 1) PG8_BAR;
        PG8_WAIT_V(2); PG8_BAR;
        PG8_STAGE(PG8_SB(1, 0), cB + kstep, voffB); PG8_STAGE(PG8_SA(1, 0), cA + kstep, voffA[0]); PG8_STAGE(PG8_SB(1, 1), cB + hstep + kstep, voffB);
        PG8_WAIT_V(6); PG8_BAR;
    } else {
        PG8_STAGE(PG8_SB(0, 0), cB, voffB); PG8_STAGE(PG8_SA(0, 0), cA, voffA[0]); PG8_STAGE(PG8_SB(0, 1), cB + hstep, voffB); PG8_STAGE(PG8_SA(0, 1), cA, voffA[1]);
        if (wr == 1) PG8_BAR;
        PG8_WAIT_V(4); PG8_BAR;
        PG8_STAGE(PG8_SB(1, 0), cB + kstep, voffB); PG8_STAGE(PG8_SA(1, 0), cA + kstep, voffA[0]); PG8_STAGE(PG8_SB(1, 1), cB + hstep + kstep, voffB);
        PG8_WAIT_V(6); PG8_BAR;
    }
    for (;;) {
        const bool has_next = S.next(ui + 1, nxt);
        if (has_next) { PG8_MKOFF(nxt, nvoffA); }
        else {
#pragma unroll
            for (int h = 0; h < 2; ++h)
#pragma unroll
                for (int i = 0; i < 2; ++i) nvoffA[h][i] = voffA[h][i]; }
        const char* nA = has_next ? nxt.A : cA; const char* nB = has_next ? nxt.B : cB;
        for (int t = 0; t < nt; t += 2) {
            const bool last = (t == nt - 2);
            const char* a1 = cA + (size_t)(t + 1) * kstep;
            const char* a2 = last ? nA : cA + (size_t)(t + 2) * kstep; const char* b2 = last ? nB : cB + (size_t)(t + 2) * kstep;
            const char* a3 = a2 + kstep; const char* b3 = b2 + kstep;
            unsigned v2[2][2];
#pragma unroll
            for (int h = 0; h < 2; ++h)
#pragma unroll
                for (int i = 0; i < 2; ++i) v2[h][i] = last ? nvoffA[h][i] : voffA[h][i];
            if constexpr (SP2) {
            PG8_LDB(B0, 0, 0); PG8_LDB(B1, 0, 1); PG8_SCHED; PG8_LDA(At, 0, 0); PG8_STAGE(PG8_SA(1, 1), a1, voffA[1]);
            PG8_WAIT_V(8); PG8_WAIT_L(0); PG8_BAR; PG8_MMA(0, 0, At, B0); PG8_MMA(0, 1, At, B1); PG8_BAR; PG8_SCHED;
            PG8_LDA(At, 0, 1); PG8_STAGE(PG8_SB(0, 0), b2, voffB); PG8_STAGE(PG8_SB(0, 1), b2 + hstep, voffB); PG8_STAGE(PG8_SA(0, 0), a2, v2[0]);
            PG8_WAIT_V(8); PG8_WAIT_L(0); PG8_BAR; PG8_MMA(1, 0, At, B0); PG8_MMA(1, 1, At, B1); PG8_BAR; PG8_SCHED;
            PG8_LDB(B0, 1, 0); PG8_LDB(B1, 1, 1); PG8_SCHED; PG8_LDA(At, 1, 0); PG8_STAGE(PG8_SA(0, 1), a2, v2[1]);
            PG8_WAIT_V(8); PG8_WAIT_L(0); PG8_BAR; PG8_MMA(0, 0, At, B0); PG8_MMA(0, 1, At, B1); PG8_BAR; PG8_SCHED;
            PG8_LDA(At, 1, 1); PG8_STAGE(PG8_SB(1, 0), b3, voffB); PG8_STAGE(PG8_SB(1, 1), b3 + hstep, voffB); PG8_STAGE(PG8_SA(1, 0), a3, v2[0]);
            PG8_WAIT_V(8); PG8_WAIT_L(0); PG8_BAR; PG8_MMA(1, 0, At, B0); PG8_MMA(1, 1, At, B1); PG8_BAR; PG8_SCHED;
            } else {
            PG8_LDB(B0, 0, 0); PG8_SCHED; PG8_LDA(At, 0, 0); PG8_STAGE(PG8_SA(1, 1), a1, voffA[1]);
            PG8_WAIT_L(8); PG8_BAR; PG8_WAIT_L(0); PG8_MMA(0, 0, At, B0); PG8_BAR; PG8_SCHED;
            PG8_LDB(B1, 0, 1); PG8_STAGE(PG8_SB(0, 0), b2, voffB);
            PG8_BAR; PG8_WAIT_L(0); PG8_MMA(0, 1, At, B1); PG8_BAR;
            PG8_LDA(At, 0, 1); PG8_STAGE(PG8_SA(0, 0), a2, v2[0]);
            PG8_BAR; PG8_WAIT_L(0); PG8_MMA(1, 0, At, B0); PG8_BAR; PG8_SCHED;
            PG8_STAGE(PG8_SB(0, 1), b2 + hstep, voffB);
            PG8_WAIT_V(6); PG8_BAR; PG8_MMA(1, 1, At, B1); PG8_BAR;
            PG8_LDB(B0, 1, 0); PG8_SCHED; PG8_LDA(At, 1, 0); PG8_STAGE(PG8_SA(0, 1), a2, v2[1]);
            PG8_WAIT_L(8); PG8_BAR; PG8_WAIT_L(0); PG8_MMA(0, 0, At, B0); PG8_BAR; PG8_SCHED;
            PG8_LDB(B1, 1, 1); PG8_STAGE(PG8_SB(1, 0), b3, voffB);
            PG8_BAR; PG8_WAIT_L(0); PG8_MMA(0, 1, At, B1); PG8_BAR;
            PG8_LDA(At, 1, 1); PG8_STAGE(PG8_SA(1, 0), a3, v2[0]);
            PG8_BAR; PG8_WAIT_L(0); PG8_MMA(1, 0, At, B0); PG8_BAR; PG8_SCHED;
            PG8_STAGE(PG8_SB(1, 1), b3 + hstep, voffB);
            PG8_WAIT_V(6); PG8_BAR; PG8_MMA(1, 1, At, B1); PG8_BAR;
            }
        }
        if constexpr (ALIGN_EPI) { if (wr == 0) PG8_BAR; }
        E(acc, cur, wr, wc, fr, fq);
        if (!has_next) break;
#pragma unroll
        for (int a = 0; a < 2; ++a)
#pragma unroll
            for (int b = 0; b < 2; ++b)
#pragma unroll
                for (int m = 0; m < 4; ++m)
#pragma unroll
                    for (int n = 0; n < 2; ++n) acc[a][b][m][n] = (f32x4){0.f, 0.f, 0.f, 0.f};
        cur = nxt; cA = nA; cB = nB; ++ui;
#pragma unroll
        for (int h = 0; h < 2; ++h)
#pragma unroll
            for (int i = 0; i < 2; ++i) voffA[h][i] = nvoffA[h][i];
        if constexpr (ALIGN_EPI) { if (wr == 1) PG8_BAR; }
    }
    PG8_WAIT_V(0);
    if constexpr (!ALIGN_EPI) { if (wr == 0) PG8_BAR; }
    PG8_BAR;
#undef PG8_MKOFF
#undef PG8_SA
#undef PG8_SB
#undef PG8_STAGE
#undef PG8_LDA
#undef PG8_LDB
#undef PG8_MMA
#undef PG8_WAIT_V
#undef PG8_WAIT_L
#undef PG8_BAR
#undef PG8_SCHED
}
__device__ __forceinline__ int xcd_remap(int L, int nwg) { const int q = nwg / 8, r = nwg % 8, xcd = L % 8, off = L / 8; return (xcd < r ? xcd * (q + 1) : r * (q + 1) + (xcd - r) * q) + off; }
}

constexpr int LDS_MM_OFF = 131072;

struct OrderInProj { int G, c; const char* H; const char* W;
    __device__ __forceinline__ bool next(int i, pg8::Unit& u) const {
        const int L = i * G + c; if (L >= 1792) return false;
        int pmg, pn;
        if (L < 1664) { const int wgid = pg8::xcd_remap(L, 1664); const int nig = 8 * 13, gid = wgid / nig, p = gid * 8 + ((wgid % nig) & 7); pn = (wgid % nig) >> 3; pmg = (p >> 3) * 9 + 1 + (p & 7); }
        else { const int idx = L - 1664, p = idx & 15, ci = idx >> 4; pmg = p * 9; pn = ci < 4 ? 2 + ci : (ci < 7 ? 3 + ci : 12); }
        u.A = H + (size_t)pmg * 256 * 2048; u.B = W + (size_t)pn * 256 * 2048; u.row0 = pmg * 256; u.col0 = pn * 256; u.ge = -1; u.gp = 0; return true; } };
struct OrderOutProj { int G, c; const char* A; const char* W;
    __device__ __forceinline__ bool next(int i, pg8::Unit& u) const {
        const int L = i * G + c; if (L >= 512) return false;
        const int wgid = pg8::xcd_remap(L, 512); const int nig = 8 * 4, gid = wgid / nig, pm = gid * 8 + ((wgid % nig) & 7), pn = (wgid % nig) >> 3;
        u.A = A + (size_t)pm * 256 * 2048; u.B = W + (size_t)pn * 256 * 2048; u.row0 = pm * 256; u.col0 = pn * 256; u.ge = -1; u.gp = 0; return true; } };
struct OrderGateUp { int G, c; const char* H2; const char* W; const LAS int* mm;
    __device__ __forceinline__ bool next(int i, pg8::Unit& u) const {
        const int nwg = mm[64] * 4, L = i * G + c; if (L >= nwg) return false;
        const int wgid = pg8::xcd_remap(L, nwg), tt = wgid >> 2, pn = wgid & 3, e = moe_tile_expert(mm, tt);
        u.A = H2; u.B = W + ((size_t)e * 1024 + pn * 256) * 2048; u.row0 = tt * 256; u.col0 = pn * 256; u.ge = e; u.gp = (tt - mm[32 + e]) * 256; return true; } };
struct OrderDown { int G, c; const char* HM; const char* W; const LAS int* mm;
    __device__ __forceinline__ bool next(int i, pg8::Unit& u) const {
        const int nwg = mm[64] * 4, L = i * G + c; if (L >= nwg) return false;
        const int wgid = pg8::xcd_remap(L, nwg), tt = wgid >> 2, pn = wgid & 3, e = moe_tile_expert(mm, tt);
        u.A = HM + (size_t)tt * 256 * 1024; u.B = W + ((size_t)e * 1024 + pn * 256) * 1024; u.row0 = tt * 256; u.col0 = pn * 256; u.ge = -1; u.gp = 0; return true; } };

__device__ __forceinline__ void ph_inproj(const Ctx& c, LAS unsigned char* lds) {
    pg8::Gemm g{1024, nullptr, nullptr}; OrderInProj S{(int)gridDim.x, (int)blockIdx.x, (const char*)(c.ws + WS_H), (const char*)(c.ws + WS_WIN_T)};
    pg8::EpiInProjF E{c.ws};
    pg8::gemm_phase<pg8::EpiInProjF, OrderInProj, false>(lds, g, S, E);
}
__device__ __forceinline__ void ph_outproj(const Ctx& c, LAS unsigned char* lds) {
    pg8::Gemm g{1024, nullptr, nullptr}; OrderOutProj S{(int)gridDim.x, (int)blockIdx.x, (const char*)(c.ws + WS_MIX), (const char*)(c.ws + WS_WOUT_T)};
    pg8::EpiOutProjB E{c.x, (const float*)(c.ws + WS_MOD), (bf16*)(c.ws + WS_X1), (float*)(c.ws + WS_SSP)};
    pg8::gemm_phase<pg8::EpiOutProjB, OrderOutProj, false>(lds, g, S, E);
}
__device__ __forceinline__ void ph_gateup(const Ctx& c, LAS unsigned char* lds) {
    LAS int* mm = (LAS int*)(lds + LDS_MM_OFF); moe_build(mm, (const unsigned*)(c.ws + WS_CTL));
    pg8::Gemm g{1024, (const int*)(c.ws + WS_LIST), mm}; OrderGateUp S{(int)gridDim.x, (int)blockIdx.x, (const char*)(c.ws + WS_H2), (const char*)(c.ws + WS_WGU_T), mm};
    pg8::Epi8<EpiGateUp> E{EpiGateUp{(bf16*)(c.ws + WS_HMID)}};
    pg8::gemm_phase<pg8::Epi8<EpiGateUp>, OrderGateUp, true>(lds, g, S, E);
}
__device__ __forceinline__ void ph_down(const Ctx& c, LAS unsigned char* lds) {
    LAS int* mm = (LAS int*)(lds + LDS_MM_OFF); moe_build(mm, (const unsigned*)(c.ws + WS_CTL));
    pg8::Gemm g{512, nullptr, mm}; OrderDown S{(int)gridDim.x, (int)blockIdx.x, (const char*)(c.ws + WS_HMID), (const char*)(c.ws + WS_WD_T), mm};
    pg8::Epi8<EpiDown> E{EpiDown{(bf16*)(c.ws + WS_YB)}};
    pg8::gemm_phase<pg8::Epi8<EpiDown>, OrderDown, false>(lds, g, S, E);
}

__device__ __forceinline__ float da_lambda_full(const float* lp) {
    float s0 = 0.f, s1 = 0.f;
    for (int i = 0; i < 64; ++i) { s0 += lp[i] * lp[64 + i]; s1 += lp[128 + i] * lp[192 + i]; }
    return expf(s0) - expf(s1) + LAMBDA_INIT;
}
namespace da {
typedef short bf16x8 __attribute__((ext_vector_type(8)));
typedef short s16x4 __attribute__((ext_vector_type(4)));
typedef float f32x16 __attribute__((ext_vector_type(16)));
typedef float f32x2_t __attribute__((ext_vector_type(2))); typedef __bf16 bf16x2_t __attribute__((ext_vector_type(2)));
__device__ __forceinline__ unsigned cvtpk(float lo, float hi) { f32x2_t v = {lo, hi}; bf16x2_t b = __builtin_convertvector(v, bf16x2_t); return __builtin_bit_cast(unsigned, b); }
__device__ __forceinline__ bf16x8 pack_half(const f32x16& x, int s) {
    u32x4 p; p.x = cvtpk(x[8 * s], x[8 * s + 1]); p.y = cvtpk(x[8 * s + 2], x[8 * s + 3]); p.z = cvtpk(x[8 * s + 4], x[8 * s + 5]); p.w = cvtpk(x[8 * s + 6], x[8 * s + 7]);
    return __builtin_bit_cast(bf16x8, p); }
__device__ __forceinline__ s16x4 vtr(const LAS unsigned char* p) { return __builtin_bit_cast(s16x4, __builtin_amdgcn_ds_read_tr16_b64_v4i16((LAS s16x4*)p)); }
#define DA_MFMA(a, b, c) __builtin_amdgcn_mfma_f32_32x32x16_bf16((a), (b), (c), 0, 0, 0)
constexpr int NT = KVL / 64;
constexpr int QS_OFF = 81920;

template <int KB> __device__ __forceinline__ void qk_tile(const LAS unsigned char* kq, const bf16x8 (&qf)[4], const f32x16& negm, f32x16& s0, f32x16& s1) {
#pragma unroll
    for (int ks = 0; ks < 4; ++ks) {
        const bf16x8 k0 = *(const LAS bf16x8*)(kq + KB + ks * 2048), k1 = *(const LAS bf16x8*)(kq + KB + ks * 2048 + 512), qq = qf[ks];
        if (ks == 0) { s0 = DA_MFMA(k0, qq, negm); s1 = DA_MFMA(k1, qq, negm); } else { s0 = DA_MFMA(k0, qq, s0); s1 = DA_MFMA(k1, qq, s1); } }
}
__device__ __forceinline__ float max3f(float a, float b, float c) { return fmaxf(fmaxf(a, b), c); }
template <int VB> __device__ __forceinline__ void softmax_pv(const LAS unsigned char* lds, int vlane, f32x16& s0, f32x16& s1, f32x16 (&O)[4], f32x16& negm, float& lrun) {
    float ma = max3f(s0[0], s0[1], s1[0]), mb = max3f(s0[2], s0[3], s1[1]); ma = max3f(ma, s1[2], s1[3]);
#pragma unroll
    for (int r = 4; r < 16; r += 4) { ma = max3f(ma, s0[r], s0[r + 1]); mb = max3f(mb, s0[r + 2], s0[r + 3]); ma = max3f(ma, s1[r], s1[r + 1]); mb = max3f(mb, s1[r + 2], s1[r + 3]); }
    float mx = fmaxf(ma, mb);
    mx = fmaxf(mx, __shfl_xor(mx, 32));
    if (__any(mx > 8.0f)) {
        const float dl = fmaxf(mx, 0.f), alpha = __builtin_amdgcn_exp2f(-dl);
        lrun *= alpha;
#pragma unroll
        for (int r = 0; r < 16; ++r) { s0[r] -= dl; s1[r] -= dl; negm[r] -= dl; }
#pragma unroll
        for (int dt = 0; dt < 4; ++dt)
#pragma unroll
            for (int r = 0; r < 16; ++r) O[dt][r] *= alpha;
    }
    const unsigned vb = (unsigned)(size_t)(lds + VB + vlane);
    s16x4 fa[8], fb[8]; bf16x8 Pa, Pb; float ps = 0.f;
#define DA_VRDK(dst, ks) do { _Pragma("unroll") for (int _d = 0; _d < 4; ++_d) { \
        asm volatile("ds_read_b64_tr_b16 %0, %1 offset:%2" : "=&v"(dst[2 * _d]) : "v"(vb), "n"((_d * 4 + (ks)) * 1024) : "memory"); \
        asm volatile("ds_read_b64_tr_b16 %0, %1 offset:%2" : "=&v"(dst[2 * _d + 1]) : "v"(vb), "n"((_d * 4 + (ks)) * 1024 + 512) : "memory"); } } while (0)
#define DA_VWAIT(N, f) asm volatile("s_waitcnt lgkmcnt(" #N ")" : "+v"(f[0]), "+v"(f[1]), "+v"(f[2]), "+v"(f[3]), "+v"(f[4]), "+v"(f[5]), "+v"(f[6]), "+v"(f[7]) :: "memory")
#define DA_EXP2(S, r0) do { S[r0] = __builtin_amdgcn_exp2f(S[r0]); S[(r0) + 1] = __builtin_amdgcn_exp2f(S[(r0) + 1]); ps += S[r0] + S[(r0) + 1]; } while (0)
#define DA_MX(f, Pcur, d, S, r0) do { O[d] = DA_MFMA(__builtin_shufflevector(f[2 * (d)], f[2 * (d) + 1], 0, 1, 2, 3, 4, 5, 6, 7), Pcur, O[d]); DA_EXP2(S, r0); __builtin_amdgcn_sched_barrier(0); } while (0)
    DA_VRDK(fa, 0); DA_VRDK(fb, 1);
    DA_EXP2(s0, 0); DA_EXP2(s0, 2); DA_EXP2(s0, 4); DA_EXP2(s0, 6); Pa = pack_half(s0, 0);
    DA_VWAIT(8, fa); __builtin_amdgcn_sched_barrier(0);
    DA_MX(fa, Pa, 0, s0, 8); DA_MX(fa, Pa, 1, s0, 10); DA_MX(fa, Pa, 2, s0, 12); DA_MX(fa, Pa, 3, s0, 14); Pb = pack_half(s0, 1);
    DA_VRDK(fa, 2); DA_VWAIT(8, fb); __builtin_amdgcn_sched_barrier(0);
    DA_MX(fb, Pb, 0, s1, 0); DA_MX(fb, Pb, 1, s1, 2); DA_MX(fb, Pb, 2, s1, 4); DA_MX(fb, Pb, 3, s1, 6); Pa = pack_half(s1, 0);
    DA_VRDK(fb, 3); DA_VWAIT(8, fa); __builtin_amdgcn_sched_barrier(0);
    DA_MX(fa, Pa, 0, s1, 8); DA_MX(fa, Pa, 1, s1, 10); DA_MX(fa, Pa, 2, s1, 12); DA_MX(fa, Pa, 3, s1, 14); Pb = pack_half(s1, 1);
    DA_VWAIT(0, fb); __builtin_amdgcn_sched_barrier(0);
#pragma unroll
    for (int d = 0; d < 4; ++d) O[d] = DA_MFMA(__builtin_shufflevector(fb[2 * d], fb[2 * d + 1], 0, 1, 2, 3, 4, 5, 6, 7), Pb, O[d]);
    lrun += ps;
#undef DA_VRDK
#undef DA_VWAIT
#undef DA_EXP2
#undef DA_MX
}

template <int m> __device__ __forceinline__ void attn_body(const Ctx& c, LAS unsigned char* lds) {
    const int tid = threadIdx.x, lane = tid & 63, wid = __builtin_amdgcn_readfirstlane(tid >> 6), r32 = lane & 31, hi = lane >> 5;
    const int qsub = wid & 3;
    const bf16* Q = (const bf16*)(c.ws + WS_QDA); const bf16* K = (const bf16*)(c.ws + WS_KDA); const bf16* V = (const bf16*)(c.ws + WS_VDA); bf16* MIX = (bf16*)(c.ws + WS_MIX);
    const float lam = da_lambda_full(c.da_lambda);
    const int vlane = (4 * hi + ((lane & 15) >> 2)) * 64 + ((lane >> 4) & 1) * 32 + (lane & 3) * 8;
    const LAS unsigned char* kq = lds + (m * 8 + hi) * 1024 + r32 * 16;
    const unsigned kgo0 = (unsigned)(lane * 512 + (wid * 2) * 8) * 2u, kgo1 = kgo0 + 16u;
    const unsigned vgo0 = (unsigned)((((wid * 2) & 3) * 16 + (lane >> 2)) * 512 + ((wid * 2) >> 2) * 32 + (lane & 3) * 8) * 2u, vgo1 = vgo0 + 16u * 512u * 2u;
    for (int it = 0;; ++it) {
        const int L = it * (int)gridDim.x + (int)blockIdx.x; if (L >= 1024) break;
        const int wg = pg8::xcd_remap(L, 1024), bh = wg >> 4, qb = wg & 15, b = bh >> 2, h = bh & 3;
        const char* Kb = (const char*)(K + (size_t)b * KVL * 512 + h * 128); const char* Vb = (const char*)(V + (size_t)b * KVL * 512 + h * 128);
        const size_t qrow = (size_t)b * SEQ + qb * 128 + qsub * 32 + r32;
#define DA_DMA_K(t, bo) do { const size_t _to = (size_t)(t) * (64 * 512 * 2); \
            __builtin_amdgcn_global_load_lds((const unsigned*)(Kb + _to + kgo0), (LAS unsigned*)(lds + (bo) + (wid * 2) * 1024), 16, 0, 0); \
            __builtin_amdgcn_global_load_lds((const unsigned*)(Kb + _to + kgo1), (LAS unsigned*)(lds + (bo) + (wid * 2 + 1) * 1024), 16, 0, 0); } while (0)
#define DA_DMA_V(t, bo) do { const size_t _to = (size_t)(t) * (64 * 512 * 2); \
            __builtin_amdgcn_global_load_lds((const unsigned*)(Vb + _to + vgo0), (LAS unsigned*)(lds + (bo) + (wid * 2) * 1024), 16, 0, 0); \
            __builtin_amdgcn_global_load_lds((const unsigned*)(Vb + _to + vgo1), (LAS unsigned*)(lds + (bo) + (wid * 2 + 1) * 1024), 16, 0, 0); } while (0)
        DA_DMA_K(0, 0); DA_DMA_K(1, 16384); DA_DMA_K(2, 32768); DA_DMA_V(0, 65536); DA_DMA_V(1, 81920);
        bf16x8 qf[4];
#pragma unroll
        for (int ks = 0; ks < 4; ++ks) qf[ks] = *(const bf16x8*)(Q + qrow * 512 + h * 128 + m * 64 + ks * 16 + hi * 8);
        f32x16 O[4];
#pragma unroll
        for (int dt = 0; dt < 4; ++dt)
#pragma unroll
            for (int r = 0; r < 16; ++r) O[dt][r] = 0.f;
        float lrun = 0.f; f32x16 negm, s0, s1;
#pragma unroll
        for (int r = 0; r < 16; ++r) negm[r] = 0.f;
        asm volatile("s_waitcnt vmcnt(0) lgkmcnt(0)\n\ts_barrier" ::: "memory");
        if constexpr (m == 1) qk_tile<0>(kq, qf, negm, s0, s1);
#define DA_STEP(tt, KBC, KBN, KB3, VBC, VB2) do { \
            if ((tt) + 3 < NT) DA_DMA_K((tt) + 3, KB3); else DA_DMA_K(NT - 1, KB3); \
            if ((tt) + 2 < NT) DA_DMA_V((tt) + 2, VB2); else DA_DMA_V(NT - 1, VB2); \
            if constexpr (m == 0) { qk_tile<KBC>(kq, qf, negm, s0, s1); softmax_pv<VBC>(lds, vlane, s0, s1, O, negm, lrun); } \
            else { softmax_pv<VBC>(lds, vlane, s0, s1, O, negm, lrun); if ((tt) + 1 < NT) qk_tile<KBN>(kq, qf, negm, s0, s1); } \
            asm volatile("s_waitcnt vmcnt(4) lgkmcnt(0)\n\ts_barrier" ::: "memory"); } while (0)
        for (int t = 0; t < NT; t += 12) {
            DA_STEP(t + 0, 0, 16384, 49152, 65536, 98304);
            DA_STEP(t + 1, 16384, 32768, 0, 81920, 65536);
            DA_STEP(t + 2, 32768, 49152, 16384, 98304, 81920);
            DA_STEP(t + 3, 49152, 0, 32768, 65536, 98304);
            DA_STEP(t + 4, 0, 16384, 49152, 81920, 65536);
            DA_STEP(t + 5, 16384, 32768, 0, 98304, 81920);
            DA_STEP(t + 6, 32768, 49152, 16384, 65536, 98304);
            DA_STEP(t + 7, 49152, 0, 32768, 81920, 65536);
            DA_STEP(t + 8, 0, 16384, 49152, 98304, 81920);
            DA_STEP(t + 9, 16384, 32768, 0, 65536, 98304);
            DA_STEP(t + 10, 32768, 49152, 16384, 81920, 65536);
            DA_STEP(t + 11, 49152, 0, 32768, 98304, 81920);
        }
#undef DA_STEP
        asm volatile("s_waitcnt vmcnt(0) lgkmcnt(0)\n\ts_barrier" ::: "memory");
        const float lt = lrun + __shfl_xor(lrun, 32);
        LAS float* xch = (LAS float*)(lds + qsub * 16384) + lane;
        if (m == 1) { const float sc = lam / lt;
#pragma unroll
            for (int dt = 0; dt < 4; ++dt)
#pragma unroll
                for (int r = 0; r < 16; ++r) xch[(dt * 16 + r) * 64] = O[dt][r] * sc; }
        __syncthreads();
        if (m == 0) { const float i1 = 1.0f / lt; float ss = 0.f;
#pragma unroll
            for (int dt = 0; dt < 4; ++dt)
#pragma unroll
                for (int r = 0; r < 16; ++r) { const float a = O[dt][r] * i1 - xch[(dt * 16 + r) * 64]; O[dt][r] = a; ss += a * a; }
            ss += __shfl_xor(ss, 32);
            const float rstd = rsqrtf(ss * (1.0f / 128.0f) + NORM_EPS) * (1.0f - LAMBDA_INIT);
            bf16* orow = MIX + qrow * 1024 + h * 128;
#pragma unroll
            for (int dt = 0; dt < 4; ++dt)
#pragma unroll
                for (int g4 = 0; g4 < 4; ++g4) { const int d0 = 32 * dt + 8 * g4 + 4 * hi; const f32x4 gg = *(const f32x4*)(c.da_subln_g + d0);
                    u32x2 w; w.x = cvtpk(O[dt][4 * g4] * rstd * gg.x, O[dt][4 * g4 + 1] * rstd * gg.y); w.y = cvtpk(O[dt][4 * g4 + 2] * rstd * gg.z, O[dt][4 * g4 + 3] * rstd * gg.w);
                    *(u32x2*)(orow + d0) = w; } }
        __syncthreads();
#undef DA_DMA_K
#undef DA_DMA_V
    }
}
__device__ __forceinline__ void attn_phase(const Ctx& c, LAS unsigned char* lds) {
    if (__builtin_amdgcn_readfirstlane((int)threadIdx.x >> 8) == 0) attn_body<0>(c, lds); else attn_body<1>(c, lds);
}
#undef DA_MFMA
}

namespace gla {
using da::bf16x8; using da::s16x4; using da::f32x16; using da::cvtpk; using da::pack_half; using da::vtr;
#define GL_MFMA(a, b, c) __builtin_amdgcn_mfma_f32_32x32x16_bf16((a), (b), (c), 0, 0, 0)
constexpr int NTASK = NB * 4 * 2 * 36;
constexpr int PT64_BYTES = 8192;
constexpr int PTV_BYTES = 16384;

template <int CTRL, int RM, bool BC> __device__ __forceinline__ float dpp_get(float x) { return __builtin_bit_cast(float, __builtin_amdgcn_update_dpp(0, __builtin_bit_cast(int, x), CTRL, RM, 0xf, BC)); }
__device__ __forceinline__ float scan32(float x) {
    x += dpp_get<0x111, 0xf, true>(x); x += dpp_get<0x112, 0xf, true>(x); x += dpp_get<0x114, 0xf, true>(x); x += dpp_get<0x118, 0xf, true>(x);
    x += dpp_get<0x142, 0xa, false>(x);
    return x; }
__device__ __forceinline__ float last32(float x, int hi) {
    const float a = __builtin_bit_cast(float, __builtin_amdgcn_readlane(__builtin_bit_cast(int, x), 31)), b = __builtin_bit_cast(float, __builtin_amdgcn_readlane(__builtin_bit_cast(int, x), 63));
    return hi ? b : a; }
template <int DK0, int DK1> __device__ __forceinline__ void g0_task(const Ctx& c, const LAS unsigned char* w2f, const LAS float* gbs, int u, int lane, int r32, int hi) {
    bf16* KE = (bf16*)(c.ws + WS_KEND); bf16* QD = (bf16*)(c.ws + WS_QD); bf16* KI = (bf16*)(c.ws + WS_KI); float* DB = (float*)(c.ws + WS_DB);
        const int cc = u % 36, chain = u / 36, dir = chain & 1, h = (chain >> 1) & 3, b = chain >> 3, bh = chain >> 1;
        const bool lat = cc >= 4;
        const size_t row0 = (size_t)b * KVL + cc * 64 + r32;
        bf16x8 lrh[2], lrl[2];
#pragma unroll
        for (int T = 0; T < 2; ++T) { const float* lr = (const float*)(c.ws + WS_LR) + (row0 + 32 * T) * 32 + dir * 16 + 8 * hi;
            const f32x4 x0 = *(const f32x4*)lr, x1 = *(const f32x4*)(lr + 4);
            u32x4 ph; ph.x = pk2(x0.x, x0.y); ph.y = pk2(x0.z, x0.w); ph.z = pk2(x1.x, x1.y); ph.w = pk2(x1.z, x1.w);
            u32x4 pl; pl.x = pk2(x0.x - bflo(ph.x), x0.y - bfhi(ph.x)); pl.y = pk2(x0.z - bflo(ph.y), x0.w - bfhi(ph.y)); pl.z = pk2(x1.x - bflo(ph.z), x1.y - bfhi(ph.z)); pl.w = pk2(x1.z - bflo(ph.w), x1.w - bfhi(ph.w));
            lrh[T] = __builtin_bit_cast(bf16x8, ph); lrl[T] = __builtin_bit_cast(bf16x8, pl); }
        const bf16* kbase = (const bf16*)(c.ws + WS_GK) + row0 * 256 + h * 64;
        const bf16* qbase = (const bf16*)(c.ws + WS_GQ) + ((size_t)b * SEQ + (lat ? (cc - 4) * 64 + r32 : 0)) * 256 + h * 64;
        bf16* kebase = KE + ((size_t)u * 64 + r32) * 64;
        const size_t qo = (((size_t)(dir * 64 + bh) * 32 + (lat ? cc - 4 : 0)) * 64 + r32) * 64;
#pragma unroll
        for (int Dk = DK0; Dk < DK1; ++Dk) {
            const LAS unsigned char* wf = w2f + (((dir * 4 + h) * 2 + Dk) * 64 + lane) * 32;
            const bf16x8 wh = *(const LAS bf16x8*)wf, wl = *(const LAS bf16x8*)(wf + 16);
            f32x16 z[2];
#pragma unroll
            for (int T = 0; T < 2; ++T) {
#pragma unroll
                for (int r = 0; r < 16; ++r) z[T][r] = 0.f;
                z[T] = GL_MFMA(wh, lrh[T], z[T]); z[T] = GL_MFMA(wl, lrh[T], z[T]); z[T] = GL_MFMA(wh, lrl[T], z[T]); }
            u32x2 kv[2][4], qv[2][4];
#pragma unroll
            for (int T = 0; T < 2; ++T)
#pragma unroll
                for (int g4 = 0; g4 < 4; ++g4) { const int dko = 32 * Dk + 8 * g4 + 4 * hi; kv[T][g4] = *(const u32x2*)(kbase + (size_t)(32 * T) * 256 + dko); qv[T][g4] = *(const u32x2*)(qbase + (size_t)(lat ? 32 * T : 0) * 256 + dko); }
            float g[2][16], inc[2][16], dtot[16], tot[16];
#pragma unroll
            for (int g4 = 0; g4 < 4; ++g4) { const f32x4 bs = *(const LAS f32x4*)(gbs + dir * 256 + h * 64 + 32 * Dk + 8 * g4 + 4 * hi);
#pragma unroll
                for (int j = 0; j < 4; ++j)
#pragma unroll
                    for (int T = 0; T < 2; ++T) { const float zz = z[T][4 * g4 + j] + bs[j];
                        const float t = __builtin_amdgcn_exp2f(-fabsf(zz) * 1.4426950408889634f);
                        g[T][4 * g4 + j] = (fminf(zz, 0.f) - __builtin_amdgcn_logf(1.0f + t) * 0.6931471805599453f) * (1.0f / 16.0f); } }
#pragma unroll
            for (int r = 0; r < 16; ++r) { inc[0][r] = scan32(g[0][r]); const float l0 = last32(inc[0][r], hi); inc[1][r] = scan32(g[1][r]) + l0; tot[r] = last32(inc[1][r], hi); dtot[r] = __builtin_amdgcn_exp2f(tot[r] * 1.4426950408889634f); }
#pragma unroll
            for (int T = 0; T < 2; ++T)
#pragma unroll
                for (int g4 = 0; g4 < 4; ++g4) { const int dko = 32 * Dk + 8 * g4 + 4 * hi;
                    float eq[4], ek[4], ee[4];
#pragma unroll
                    for (int j = 0; j < 4; ++j) { const int r = 4 * g4 + j; const float bc = dir == 0 ? inc[T][r] : tot[r] - inc[T][r] + g[T][r];
                        eq[j] = __builtin_amdgcn_exp2f(bc * 1.4426950408889634f); ek[j] = __builtin_amdgcn_rcpf(eq[j]); ee[j] = ek[j] * dtot[r]; }
                    const float k0 = bflo(kv[T][g4].x), k1 = bfhi(kv[T][g4].x), k2 = bflo(kv[T][g4].y), k3 = bfhi(kv[T][g4].y);
                    u32x2 e2; e2.x = cvtpk(k0 * ee[0], k1 * ee[1]); e2.y = cvtpk(k2 * ee[2], k3 * ee[3]);
                    *(u32x2*)(kebase + (size_t)(32 * T) * 64 + dko) = e2;
                    if (lat) { const float q0 = bflo(qv[T][g4].x), q1 = bfhi(qv[T][g4].x), q2 = bflo(qv[T][g4].y), q3 = bfhi(qv[T][g4].y);
                        u32x2 a2, k2v; a2.x = cvtpk(q0 * eq[0], q1 * eq[1]); a2.y = cvtpk(q2 * eq[2], q3 * eq[3]); k2v.x = cvtpk(k0 * ek[0], k1 * ek[1]); k2v.y = cvtpk(k2 * ek[2], k3 * ek[3]);
                        *(u32x2*)(QD + qo + (size_t)(32 * T) * 64 + dko) = a2; *(u32x2*)(KI + qo + (size_t)(32 * T) * 64 + dko) = k2v; } }
            if (r32 == 0) {
#pragma unroll
                for (int g4 = 0; g4 < 4; ++g4) *(f32x4*)(DB + (size_t)u * 64 + 32 * Dk + 8 * g4 + 4 * hi) = (f32x4){dtot[4 * g4], dtot[4 * g4 + 1], dtot[4 * g4 + 2], dtot[4 * g4 + 3]}; }
        }
    }
__device__ __forceinline__ void g0_phase(const Ctx& c, LAS unsigned char* lds) {
    const int tid = threadIdx.x, lane = tid & 63, w = __builtin_amdgcn_readfirstlane(tid >> 6), r32 = lane & 31, hi = lane >> 5;
    LAS unsigned char* w2f = lds;
    LAS float* gbs = (LAS float*)(lds + 32768);
    for (int q = tid; q < 16 * 64; q += 512) { const int combo = q >> 6, l = q & 63, dir = combo >> 3, h = (combo >> 1) & 3, Dk = combo & 1, dk = h * 64 + 32 * Dk + (l & 31), hh = l >> 5;
        float v[8];
#pragma unroll
        for (int j = 0; j < 8; ++j) v[j] = c.gate_w2[(dir * 16 + 8 * hh + j) * 256 + dk];
        u32x4 ph; ph.x = pk2(v[0], v[1]); ph.y = pk2(v[2], v[3]); ph.z = pk2(v[4], v[5]); ph.w = pk2(v[6], v[7]);
        u32x4 pl; pl.x = pk2(v[0] - bflo(ph.x), v[1] - bfhi(ph.x)); pl.y = pk2(v[2] - bflo(ph.y), v[3] - bfhi(ph.y)); pl.z = pk2(v[4] - bflo(ph.z), v[5] - bfhi(ph.z)); pl.w = pk2(v[6] - bflo(ph.w), v[7] - bfhi(ph.w));
        *(LAS u32x4*)(w2f + q * 32) = ph; *(LAS u32x4*)(w2f + q * 32 + 16) = pl; }
    if (tid < 128) *(LAS f32x4*)(gbs + 4 * tid) = *(const f32x4*)(c.gate_b + 4 * tid);
    __syncthreads();
    const int gwv = blockIdx.x * 8 + w, ngw = gridDim.x * 8, nfull = (NTASK / ngw) * ngw;
    for (int u = gwv; u < nfull; u += ngw) g0_task<0, 2>(c, w2f, gbs, u, lane, r32, hi);
    for (int uh = gwv; uh < 2 * (NTASK - nfull); uh += ngw) { if (uh & 1) g0_task<1, 2>(c, w2f, gbs, nfull + (uh >> 1), lane, r32, hi); else g0_task<0, 1>(c, w2f, gbs, nfull + (uh >> 1), lane, r32, hi); }
    __syncthreads();
}
__device__ __forceinline__ void dma_piece(const bf16* base, int pitch, int p, LAS unsigned char* dst, int lane) {
    __builtin_amdgcn_global_load_lds((const unsigned*)(base + (size_t)((p & 3) * 16 + (lane >> 2)) * pitch + (p >> 2) * 32 + (lane & 3) * 8), (LAS unsigned*)(dst + p * 1024), 16, 0, 0);
}
__device__ __forceinline__ void dma_chunk(const bf16* tile, int row0, int ch, LAS unsigned char* dst, int lane) {
    __builtin_amdgcn_global_load_lds((const unsigned*)(tile + (size_t)(row0 + lane) * 64 + ch * 8), (LAS unsigned*)dst, 16, 0, 0);
}
__device__ __forceinline__ void g1_phase(const Ctx& c, LAS unsigned char* lds) {
    const int tid = threadIdx.x, lane = tid & 63, w = __builtin_amdgcn_readfirstlane(tid >> 6), hi = lane >> 5, dir = w >> 2, dvt = w & 3;
    const int vlane = (4 * hi + ((lane & 15) >> 2)) * 64 + ((lane >> 4) & 1) * 32 + (lane & 3) * 8;
    const bf16* KE = (const bf16*)(c.ws + WS_KEND); const bf16* GV = (const bf16*)(c.ws + WS_GV); bf16* UT = (bf16*)(c.ws + WS_UT);
    constexpr int BUF = 32768;
    const int nun = NB * 4 * 36;
#define G1_STAGE(un, bo) do { const int _cc = (un) % 36, _bh = (un) / 36, _b = _bh >> 2, _h = _bh & 3; \
        dma_piece(GV + ((size_t)_b * KVL + _cc * 64) * 512 + _h * 128, 512, w * 2, lds + (bo), lane); dma_piece(GV + ((size_t)_b * KVL + _cc * 64) * 512 + _h * 128, 512, w * 2 + 1, lds + (bo), lane); \
        dma_piece(KE + ((size_t)(_bh * 2) * 36 + _cc) * 4096, 64, w, lds + (bo) + 16384, lane); dma_piece(KE + ((size_t)(_bh * 2 + 1) * 36 + _cc) * 4096, 64, w, lds + (bo) + 24576, lane); } while (0)
    int un = blockIdx.x, par = 0;
    if (un < nun) G1_STAGE(un, 0);
    asm volatile("s_waitcnt vmcnt(0)" ::: "memory"); __syncthreads();
    for (; un < nun; un += gridDim.x, par ^= 1) {
        const int bo = par * BUF, nx = un + (int)gridDim.x;
        if (nx < nun) G1_STAGE(nx, BUF - bo);
        const int cc = un % 36, bh = un / 36;
        const LAS unsigned char* vpt = lds + bo; const LAS unsigned char* kend = lds + bo + 16384 + dir * 8192;
        f32x16 U[2];
#pragma unroll
        for (int dkt = 0; dkt < 2; ++dkt)
#pragma unroll
            for (int r = 0; r < 16; ++r) U[dkt][r] = 0.f;
#pragma unroll
        for (int ks = 0; ks < 4; ++ks) {
            const LAS unsigned char* bp = vpt + (dvt * 4 + ks) * 1024 + vlane; const s16x4 b0 = vtr(bp), b1 = vtr(bp + 512);
            const bf16x8 bfr = __builtin_shufflevector(b0, b1, 0, 1, 2, 3, 4, 5, 6, 7);
#pragma unroll
            for (int dkt = 0; dkt < 2; ++dkt) { const LAS unsigned char* ap = kend + (dkt * 4 + ks) * 1024 + vlane; const s16x4 a0 = vtr(ap), a1 = vtr(ap + 512);
                U[dkt] = GL_MFMA(__builtin_shufflevector(a0, a1, 0, 1, 2, 3, 4, 5, 6, 7), bfr, U[dkt]); } }
        const size_t task = ((size_t)(bh * 2 + dir)) * 36 + cc;
#pragma unroll
        for (int dkt = 0; dkt < 2; ++dkt) { bf16* up = UT + task * 8192 + (size_t)(dvt * 32 + (lane & 31)) * 64 + dkt * 32 + 4 * hi;
#pragma unroll
            for (int g4 = 0; g4 < 4; ++g4) { u32x2 wv; wv.x = cvtpk(U[dkt][4 * g4], U[dkt][4 * g4 + 1]); wv.y = cvtpk(U[dkt][4 * g4 + 2], U[dkt][4 * g4 + 3]); *(u32x2*)(up + 8 * g4) = wv; } }
        asm volatile("s_waitcnt vmcnt(0)" ::: "memory"); __syncthreads();
    }
#undef G1_STAGE
}
__device__ __forceinline__ void g2_phase(const Ctx& c) {
    const bf16* UT = (const bf16*)(c.ws + WS_UT); const float* DB = (const float*)(c.ws + WS_DB); bf16* ST = (bf16*)(c.ws + WS_ST);
    for (int i = blockIdx.x * blockDim.x + threadIdx.x; i < 128 * 1024; i += gridDim.x * blockDim.x) {
        const int chain = i >> 10, e8 = i & 1023, dk0 = (e8 & 7) * 8, dir = chain & 1, bh = chain >> 1;
        float S[8];
#pragma unroll
        for (int j = 0; j < 8; ++j) S[j] = 0.f;
        u32x4 ua[6], ub[6]; f32x4 da[6][2], db[6][2];
#define G2_CC(s) (dir == 0 ? (s) : ((s) < 4 ? 3 - (s) : 39 - (s)))
#define G2_LOAD(U, D, blk) _Pragma("unroll") for (int j = 0; j < 6; ++j) { const size_t u = (size_t)chain * 36 + G2_CC((blk) * 6 + j); \
            U[j] = *(const u32x4*)(UT + u * 8192 + (size_t)e8 * 8); D[j][0] = *(const f32x4*)(DB + u * 64 + dk0); D[j][1] = *(const f32x4*)(DB + u * 64 + dk0 + 4); }
#define G2_PROC(U, D, blk) _Pragma("unroll") for (int j = 0; j < 6; ++j) { const int cc = G2_CC((blk) * 6 + j); \
            if (cc >= 4) { u32x4 o; o.x = cvtpk(S[0], S[1]); o.y = cvtpk(S[2], S[3]); o.z = cvtpk(S[4], S[5]); o.w = cvtpk(S[6], S[7]); \
                *(u32x4*)(ST + ((size_t)(dir * 64 + bh) * 32 + (cc - 4)) * 8192 + (size_t)e8 * 8) = o; } \
            S[0] = S[0] * D[j][0].x + bflo(U[j].x); S[1] = S[1] * D[j][0].y + bfhi(U[j].x); S[2] = S[2] * D[j][0].z + bflo(U[j].y); S[3] = S[3] * D[j][0].w + bfhi(U[j].y); \
            S[4] = S[4] * D[j][1].x + bflo(U[j].z); S[5] = S[5] * D[j][1].y + bfhi(U[j].z); S[6] = S[6] * D[j][1].z + bflo(U[j].w); S[7] = S[7] * D[j][1].w + bfhi(U[j].w); }
        G2_LOAD(ua, da, 0)
        G2_LOAD(ub, db, 1) G2_PROC(ua, da, 0)
        G2_LOAD(ua, da, 2) G2_PROC(ub, db, 1)
        G2_LOAD(ub, db, 3) G2_PROC(ua, da, 2)
        G2_LOAD(ua, da, 4) G2_PROC(ub, db, 3)
        G2_LOAD(ub, db, 5) G2_PROC(ua, da, 4)
        G2_PROC(ub, db, 5)
#undef G2_CC
#undef G2_LOAD
#undef G2_PROC
    }
}
__device__ __forceinline__ void g3_phase(const Ctx& c, LAS unsigned char* lds) {
    const int tid = threadIdx.x, lane = tid & 63, w = __builtin_amdgcn_readfirstlane(tid >> 6), r32 = lane & 31, hi = lane >> 5, ih = w >> 2, dq = w & 3;
    const int vlane = (4 * hi + ((lane & 15) >> 2)) * 64 + ((lane >> 4) & 1) * 32 + (lane & 3) * 8;
    const bf16* ST = (const bf16*)(c.ws + WS_ST); const bf16* GR = (const bf16*)(c.ws + WS_GR); const bf16* GV = (const bf16*)(c.ws + WS_GV); bf16* MIX = (bf16*)(c.ws + WS_MIX);
    const bf16* QD = (const bf16*)(c.ws + WS_QD); const bf16* KI = (const bf16*)(c.ws + WS_KI);
    constexpr int BUF = 49152;
    LAS float* ssx = (LAS float*)(lds + 2 * BUF);
    const int nun = NB * 4 * 32;
#define G3_STAGE(un, bo) do { const int _cl = (un) & 31, _bh = (un) >> 5, _b = _bh >> 2, _h = _bh & 3; \
        dma_piece(GV + ((size_t)_b * KVL + (_cl + 4) * 64) * 512 + _h * 128, 512, w * 2, lds + (bo), lane); dma_piece(GV + ((size_t)_b * KVL + (_cl + 4) * 64) * 512 + _h * 128, 512, w * 2 + 1, lds + (bo), lane); \
        _Pragma("unroll") for (int _d = 0; _d < 2; ++_d) { const size_t _tb = ((size_t)(_d * 64 + _bh) * 32 + _cl) * 4096; \
            dma_chunk(QD + _tb, 0, w, lds + (bo) + 16384 + _d * 8192 + w * 1024, lane); dma_chunk(KI + _tb, 0, w, lds + (bo) + 32768 + _d * 8192 + w * 1024, lane); } } while (0)
#define G3_LOADS(u_, sa_, gr_) do { const int _cl = (u_) & 31, _bh = (u_) >> 5, _b = _bh >> 2, _h = _bh & 3; const size_t _tl = (size_t)_b * SEQ + _cl * 64 + ih * 32 + r32; \
        _Pragma("unroll") for (int _d = 0; _d < 2; ++_d) _Pragma("unroll") for (int _k = 0; _k < 4; ++_k) sa_[_d][_k] = *(const bf16x8*)(ST + ((size_t)(_d * 64 + _bh) * 32 + _cl) * 8192 + (size_t)(dq * 32 + r32) * 64 + _k * 16 + hi * 8); \
        _Pragma("unroll") for (int _g = 0; _g < 4; ++_g) gr_[_g] = *(const u32x2*)(GR + _tl * 512 + _h * 128 + dq * 32 + 8 * _g + 4 * hi); } while (0)
    int un = blockIdx.x, par = 0;
    bf16x8 sa[2][4], san[2][4]; u32x2 gr[4], grn[4];
    if (un < nun) { G3_LOADS(un, sa, gr); G3_STAGE(un, 0); }
    asm volatile("s_waitcnt vmcnt(0)" ::: "memory"); __syncthreads();
    for (; un < nun; un += gridDim.x, par ^= 1) {
        const int bo = par * BUF, nx = un + (int)gridDim.x;
        const int cl = un & 31, bh = un >> 5, b = bh >> 2, h = bh & 3;
        const size_t tl = (size_t)b * SEQ + cl * 64 + ih * 32 + r32;
        if (nx < nun) { G3_LOADS(nx, san, grn); G3_STAGE(nx, BUF - bo); }
        const LAS unsigned char* vpt = lds + bo; const LAS unsigned char* qimg = lds + bo + 16384; const LAS unsigned char* kimg = lds + bo + 32768;
        f32x16 At[2];
#pragma unroll
        for (int jt = 0; jt < 2; ++jt)
#pragma unroll
            for (int r = 0; r < 16; ++r) At[jt][r] = 0.f;
        bf16x8 qf[2][4];
#pragma unroll
        for (int dir = 0; dir < 2; ++dir) {
#pragma unroll
            for (int ks = 0; ks < 4; ++ks) qf[dir][ks] = *(const LAS bf16x8*)(qimg + dir * 8192 + (2 * ks + hi) * 1024 + (ih * 32 + r32) * 16);
#pragma unroll
            for (int jt = 0; jt < 2; ++jt) { f32x16 T;
#pragma unroll
                for (int r = 0; r < 16; ++r) T[r] = 0.f;
#pragma unroll
                for (int ks = 0; ks < 4; ++ks) { const bf16x8 a = *(const LAS bf16x8*)(kimg + dir * 8192 + (2 * ks + hi) * 1024 + (jt * 32 + r32) * 16); T = GL_MFMA(a, qf[dir][ks], T); }
                const int icol = ih * 32 + r32;
#pragma unroll
                for (int r = 0; r < 16; ++r) { const int j = jt * 32 + (r & 3) + 8 * (r >> 2) + 4 * hi; const bool keep = dir == 0 ? (j <= icol) : (j >= icol); At[jt][r] += keep ? T[r] : 0.f; } }
        }
        bf16x8 P[4];
        P[0] = pack_half(At[0], 0); P[1] = pack_half(At[0], 1); P[2] = pack_half(At[1], 0); P[3] = pack_half(At[1], 1);
        f32x16 O;
#pragma unroll
        for (int r = 0; r < 16; ++r) O[r] = 0.f;
#pragma unroll
        for (int ks = 0; ks < 4; ++ks) { const LAS unsigned char* vp = vpt + (dq * 4 + ks) * 1024 + vlane; const s16x4 lo = vtr(vp), hh = vtr(vp + 512);
            O = GL_MFMA(__builtin_shufflevector(lo, hh, 0, 1, 2, 3, 4, 5, 6, 7), P[ks], O); }
#pragma unroll
        for (int dir = 0; dir < 2; ++dir)
#pragma unroll
            for (int ks = 0; ks < 4; ++ks) O = GL_MFMA(sa[dir][ks], qf[dir][ks], O);
        float ss = 0.f;
#pragma unroll
        for (int r = 0; r < 16; ++r) ss += O[r] * O[r];
        ss += __shfl_xor(ss, 32);
        if (hi == 0) ssx[dq * 64 + ih * 32 + r32] = ss;
        __syncthreads();
        const int tokl = ih * 32 + r32; const float tot = ssx[tokl] + ssx[64 + tokl] + ssx[128 + tokl] + ssx[192 + tokl];
        const float rstd = rsqrtf(tot * (1.0f / 128.0f) + NORM_EPS);
#pragma unroll
        for (int g4 = 0; g4 < 4; ++g4) { const int dv = dq * 32 + 8 * g4 + 4 * hi; const f32x4 gn = *(const f32x4*)(c.gla_norm_g + dv);
            u32x2 wv; wv.x = cvtpk(O[4 * g4] * rstd * gn.x * silu_f(bflo(gr[g4].x)), O[4 * g4 + 1] * rstd * gn.y * silu_f(bfhi(gr[g4].x)));
            wv.y = cvtpk(O[4 * g4 + 2] * rstd * gn.z * silu_f(bflo(gr[g4].y)), O[4 * g4 + 3] * rstd * gn.w * silu_f(bfhi(gr[g4].y)));
            *(u32x2*)(MIX + tl * 1024 + 512 + h * 128 + dv) = wv; }
        asm volatile("s_waitcnt vmcnt(0)" ::: "memory"); __syncthreads();
#pragma unroll
        for (int d = 0; d < 2; ++d)
#pragma unroll
            for (int k = 0; k < 4; ++k) sa[d][k] = san[d][k];
#pragma unroll
        for (int g4 = 0; g4 < 4; ++g4) gr[g4] = grn[g4];
    }
#undef G3_STAGE
#undef G3_LOADS
}
#undef GL_MFMA
}

template <bool DRY> __device__ __forceinline__ void ph_router(const Ctx& c, LAS unsigned char* lds) {
    typedef short bf16x8 __attribute__((ext_vector_type(8)));
    const int tid = threadIdx.x, lane = tid & 63, wave = tid >> 6, tk = lane & 15, kg = lane >> 4;
    const float* MOD = (const float*)(c.ws + WS_MOD); const bf16* X1 = (const bf16*)(c.ws + WS_X1); bf16* H2 = (bf16*)(c.ws + WS_H2);
    const bf16* WRT = (const bf16*)(c.ws + WS_WRT);
    int* ROUTE = (int*)(c.ws + WS_ROUTE); int* LIST = (int*)(c.ws + WS_LIST); unsigned* ctl = (unsigned*)(c.ws + WS_CTL);
    constexpr int WROW = 1040, WHALF = 36 * WROW;
    LAS unsigned char* whi = lds; LAS unsigned char* wlo = lds + WHALF;
    LAS int* bcnt = (LAS int*)(lds + 2 * WHALF);
    LAS int* rt = bcnt + 64;
    for (int base = blockIdx.x * 128; base < NTOK; base += gridDim.x * 128) {
        if (tid < 32) bcnt[tid] = 0;
        const int lt = wave * 16 + tk, tok = base + lt, bb = tok / SEQ;
        const bf16* xr = X1 + (size_t)tok * DM + 8 * kg; const float* gp = c.g_ffn + 8 * kg; const float* scp = MOD + bb * 6144 + 4096 + 8 * kg; const float* shp = MOD + bb * 6144 + 3072 + 8 * kg;
        f32x4 acc[3];
#pragma unroll
        for (int ct = 0; ct < 3; ++ct) acc[ct] = (f32x4){0.f, 0.f, 0.f, 0.f};
        const int arow0 = tk, arow1 = 16 + tk, arow2 = (32 + tk) < 36 ? 32 + tk : 35;
        float rstd; { const float* sp = (const float*)(c.ws + WS_SSP) + (size_t)tok * 16; const f32x4 p0 = *(const f32x4*)sp, p1 = *(const f32x4*)(sp + 4), p2 = *(const f32x4*)(sp + 8), p3 = *(const f32x4*)(sp + 12);
            const float ss = (((p0.x + p0.y) + (p0.z + p0.w)) + ((p1.x + p1.y) + (p1.z + p1.w))) + (((p2.x + p2.y) + (p2.z + p2.w)) + ((p3.x + p3.y) + (p3.z + p3.w)));
            rstd = rsqrtf(ss * (1.0f / DM) + NORM_EPS); }
        for (int kh = 0; kh < 2; ++kh) {
            __syncthreads();
            for (int q = tid; q < 2 * 36 * 64; q += 512) { const int which = q / 2304, r = (q % 2304) >> 6, ch = q & 63;
                *(LAS u32x4*)((which ? wlo : whi) + r * WROW + ch * 16) = *(const u32x4*)(WRT + (size_t)which * 36 * 1024 + r * 1024 + kh * 512 + ch * 8); }
            __syncthreads();
#pragma unroll 2
            for (int s = 0; s < 16; ++s) { const int ko = kh * 512 + 32 * s;
                const u32x4 xw = *(const u32x4*)(xr + ko); const f32x4 x0 = {bflo(xw.x), bfhi(xw.x), bflo(xw.y), bfhi(xw.y)}, x1 = {bflo(xw.z), bfhi(xw.z), bflo(xw.w), bfhi(xw.w)};
                const f32x4 g0 = *(const f32x4*)(gp + ko), g1 = *(const f32x4*)(gp + ko + 4), s0 = *(const f32x4*)(scp + ko), s1 = *(const f32x4*)(scp + ko + 4);
                const f32x4 h0 = *(const f32x4*)(shp + ko), h1 = *(const f32x4*)(shp + ko + 4);
                const f32x4 u0 = (x0 * rstd * g0) * (s0 + 1.0f) + h0, u1 = (x1 * rstd * g1) * (s1 + 1.0f) + h1;
                u32x4 hw; hw.x = pk2(u0.x, u0.y); hw.y = pk2(u0.z, u0.w); hw.z = pk2(u1.x, u1.y); hw.w = pk2(u1.z, u1.w);
                *(u32x4*)(H2 + (size_t)tok * DM + 8 * kg + ko) = hw;
                u32x4 lw; lw.x = pk2(u0.x - bflo(hw.x), u0.y - bfhi(hw.x)); lw.y = pk2(u0.z - bflo(hw.y), u0.w - bfhi(hw.y)); lw.z = pk2(u1.x - bflo(hw.z), u1.y - bfhi(hw.z)); lw.w = pk2(u1.z - bflo(hw.w), u1.w - bfhi(hw.w));
                const bf16x8 uh = __builtin_bit_cast(bf16x8, hw), ul = __builtin_bit_cast(bf16x8, lw);
                const int co = (32 * s + 8 * kg) * 2;
#pragma unroll
                for (int ct = 0; ct < 3; ++ct) { const int ar = ct == 0 ? arow0 : (ct == 1 ? arow1 : arow2);
                    const bf16x8 ah = *(const LAS bf16x8*)(whi + ar * WROW + co), al = *(const LAS bf16x8*)(wlo + ar * WROW + co);
                    acc[ct] = __builtin_amdgcn_mfma_f32_16x16x32_bf16(ah, uh, acc[ct], 0, 0, 0);
                    acc[ct] = __builtin_amdgcn_mfma_f32_16x16x32_bf16(al, uh, acc[ct], 0, 0, 0);
                    acc[ct] = __builtin_amdgcn_mfma_f32_16x16x32_bf16(ah, ul, acc[ct], 0, 0, 0); }
            }
        }
        float gl[4];
#pragma unroll
        for (int j = 0; j < 4; ++j) gl[j] = __shfl(acc[2][j] + c.b_rg[j], tk);
        int gs = 0; float gm = gl[0];
#pragma unroll
        for (int n = 1; n < 4; ++n) if (gl[n] > gm) { gm = gl[n]; gs = n; }
        float gden = 0.f;
#pragma unroll
        for (int n = 0; n < 4; ++n) gden += expf(gl[n] - gm);
        const float gw_ = 1.0f / gden;
        float cand[4];
#pragma unroll
        for (int j = 0; j < 4; ++j) { const int n = 16 * (gs >> 1) + 4 * kg + j; cand[j] = ((gs >> 1) ? acc[1][j] : acc[0][j]) + c.b_re[n]; }
        float el[8]; const int srcl = tk + 32 * (gs & 1);
#pragma unroll
        for (int j = 0; j < 4; ++j) { el[j] = __shfl(cand[j], srcl); el[4 + j] = __shfl(cand[j], srcl + 16); }
        int i0 = 0; float v0 = el[0];
#pragma unroll
        for (int n = 1; n < 8; ++n) if (el[n] > v0) { v0 = el[n]; i0 = n; }
        int i1 = i0 == 0 ? 1 : 0; float v1 = i0 == 0 ? el[1] : el[0];
#pragma unroll
        for (int n = 1; n < 8; ++n) if (n != i0 && el[n] > v1) { v1 = el[n]; i1 = n; }
        const float e1 = expf(v1 - v0), den = 1.0f + e1; const float w0 = gw_ / den, w1 = gw_ * e1 / den;
        if (DRY) { asm volatile("" :: "v"(w0), "v"(w1), "v"(i0), "v"(i1)); }
        if (kg == 0 && !DRY) { const int e0g = gs * 8 + i0, e1g = gs * 8 + i1; const int r0 = atomicAdd((int*)&bcnt[e0g], 1), r1 = atomicAdd((int*)&bcnt[e1g], 1);
            LAS int* r = rt + lt * 6; r[0] = e0g; r[1] = e1g; r[2] = r0; r[3] = r1; r[4] = __builtin_bit_cast(int, w0); r[5] = __builtin_bit_cast(int, w1); }
        __syncthreads();
        if (DRY) continue;
        if (tid < 32) bcnt[32 + tid] = (int)__hip_atomic_fetch_add(ctl + CW_CNT + 64 * tid, (unsigned)bcnt[tid], __ATOMIC_RELAXED, __HIP_MEMORY_SCOPE_AGENT);
        __syncthreads();
        if (tid < 128) { const LAS int* r = rt + tid * 6; const int tk2 = base + tid; const int e0g = r[0], e1g = r[1], p0 = bcnt[32 + e0g] + r[2], p1 = bcnt[32 + e1g] + r[3];
            int* ro = ROUTE + (size_t)tk2 * 8; ro[0] = e0g; ro[1] = e1g; ro[2] = p0; ro[3] = p1; ro[4] = r[4]; ro[5] = r[5];
            LIST[e0g * NTOK + p0] = tk2; LIST[e1g * NTOK + p1] = tk2; }
        __syncthreads();
    }
}

__device__ __forceinline__ void ph_final(const Ctx& c, LAS unsigned char* lds) {
    const int tid = threadIdx.x, lane = tid & 63, wave = tid >> 6, nw = blockDim.x >> 6;
    const float* MOD = (const float*)(c.ws + WS_MOD); const bf16* X1 = (const bf16*)(c.ws + WS_X1); const bf16* YB = (const bf16*)(c.ws + WS_YB);
    const int* ROUTE = (const int*)(c.ws + WS_ROUTE);
    LAS int* mm = (LAS int*)lds; moe_build(mm, (const unsigned*)(c.ws + WS_CTL));
    f32x4 g[4];
#pragma unroll
    for (int q = 0; q < 4; ++q) g[q] = *(const f32x4*)(c.g_final + 4 * lane + 256 * q);
    for (int tok = blockIdx.x * nw + wave; tok < NTOK; tok += gridDim.x * nw) {
        const int bb = tok / SEQ; const float* gt = MOD + bb * 6144 + 5120; const int* ro = ROUTE + (size_t)tok * 8;
        const int e0 = ro[0], e1 = ro[1]; const size_t r0 = ((size_t)mm[32 + e0] << 8) + ro[2], r1 = ((size_t)mm[32 + e1] << 8) + ro[3];
        const float w0 = __builtin_bit_cast(float, ro[4]), w1 = __builtin_bit_cast(float, ro[5]);
        f32x4 v[4]; float ss = 0.f;
#pragma unroll
        for (int q = 0; q < 4; ++q) { const int col = 4 * lane + 256 * q; const u32x2 xw = *(const u32x2*)(X1 + (size_t)tok * DM + col); const f32x4 xv = {bflo(xw.x), bfhi(xw.x), bflo(xw.y), bfhi(xw.y)}, gv = *(const f32x4*)(gt + col);
            const u32x2 ya = *(const u32x2*)(YB + r0 * DM + col), yb = *(const u32x2*)(YB + r1 * DM + col);
            f32x4 y; y.x = w0 * bflo(ya.x) + w1 * bflo(yb.x); y.y = w0 * bfhi(ya.x) + w1 * bfhi(yb.x); y.z = w0 * bflo(ya.y) + w1 * bflo(yb.y); y.w = w0 * bfhi(ya.y) + w1 * bfhi(yb.y);
            v[q] = xv + gv * y; ss += (v[q].x * v[q].x + v[q].y * v[q].y) + (v[q].z * v[q].z + v[q].w * v[q].w); }
        const float rstd = rsqrtf(wave_sum(ss) * (1.0f / DM) + NORM_EPS);
#pragma unroll
        for (int q = 0; q < 4; ++q) *(f32x4*)(c.out + (size_t)tok * DM + 4 * lane + 256 * q) = v[q] * rstd * g[q];
    }
}

#define XB_TMO      128
#define XB_XCNT(j)  (256  + 64 * (j))
#define XB_XSUB(j)  (1280 + 64 * (j))
#define XB_XGEN(j)  (2304 + 64 * (j))
#define XB_TOP      3328
#define XB_TOPGEN   3392
#define XCD_BAR_WORDS 3456
#define XB_SPIN_CAP (1u << 18)

__device__ __forceinline__ unsigned xb_ld(unsigned* p)              { return __hip_atomic_load(p, __ATOMIC_RELAXED, __HIP_MEMORY_SCOPE_AGENT); }
__device__ __forceinline__ unsigned xb_add(unsigned* p, unsigned v) { return __hip_atomic_fetch_add(p, v, __ATOMIC_RELAXED, __HIP_MEMORY_SCOPE_AGENT); }
__device__ __forceinline__ unsigned xb_xcc_id() { return (unsigned)__builtin_amdgcn_s_getreg((3 << 11) | 20) & 0xFu; }
#define XB_SPIN(cond, bar) do { unsigned _sp = 0; while (cond) { __builtin_amdgcn_s_sleep(1); \
    if ((++_sp & 255u) == 0u) { if (xb_ld(&(bar)[XB_TMO])) break; if (_sp > XB_SPIN_CAP) { atomicAdd(&(bar)[XB_TMO], 1u); break; } } } } while (0)

struct XcdBarrier {
    unsigned* bar; unsigned x;
    volatile LAS unsigned* st;
};
__device__ __forceinline__ XcdBarrier xcd_barrier_post(unsigned* bar, volatile LAS unsigned* st) {
    XcdBarrier b; b.bar = bar; b.x = xb_xcc_id(); b.st = st;
    if (threadIdx.x == 0) (void)xb_add(&bar[XB_XCNT(b.x)], 1u);
    return b;
}
__device__ __forceinline__ void xcd_barrier_complete(unsigned* bar, unsigned x, unsigned& nloc, unsigned& nx) {
    const unsigned G = gridDim.x * gridDim.y * gridDim.z;
    unsigned sum, cnt, mine, sp = 0u;
    for (;;) {
        sum = 0u; cnt = 0u; mine = 0u;
#pragma unroll
        for (unsigned j = 0; j < 16; ++j) { const unsigned c = xb_ld(&bar[XB_XCNT(j)]); sum += c; cnt += (c > 0u) ? 1u : 0u; mine = (j == x) ? c : mine; }
        if (sum == G) break;
        __builtin_amdgcn_s_sleep(1);
        if ((++sp & 255u) == 0u) { if (xb_ld(&bar[XB_TMO])) break; if (sp > XB_SPIN_CAP) { atomicAdd(&bar[XB_TMO], 1u); break; } }
    }
    nloc = mine > 0u ? mine : 1u; nx = cnt > 0u ? cnt : 1u;
}
__device__ __forceinline__ void xcd_barrier(const XcdBarrier& b) {
    asm volatile("s_waitcnt vmcnt(0)" ::: "memory");
    __syncthreads();
    if (threadIdx.x == 0) {
        unsigned* bar = b.bar;
        __builtin_amdgcn_s_waitcnt(0);
        unsigned nloc = b.st[0], nx = b.st[1];
        if (nloc == 0u) { xcd_barrier_complete(bar, b.x, nloc, nx); b.st[0] = nloc; b.st[1] = nx; }
        const unsigned old = xb_add(&bar[XB_XSUB(b.x)], 1u);
        const unsigned gen = old / nloc;
        if (old + 1u == (gen + 1u) * nloc) {
            __builtin_amdgcn_fence(__ATOMIC_RELEASE, "agent");
            asm volatile("s_waitcnt vmcnt(0)" ::: "memory");
            const unsigned og = xb_add(&bar[XB_TOP], 1u);
            const unsigned tg = og / nx;
            if (og + 1u == (tg + 1u) * nx) xb_add(&bar[XB_TOPGEN], 1u);
            else XB_SPIN(xb_ld(&bar[XB_TOPGEN]) == tg, bar);
            __builtin_amdgcn_fence(__ATOMIC_ACQUIRE, "agent");
            xb_add(&bar[XB_XGEN(b.x)], 1u);
            asm volatile("s_waitcnt vmcnt(0)" ::: "memory");
        } else {
            XB_SPIN(xb_ld(&bar[XB_XGEN(b.x)]) == gen, bar);
            __builtin_amdgcn_fence(__ATOMIC_ACQUIRE, "agent");
            asm volatile("s_waitcnt vmcnt(0)" ::: "memory");
        }
    }
    __syncthreads();
}

#ifndef PROBE_MASK
#define PROBE_MASK 0
#endif
constexpr int LDS_BYTES = 147456;
constexpr int LDS_BARW_OFF = LDS_BYTES - 16;
__global__ void __launch_bounds__(512, 2) mega_fwd(Ctx c) {
    extern __shared__ __attribute__((aligned(16))) unsigned char lds_raw[];
    LAS unsigned char* lds = (LAS unsigned char*)lds_raw;
    if (threadIdx.x == 0) *(LAS u32x4*)(lds + LDS_BARW_OFF) = (u32x4){0u, 0u, 0u, 0u};
    __syncthreads();
    const XcdBarrier bar = xcd_barrier_post((unsigned*)(c.ws + WS_CTL) + CW_BAR, (volatile LAS unsigned*)(lds + LDS_BARW_OFF));
#define RUN(k, call) do { call; xcd_barrier(bar); if (PROBE_MASK & (1 << (k))) { call; xcd_barrier(bar); } } while (0)
    if (PROBE_MASK & (1 << 14)) { for (int i = 0; i < 8; ++i) xcd_barrier(bar); }
    RUN(0, ph_prologue(c, lds));
    RUN(1, ph_norm1(c));
    RUN(2, ph_inproj(c, lds));
    if (PROBE_MASK & (1 << 12)) gla::g0_phase(c, lds);
    if (PROBE_MASK & (1 << 13)) { da::attn_phase(c, lds); }
    RUN(3, (gla::g0_phase(c, lds), da::attn_phase(c, lds)));
    RUN(4, gla::g1_phase(c, lds));
    RUN(5, gla::g2_phase(c));
    RUN(6, gla::g3_phase(c, lds));
    RUN(7, ph_outproj(c, lds));
    if (PROBE_MASK & (1 << 8)) { ph_router<true>(c, lds); xcd_barrier(bar); }
    ph_router<false>(c, lds); xcd_barrier(bar);
    RUN(9, ph_gateup(c, lds));
    RUN(10, ph_down(c, lds));
    if (PROBE_MASK & (1 << 11)) { ph_final(c, lds); xcd_barrier(bar); }
    ph_final(c, lds);
}

extern "C" void kernel_launch(void* const* d_in, const int* in_sizes, int n_in, void* d_out, int out_size, void* d_ws, size_t ws_size, hipStream_t stream) {
    static int grid = 0;
    if (grid == 0) {
        if (n_in != 23 || in_sizes[0] != NTOK * DM || out_size != NTOK * DM || ws_size < WS_END) { fprintf(stderr, "kernel_launch: unexpected problem shape (n_in %d, in0 %d, out %d, ws %zu)\n", n_in, n_in > 0 ? in_sizes[0] : -1, out_size, ws_size); grid = -1; return; }
        int dev = 0, cus = 0, per_cu = 0;
        if (hipGetDevice(&dev) != hipSuccess || hipDeviceGetAttribute(&cus, hipDeviceAttributeMultiprocessorCount, dev) != hipSuccess) { grid = -1; return; }
        if (hipFuncSetAttribute((const void*)mega_fwd, hipFuncAttributeMaxDynamicSharedMemorySize, LDS_BYTES) != hipSuccess) { fprintf(stderr, "kernel_launch: hipFuncSetAttribute failed\n"); grid = -1; return; }
        if (hipOccupancyMaxActiveBlocksPerMultiprocessor(&per_cu, (const void*)mega_fwd, 512, LDS_BYTES) != hipSuccess || per_cu < 1) fprintf(stderr, "kernel_launch: occupancy query reports %d workgroups per CU\n", per_cu);
        (void)hipGetLastError();
        grid = cus;
    }
    if (grid < 0) return;
    Ctx c{};
    const float** f = (const float**)&c;
    for (int i = 0; i < 23; ++i) f[i] = (const float*)d_in[i];
    c.out = (float*)d_out; c.ws = (unsigned char*)d_ws;
    if (hipMemsetAsync((unsigned char*)d_ws + WS_CTL, 0, CTL_ZERO_BYTES, stream) != hipSuccess) return;
    hipLaunchKernelGGL(mega_fwd, dim3(grid), dim3(512), LDS_BYTES, stream, c);
}
```

```cpp
#include <hip/hip_runtime.h>
#include <cstdint>
#include <cstdio>

#define GAS __attribute__((address_space(1)))
#define LAS __attribute__((address_space(3)))
typedef unsigned short bf16;
typedef float f32x4 __attribute__((ext_vector_type(4)));
typedef float f32x2 __attribute__((ext_vector_type(2)));
typedef unsigned u32x4 __attribute__((ext_vector_type(4)));
typedef unsigned u32x2 __attribute__((ext_vector_type(2)));

constexpr int NB = 16, SEQ = 2048, DM = 1024, CTXL = 256, KVL = CTXL + SEQ;
constexpr int NTOK = NB * SEQ;
constexpr int NROW = NB * KVL;
constexpr int NPROJ = 3104, NPROJ_PAD = 3328;
constexpr int NEXP = 32, EHID = 512;
constexpr int MOE_ROWS_MAX = 73728;
constexpr float NORM_EPS = 1e-6f;
constexpr float LAMBDA_INIT = 0.2f;
constexpr float QSCALE = 0.125f * 1.4426950408889634f;

constexpr int C_DAQ = 0, C_DAK = 512, C_DAV = 1024, C_GQ = 1536, C_GK = 1792, C_GV = 2048, C_GR = 2560, C_LR = 3072;

constexpr size_t MiB = 1u << 20;
constexpr size_t WS_CTL = 0, CTL_ZERO_BYTES = 1 * MiB;
constexpr size_t WS_MOD = 1 * MiB;
constexpr size_t WS_ROPE = 1 * MiB + 512 * 1024;
constexpr size_t WS_WRT = 462 * MiB;
constexpr size_t WS_ROUTE = 2 * MiB;
constexpr size_t WS_LIST = 3 * MiB;
constexpr size_t WS_WIN_T = 7 * MiB;
constexpr size_t WS_WOUT_T = 14 * MiB;
constexpr size_t WS_WGU_T = 16 * MiB;
constexpr size_t WS_WD_T = 80 * MiB;
constexpr size_t WS_H = 112 * MiB;
constexpr size_t WS_HMID = 112 * MiB;
constexpr size_t WS_QDA = 184 * MiB;
constexpr size_t WS_KDA = 216 * MiB;
constexpr size_t WS_VDA = 252 * MiB;
constexpr size_t WS_GQ = 288 * MiB;
constexpr size_t WS_GK = 304 * MiB;
constexpr size_t WS_GV = 322 * MiB;
constexpr size_t WS_GR = 358 * MiB;
constexpr size_t WS_LR = 390 * MiB;
constexpr size_t WS_X1 = 184 * MiB;
constexpr size_t WS_H2 = 312 * MiB;
constexpr size_t WS_YB = 312 * MiB;
constexpr size_t WS_MIX = 112 * MiB;
constexpr size_t WS_UT = 184 * MiB;
constexpr size_t WS_ST = 256 * MiB;
constexpr size_t WS_QD = 395 * MiB;
constexpr size_t WS_KI = 427 * MiB;
constexpr size_t WS_KEND = 464 * MiB;
constexpr size_t WS_DB = 460 * MiB;
constexpr size_t WS_SSP = 500 * MiB;
constexpr size_t WS_END = 502 * MiB;

constexpr int CW_BAR = 4096;
constexpr int CW_CNT = 16384;

struct Ctx {
    const float *x, *c, *ctx, *c_ctx, *w_ada, *b_ada, *g_mix, *g_ffn, *w_in, *da_lambda, *da_subln_g, *gate_w2, *gate_b, *gla_norm_g, *w_out,
        *w_rg, *b_rg, *w_re, *b_re, *w_gate, *w_up, *w_down, *g_final;
    float* out; unsigned char* ws;
};

__device__ __forceinline__ unsigned f2bf(float f) { unsigned u = __builtin_bit_cast(unsigned, f); return (u + 0x7fffu + ((u >> 16) & 1u)) >> 16; }
typedef float f32x2_c __attribute__((ext_vector_type(2))); typedef __bf16 bf16x2_c __attribute__((ext_vector_type(2)));
__device__ __forceinline__ unsigned pk2(float lo, float hi) { f32x2_c v = {lo, hi}; bf16x2_c b = __builtin_convertvector(v, bf16x2_c); return __builtin_bit_cast(unsigned, b); }
__device__ __forceinline__ float bf2f(unsigned b) { return __builtin_bit_cast(float, b << 16); }
__device__ __forceinline__ float bflo(unsigned w) { return __builtin_bit_cast(float, w << 16); }
__device__ __forceinline__ float bfhi(unsigned w) { return __builtin_bit_cast(float, w & 0xffff0000u); }
template <int CTRL> __device__ __forceinline__ float dpp_f(float x) { return __builtin_bit_cast(float, __builtin_amdgcn_update_dpp(0, __builtin_bit_cast(int, x), CTRL, 0xf, 0xf, true)); }
__device__ __forceinline__ float wave_sum(float v) {
    v += dpp_f<0xB1>(v); v += dpp_f<0x4E>(v); v += dpp_f<0x141>(v); v += dpp_f<0x140>(v);
    const int iv = __builtin_bit_cast(int, v);
    return (__builtin_bit_cast(float, __builtin_amdgcn_readlane(iv, 0)) + __builtin_bit_cast(float, __builtin_amdgcn_readlane(iv, 16)))
         + (__builtin_bit_cast(float, __builtin_amdgcn_readlane(iv, 32)) + __builtin_bit_cast(float, __builtin_amdgcn_readlane(iv, 48)));
}
__device__ __forceinline__ float silu_f(float v) { return v * __builtin_amdgcn_rcpf(1.0f + __expf(-v)); }
#define LDS_WAIT() asm volatile("s_waitcnt lgkmcnt(0)" ::: "memory")

template <class RowMap>
__device__ __forceinline__ void transpose_item(const float* W, int ldw, int k0, int n0, bf16* WT, int KT, const RowMap& rm, LAS float* scr, int lane) {
    float v[32];
#pragma unroll
    for (int i = 0; i < 32; ++i) v[i] = W[(size_t)(k0 + 2 * i + (lane >> 5)) * ldw + n0 + (lane & 31)];
#pragma unroll
    for (int i = 0; i < 32; ++i) scr[(2 * i + (lane >> 5)) * 33 + (lane & 31)] = v[i];
    LDS_WAIT(); asm volatile("" ::: "memory");
    const int c = lane & 7;
#pragma unroll
    for (int j = 0; j < 4; ++j) { const int n = (lane >> 3) + 8 * j; const LAS float* s = scr + (8 * c) * 33 + n;
        u32x4 o; o.x = pk2(s[0 * 33], s[1 * 33]); o.y = pk2(s[2 * 33], s[3 * 33]); o.z = pk2(s[4 * 33], s[5 * 33]); o.w = pk2(s[6 * 33], s[7 * 33]);
        *(u32x4*)(WT + (size_t)rm(n0 + n) * KT + k0 + 8 * c) = o; }
    LDS_WAIT(); asm volatile("" ::: "memory");
}
struct TItem { const float* src; bf16* dst; int ldw, KT, n0, mode; };
__device__ __forceinline__ int titem_row(const TItem& t, int n) { const int a = t.n0 + n;
    return t.mode == 0 ? a : (t.mode == 1 ? (a & ~31) + (((a & 31) & 15) << 1) + ((a & 31) >> 4) : 8 * (a >> 2) + (a & 3) + 4 * (t.mode - 2)); }
__device__ __forceinline__ void titem_load(const TItem& t, float (&v)[32], int lane) {
#pragma unroll
    for (int i = 0; i < 32; ++i) v[i] = t.src[(size_t)(2 * i + (lane >> 5)) * t.ldw + (lane & 31)];
}
__device__ __forceinline__ void titem_store(const TItem& t, const float (&v)[32], LAS float* scr, int lane) {
#pragma unroll
    for (int i = 0; i < 32; ++i) scr[(2 * i + (lane >> 5)) * 33 + (lane & 31)] = v[i];
    LDS_WAIT(); asm volatile("" ::: "memory");
    const int c = lane & 7;
#pragma unroll
    for (int j = 0; j < 4; ++j) { const int n = (lane >> 3) + 8 * j; const LAS float* s = scr + (8 * c) * 33 + n;
        u32x4 o; o.x = pk2(s[0 * 33], s[1 * 33]); o.y = pk2(s[2 * 33], s[3 * 33]); o.z = pk2(s[4 * 33], s[5 * 33]); o.w = pk2(s[6 * 33], s[7 * 33]);
        *(u32x4*)(t.dst + (size_t)titem_row(t, n) * t.KT + 8 * c) = o; }
    LDS_WAIT(); asm volatile("" ::: "memory");
}
struct RowId { int off; __device__ __forceinline__ int operator()(int n) const { return off + n; } };
struct RowRope { __device__ __forceinline__ int operator()(int n) const { const int l = n & 31; return (n & ~31) + ((l & 15) << 1) + (l >> 4); } };
struct RowGU { int up; __device__ __forceinline__ int operator()(int n) const { return 8 * (n >> 2) + (n & 3) + 4 * up; } };

constexpr int I_IN = 16 * 97, I_OUT = 16 * 32, I_G = 32 * 16 * 16, I_U = I_G, I_D = 32 * 8 * 32;
constexpr int I_EARLY = I_IN + I_OUT, NITEMS = I_IN + I_OUT + I_G + I_U + I_D;
constexpr int I_PRO = I_EARLY + 8176;
__device__ __forceinline__ TItem decode_item(const Ctx& c, int it) {
    bf16* WIN_T = (bf16*)(c.ws + WS_WIN_T); bf16* WOUT_T = (bf16*)(c.ws + WS_WOUT_T); bf16* WGU_T = (bf16*)(c.ws + WS_WGU_T); bf16* WD_T = (bf16*)(c.ws + WS_WD_T);
    TItem t; int r = it;
    if (r < I_IN) { const int kb = r / 97, nb = r % 97, n0 = nb * 32; t.src = c.w_in + (size_t)(kb * 64) * NPROJ + n0; t.dst = WIN_T + kb * 64; t.ldw = NPROJ; t.KT = 1024; t.n0 = n0; t.mode = n0 < 1024 ? 1 : 0; return t; }
    r -= I_IN;
    if (r < I_OUT) { const int kb = r / 32, nb = r % 32; t.src = c.w_out + (size_t)(kb * 64) * 1024 + nb * 32; t.dst = WOUT_T + kb * 64; t.ldw = 1024; t.KT = 1024; t.n0 = nb * 32; t.mode = 0; return t; }
    r -= I_OUT;
    if (r < I_G + I_U) { const int up = r >= I_G; if (up) r -= I_G; const int e = r / 256, q = r % 256, kb = q / 16, nb = q % 16;
        t.src = (up ? c.w_up : c.w_gate) + (size_t)e * 1024 * 512 + (size_t)(kb * 64) * 512 + nb * 32; t.dst = WGU_T + (size_t)e * 1024 * 1024 + kb * 64; t.ldw = 512; t.KT = 1024; t.n0 = nb * 32; t.mode = 2 + up; return t; }
    r -= I_G + I_U;
    { const int e = r / 256, q = r % 256, kb = q / 32, nb = q % 32; t.src = c.w_down + (size_t)e * 512 * 1024 + (size_t)(kb * 64) * 1024 + nb * 32; t.dst = WD_T + (size_t)e * 1024 * 512 + kb * 64; t.ldw = 1024; t.KT = 512; t.n0 = nb * 32; t.mode = 0; return t; }
}
__device__ __forceinline__ void ph_prologue(const Ctx& c, LAS unsigned char* lds) {
    const int tid = threadIdx.x, lane = tid & 63, wave = __builtin_amdgcn_readfirstlane(tid >> 6), nw = blockDim.x >> 6;
    unsigned char* ws = c.ws;
    if (blockIdx.x < 96 && nw == 8) {
        LAS float* sv = (LAS float*)lds;
        LAS float* red = sv + 17 * 1024;
        const int col = blockIdx.x * 64 + lane;
        float cv[34];
#pragma unroll
        for (int j = 0; j < 34; ++j) cv[j] = j < 32 ? c.c[tid + 512 * j] : c.c_ctx[tid + 512 * (j - 32)];
        float w[128];
#pragma unroll
        for (int i = 0; i < 128; ++i) w[i] = c.w_ada[(size_t)(wave * 128 + i) * 6144 + col];
#pragma unroll
        for (int j = 0; j < 34; ++j) { const float v = cv[j]; sv[tid + 512 * j] = v / (1.0f + __expf(-v)); }
        __syncthreads();
        float acc[17];
#pragma unroll
        for (int r = 0; r < 17; ++r) acc[r] = 0.f;
#pragma unroll
        for (int k4 = 0; k4 < 32; ++k4) {
#pragma unroll
            for (int r = 0; r < 17; ++r) { const f32x4 s = *(const LAS f32x4*)(sv + r * 1024 + wave * 128 + 4 * k4);
                acc[r] += (s.x * w[4 * k4] + s.y * w[4 * k4 + 1]) + (s.z * w[4 * k4 + 2] + s.w * w[4 * k4 + 3]); } }
#pragma unroll
        for (int r = 0; r < 17; ++r) red[(wave * 17 + r) * 64 + lane] = acc[r];
        __syncthreads();
        float* MOD = (float*)(ws + WS_MOD);
        for (int i = tid; i < 17 * 64; i += 512) { const int r = i >> 6, l = i & 63; float s = 0.f;
            for (int w = 0; w < 8; ++w) s += red[(w * 17 + r) * 64 + l];
            MOD[r * 6144 + blockIdx.x * 64 + l] = s + c.b_ada[blockIdx.x * 64 + l]; }
        __syncthreads();
    }
    { f32x2* ROPE = (f32x2*)(ws + WS_ROPE);
      for (int i = blockIdx.x * blockDim.x + tid; i < 2048 * 32; i += gridDim.x * blockDim.x) {
          const int t = i >> 5, a = (i >> 4) & 1, f = i & 15; const float pos = (float)(a == 0 ? (t >> 6) : (t & 63));
          const float inv = exp2f(-(float)f * (13.287712379549449f / 16.0f));
          const float ang = pos * inv; f32x2 cs; cs.x = __cosf(ang); cs.y = __sinf(ang); ROPE[i] = cs; } }
    { bf16* WRT = (bf16*)(ws + WS_WRT);
      for (int i = blockIdx.x * blockDim.x + tid; i < 36 * 1024; i += gridDim.x * blockDim.x) { const int n = i >> 10, k = i & 1023;
          const float wv = n < 32 ? c.w_re[k * 32 + n] : c.w_rg[k * 4 + (n - 32)]; const unsigned h = f2bf(wv); WRT[i] = (bf16)h; WRT[36 * 1024 + i] = (bf16)f2bf(wv - bf2f(h)); } }
    { u32x4* z = (u32x4*)(ws + WS_WIN_T + (size_t)NPROJ * 1024 * 2); const int n16 = (NPROJ_PAD - NPROJ) * 1024 * 2 / 16;
      for (int i = blockIdx.x * blockDim.x + tid; i < n16; i += gridDim.x * blockDim.x) z[i] = (u32x4){0u, 0u, 0u, 0u}; }
    LAS float* scr = (LAS float*)(lds + wave * 8704);
    const bool split = gridDim.x > 96;
    const int first = split ? ((int)blockIdx.x - 96) * nw + wave : blockIdx.x * nw + wave, stride = split ? ((int)gridDim.x - 96) * nw : gridDim.x * nw;
    if (!split || blockIdx.x >= 96) {
        for (int it = first; it < I_PRO; it += 2 * stride) {
            const bool two = it + stride < I_PRO;
            const TItem ta = decode_item(c, it), tb = decode_item(c, two ? it + stride : it);
            float va[32], vb[32];
            titem_load(ta, va, lane); if (two) titem_load(tb, vb, lane);
            titem_store(ta, va, scr, lane); if (two) titem_store(tb, vb, scr, lane);
        }
    }
}
__device__ __forceinline__ void ph_convert(const Ctx& c, LAS unsigned char* lds, int hb, int nh) {
    const int tid = threadIdx.x, lane = tid & 63, wave = __builtin_amdgcn_readfirstlane(tid >> 6), nw = blockDim.x >> 6;
    LAS float* scr = (LAS float*)(lds + wave * 8704);
    const int stride = nh * nw;
    for (int it = I_PRO + hb * nw + wave; it < NITEMS; it += 4 * stride) {
        const bool h1 = it + stride < NITEMS, h2 = it + 2 * stride < NITEMS, h3 = it + 3 * stride < NITEMS;
        const TItem ta = decode_item(c, it), tb = decode_item(c, h1 ? it + stride : it), tc = decode_item(c, h2 ? it + 2 * stride : it), td = decode_item(c, h3 ? it + 3 * stride : it);
        float va[32], vb[32], vc[32], vd[32];
        titem_load(ta, va, lane); if (h1) titem_load(tb, vb, lane); if (h2) titem_load(tc, vc, lane); if (h3) titem_load(td, vd, lane);
        titem_store(ta, va, scr, lane); if (h1) titem_store(tb, vb, scr, lane); if (h2) titem_store(tc, vc, scr, lane); if (h3) titem_store(td, vd, scr, lane);
    }
    __syncthreads();
}

__device__ __forceinline__ void ph_norm1(const Ctx& c) {
    const int tid = threadIdx.x, lane = tid & 63, wave = __builtin_amdgcn_readfirstlane(tid >> 6), nw = blockDim.x >> 6;
    const int gw = blockIdx.x * nw + wave, NGW = gridDim.x * nw;
    const float* MOD = (const float*)(c.ws + WS_MOD); bf16* H = (bf16*)(c.ws + WS_H);
    f32x4 g[4];
#pragma unroll
    for (int j = 0; j < 4; ++j) g[j] = *(const f32x4*)(c.g_mix + 4 * lane + 256 * j);
    f32x4 v[2][4], vn[2][4];
#define N1_LOAD(dst, r0_) _Pragma("unroll") for (int t = 0; t < 2; ++t) { const int r = (r0_) + t, b = r / KVL, j = r % KVL; const bool isctx = j < CTXL; \
            const float* src = isctx ? c.ctx + ((size_t)b * CTXL + j) * DM : c.x + ((size_t)b * SEQ + (j - CTXL)) * DM; \
            _Pragma("unroll") for (int q = 0; q < 4; ++q) dst[t][q] = *(const f32x4*)(src + 4 * lane + 256 * q); }
    int r0 = gw * 2;
    if (r0 < NROW) { N1_LOAD(v, r0) }
    for (; r0 < NROW; r0 += NGW * 2) {
        const int rn = r0 + NGW * 2;
        if (rn < NROW) { N1_LOAD(vn, rn) }
        float rstd[2]; f32x4 sh[2][4], sc[2][4];
#pragma unroll
        for (int t = 0; t < 2; ++t) { const int r = r0 + t, b = r / KVL, j = r % KVL; const bool isctx = j < CTXL;
            const float* mod = MOD + (isctx ? 16 : b) * 6144;
#pragma unroll
            for (int q = 0; q < 4; ++q) { sh[t][q] = *(const f32x4*)(mod + 4 * lane + 256 * q); sc[t][q] = *(const f32x4*)(mod + 1024 + 4 * lane + 256 * q); }
            float ss = 0.f;
#pragma unroll
            for (int q = 0; q < 4; ++q) ss += (v[t][q].x * v[t][q].x + v[t][q].y * v[t][q].y) + (v[t][q].z * v[t][q].z + v[t][q].w * v[t][q].w);
            rstd[t] = rsqrtf(wave_sum(ss) * (1.0f / DM) + NORM_EPS); }
#pragma unroll
        for (int t = 0; t < 2; ++t) { const int r = r0 + t;
#pragma unroll
            for (int q = 0; q < 4; ++q) { const f32x4 o = (v[t][q] * rstd[t] * g[q]) * (sc[t][q] + 1.0f) + sh[t][q];
                u32x2 w; w.x = pk2(o.x, o.y); w.y = pk2(o.z, o.w); *(u32x2*)(H + (size_t)r * DM + 4 * lane + 256 * q) = w; } }
#pragma unroll
        for (int t = 0; t < 2; ++t)
#pragma unroll
            for (int q = 0; q < 4; ++q) v[t][q] = vn[t][q];
    }
#undef N1_LOAD
}

__device__ __forceinline__ u32x4 pack8(const f32x4& a, const f32x4& b) { u32x4 w; w.x = pk2(a.x, a.y); w.y = pk2(a.z, a.w); w.z = pk2(b.x, b.y); w.w = pk2(b.z, b.w); return w; }
__device__ __forceinline__ u32x4 quadx(const u32x4& w, int sl4) { u32x4 r; r.x = __builtin_amdgcn_ds_bpermute(sl4, w.x); r.y = __builtin_amdgcn_ds_bpermute(sl4, w.y); r.z = __builtin_amdgcn_ds_bpermute(sl4, w.z); r.w = __builtin_amdgcn_ds_bpermute(sl4, w.w); return r; }
struct EpiInProj {
    unsigned char* ws;
    __device__ __forceinline__ void rope8(int t, int i8, f32x4& a, f32x4& b, float scale) const {
        const f32x2* R = (const f32x2*)(ws + WS_ROPE) + (size_t)t * 32 + (i8 >> 5) * 16 + ((i8 & 31) >> 1);
        const f32x4 c0 = *(const f32x4*)R, c1 = *(const f32x4*)(R + 2);
        f32x4 oa, ob;
        oa.x = (a.x * c0.x - a.y * c0.y) * scale; oa.y = (a.y * c0.x + a.x * c0.y) * scale;
        oa.z = (a.z * c0.z - a.w * c0.w) * scale; oa.w = (a.w * c0.z + a.z * c0.w) * scale;
        ob.x = (b.x * c1.x - b.y * c1.y) * scale; ob.y = (b.y * c1.x + b.x * c1.y) * scale;
        ob.z = (b.z * c1.z - b.w * c1.w) * scale; ob.w = (b.w * c1.z + b.z * c1.w) * scale;
        a = oa; b = ob;
    }
    __device__ __forceinline__ void emit8(int row, int col, f32x4 a, f32x4 b) const {
        const int bb = row / KVL, j = row % KVL; const bool lat = j >= CTXL; const int t = j - CTXL; const size_t tl = (size_t)bb * SEQ + t;
        if (col < C_DAK) { if (!lat) return; rope8(t, col & 63, a, b, QSCALE); *(u32x4*)((bf16*)(ws + WS_QDA) + tl * 512 + col) = pack8(a, b); }
        else if (col < C_DAV) { if (lat) rope8(t, col & 63, a, b, 1.0f); *(u32x4*)((bf16*)(ws + WS_KDA) + (size_t)row * 512 + (col - C_DAK)) = pack8(a, b); }
        else if (col < C_GQ) { *(u32x4*)((bf16*)(ws + WS_VDA) + (size_t)row * 512 + (col - C_DAV)) = pack8(a, b); }
        else if (col < C_GK) { if (!lat) return; *(u32x4*)((bf16*)(ws + WS_GQ) + tl * 256 + (col - C_GQ)) = pack8(a * 0.125f, b * 0.125f); }
        else if (col < C_GV) { *(u32x4*)((bf16*)(ws + WS_GK) + (size_t)row * 256 + (col - C_GK)) = pack8(a, b); }
        else if (col < C_GR) { *(u32x4*)((bf16*)(ws + WS_GV) + (size_t)row * 512 + (col - C_GV)) = pack8(a, b); }
        else if (col < C_LR) { if (!lat) return; *(u32x4*)((bf16*)(ws + WS_GR) + tl * 512 + (col - C_GR)) = pack8(a, b); }
        else if (col < NPROJ) { float* p = (float*)(ws + WS_LR) + (size_t)row * 32 + (col - C_LR); *(f32x4*)p = a; *(f32x4*)(p + 4) = b; }
    }
};
struct EpiGateUp {
    bf16* HMID;
    __device__ __forceinline__ void emit8(int row2, int col2, int sl4, f32x4 a, f32x4 b) const {
        f32x4 h; h.x = silu_f(a.x) * b.x; h.y = silu_f(a.y) * b.y; h.z = silu_f(a.z) * b.z; h.w = silu_f(a.w) * b.w;
        u32x2 w; w.x = __builtin_amdgcn_ds_bpermute(sl4, pk2(h.x, h.y)); w.y = __builtin_amdgcn_ds_bpermute(sl4, pk2(h.z, h.w)); *(u32x2*)(HMID + (size_t)row2 * EHID + (col2 >> 1)) = w;
    }
};
struct EpiDown {
    bf16* YB;
    __device__ __forceinline__ void emit8(int row2, int col2, int sl4, f32x4 a, f32x4 b) const { *(u32x4*)(YB + (size_t)row2 * DM + col2) = quadx(pack8(a, b), sl4); }
};

constexpr int MM_TEXP = 128;
__device__ __forceinline__ void moe_build(LAS int* mm, const unsigned* ctl) {
    if (threadIdx.x < 64) { const int l = threadIdx.x, e = l & 31;
        const int cnt = (int)__hip_atomic_load((unsigned*)ctl + CW_CNT + 64 * e, __ATOMIC_RELAXED, __HIP_MEMORY_SCOPE_AGENT);
        const int tiles = (cnt + 255) >> 8; int incl = tiles;
#pragma unroll
        for (int o = 1; o < 32; o <<= 1) { const int v = __shfl_up(incl, o); if (e >= o) incl += v; }
        if (l < 32) { mm[e] = cnt; mm[32 + e] = incl - tiles; if (e == 31) mm[64] = incl;
            for (int t = incl - tiles; t < incl; ++t) mm[MM_TEXP + t] = e; } }
    __syncthreads();
}
__device__ __forceinline__ int moe_tile_expert(const LAS int* mm, int tile) { return mm[MM_TEXP + tile]; }

namespace pg8 {
typedef short bf16x8 __attribute__((ext_vector_type(8)));
constexpr int BM = 256, BK = 64, HALF = 128, HTB = HALF * BK * 2  , STAGE_BYTES = 8 * HTB;
__host__ __device__ __forceinline__ int lds_byte(int r, int c) { const int st = (r >> 4) * 2 + (c >> 5), rr = r & 15, cc = c & 31, ob = rr * 64 + cc * 2; return st * 1024 + (ob ^ (((ob >> 9) & 1) << 5)); }
__host__ __device__ __forceinline__ void stage_rc(int b, int& R, int& C) { const int st = b / 1024, sb = b % 1024, swz = sb ^ (((sb >> 9) & 1) << 5); R = (st >> 1) * 16 + swz / 64; C = (st & 1) * 32 + (swz % 64) / 2; }
__host__ __device__ __forceinline__ int perm32(int rho) { const int n = rho >> 4, i = rho & 15; return 8 * (i >> 2) + 4 * n + (i & 3); }

struct Unit { const char* A; const char* B; int row0, col0, ge, gp; };
struct Gemm { int K; const int* LIST; const LAS int* mm; };

template <class E8> struct Epi8 {
    E8 e;
    __device__ __forceinline__ void operator()(const f32x4 (&acc)[2][2][4][2], const Unit& u, int wr, int wc, int fr, int fq) const {
        const int fr2 = (fr & 12) | fq, fq2 = fr & 3, sl4 = (fr2 + 16 * fq2) << 2;
#pragma unroll
        for (int ai = 0; ai < 2; ++ai)
#pragma unroll
            for (int m = 0; m < 4; ++m)
#pragma unroll
                for (int bj = 0; bj < 2; ++bj) e.emit8(u.row0 + ai * HALF + wr * 64 + m * 16 + fr2, u.col0 + bj * HALF + wc * 32 + 8 * fq2, sl4, acc[ai][bj][m][0], acc[ai][bj][m][1]);
    }
};

struct EpiInProjF {
    unsigned char* ws;
    template <int PITCH, int MODE  > __device__ __forceinline__ void plain_tile(bf16* p, const f32x4 (&acc)[2][2][4][2], int sl4) const {
#pragma unroll
        for (int ai = 0; ai < 2; ++ai)
#pragma unroll
            for (int m = 0; m < 4; ++m)
#pragma unroll
                for (int bj = 0; bj < 2; ++bj) { f32x4 a = acc[ai][bj][m][0], b = acc[ai][bj][m][1]; if (MODE == 1) { a = a * 0.125f; b = b * 0.125f; }
                    *(u32x4*)(p + (ai * HALF + m * 16) * PITCH + bj * HALF) = quadx(pack8(a, b), sl4); }
    }
    template <int MODE> __device__ __forceinline__ void gla_tile(bf16* base, int ch0, int wr, int wc, int fr, int fq, const f32x4 (&acc)[2][2][4][2]) const {
        bf16* p = base + ((size_t)((ch0 + wr) * 4 + (wc >> 1)) * 4096 + ((wc & 1) * 4 + fq) * 512 + fr * 8);
#pragma unroll
        for (int ai = 0; ai < 2; ++ai)
#pragma unroll
            for (int m = 0; m < 4; ++m)
#pragma unroll
                for (int bj = 0; bj < 2; ++bj) { f32x4 a = acc[ai][bj][m][0], b = acc[ai][bj][m][1]; if (MODE == 1) { a = a * 0.125f; b = b * 0.125f; }
                    *(u32x4*)(p + (2 * ai * 4 + 2 * bj) * 4096 + m * 16 * 8) = pack8(a, b); }
    }
    template <int MODE  > __device__ __forceinline__ void rope_tile(bf16* p, int tseq, int cl, const f32x4 (&acc)[2][2][4][2], int sl4) const {
        const int i8 = cl & 63; const float scale = MODE == 2 ? QSCALE : 1.0f;
        const f32x2* R = (const f32x2*)(ws + WS_ROPE) + (size_t)tseq * 32 + (i8 >> 5) * 16 + ((i8 & 31) >> 1);
        f32x4 rc[4][2]; u32x4 w[4][2];
#define IPR_LOAD(ai) _Pragma("unroll") for (int m = 0; m < 4; ++m) { rc[m][0] = *(const f32x4*)(R + ((ai) * HALF + m * 16) * 32); rc[m][1] = *(const f32x4*)(R + ((ai) * HALF + m * 16) * 32 + 2); }
#define IPR_CALC(ai) _Pragma("unroll") for (int m = 0; m < 4; ++m) _Pragma("unroll") for (int bj = 0; bj < 2; ++bj) { const f32x4 a = acc[ai][bj][m][0], b = acc[ai][bj][m][1], c0 = rc[m][0], c1 = rc[m][1]; f32x4 oa, ob; \
            oa.x = (a.x * c0.x - a.y * c0.y) * scale; oa.y = (a.y * c0.x + a.x * c0.y) * scale; oa.z = (a.z * c0.z - a.w * c0.w) * scale; oa.w = (a.w * c0.z + a.z * c0.w) * scale; \
            ob.x = (b.x * c1.x - b.y * c1.y) * scale; ob.y = (b.y * c1.x + b.x * c1.y) * scale; ob.z = (b.z * c1.z - b.w * c1.w) * scale; ob.w = (b.w * c1.z + b.z * c1.w) * scale; w[m][bj] = quadx(pack8(oa, ob), sl4); }
#define IPR_STORE(ai) _Pragma("unroll") for (int m = 0; m < 4; ++m) _Pragma("unroll") for (int bj = 0; bj < 2; ++bj) *(u32x4*)(p + ((ai) * HALF + m * 16) * 512 + bj * HALF) = w[m][bj];
        IPR_LOAD(0) IPR_CALC(0) IPR_LOAD(1) IPR_STORE(0) IPR_CALC(1) IPR_STORE(1)
#undef IPR_LOAD
#undef IPR_CALC
#undef IPR_STORE
    }
    __device__ __forceinline__ void operator()(const f32x4 (&acc)[2][2][4][2], const Unit& u, int wr, int wc, int fr, int fq) const {
        asm volatile("" : "+v"(fr), "+v"(fq));
        const int pn = __builtin_amdgcn_readfirstlane(u.col0) >> 8, row0 = __builtin_amdgcn_readfirstlane(u.row0);
        const int bb = row0 / KVL, j0 = row0 - bb * KVL; const bool lat = j0 >= CTXL;
        const int rl = wr * 64 + fr, cl = wc * 32 + 8 * fq;
        const size_t gr = (size_t)(row0 + rl), tl = (size_t)(bb * SEQ + j0 - CTXL + rl);
        const int fr2 = (fr & 12) | fq, fq2 = fr & 3, sl4 = (fr2 + 16 * fq2) << 2, cl2 = wc * 32 + 8 * fq2;
        const size_t gr2 = (size_t)(row0 + wr * 64 + fr2);
        if (pn < 2) { if (lat) rope_tile<2>((bf16*)(ws + WS_QDA) + (size_t)(bb * SEQ + j0 - CTXL + wr * 64 + fr2) * 512 + pn * 256 + cl2, j0 - CTXL + rl, cl, acc, sl4); }
        else if (pn < 4) { if (lat) rope_tile<3>((bf16*)(ws + WS_KDA) + gr2 * 512 + (pn - 2) * 256 + cl2, j0 - CTXL + rl, cl, acc, sl4); else plain_tile<512, 0>((bf16*)(ws + WS_KDA) + gr2 * 512 + (pn - 2) * 256 + cl2, acc, sl4); }
        else if (pn < 6) plain_tile<512, 0>((bf16*)(ws + WS_VDA) + gr2 * 512 + (pn - 4) * 256 + cl2, acc, sl4);
        else if (pn == 6) { if (lat) gla_tile<1>((bf16*)(ws + WS_GQ), (bb * SEQ + j0 - CTXL) >> 6, wr, wc, fr, fq, acc); }
        else if (pn == 7) gla_tile<0>((bf16*)(ws + WS_GK), row0 >> 6, wr, wc, fr, fq, acc);
        else if (pn < 10) plain_tile<512, 0>((bf16*)(ws + WS_GV) + gr2 * 512 + (pn - 8) * 256 + cl2, acc, sl4);
        else if (pn < 12) { if (lat) {
                bf16* p = (bf16*)(ws + WS_GR) + ((size_t)(((((bb * SEQ + j0 - CTXL) >> 6) + wr) * 4 + (pn - 10) * 2) * 16 + wc * 4 + fq) * 512 + fr * 8);
#pragma unroll
                for (int ai = 0; ai < 2; ++ai)
#pragma unroll
                    for (int m = 0; m < 4; ++m)
#pragma unroll
                        for (int bj = 0; bj < 2; ++bj) *(u32x4*)(p + ai * 65536 + bj * 8192 + m * 128) = pack8(acc[ai][bj][m][0], acc[ai][bj][m][1]); } }
        else if (cl < NPROJ - C_LR) { float* p = (float*)(ws + WS_LR) + gr * 32 + cl;
#pragma unroll
            for (int ai = 0; ai < 2; ++ai)
#pragma unroll
                for (int m = 0; m < 4; ++m) { *(f32x4*)(p + (ai * HALF + m * 16) * 32) = acc[ai][0][m][0]; *(f32x4*)(p + (ai * HALF + m * 16) * 32 + 4) = acc[ai][0][m][1]; } }
    }
};

struct EpiOutProjB {
    const float* x; const float* MOD; bf16* X1; float* SSP;
    __device__ __forceinline__ void operator()(const f32x4 (&acc)[2][2][4][2], const Unit& u, int wr, int wc, int fr, int fq) const {
        const int bb = u.row0 / SEQ; const int colb = u.col0 + wc * 32 + 8 * fq;
        f32x4 g[2][2];
#pragma unroll
        for (int bj = 0; bj < 2; ++bj) { const float* gp = MOD + bb * 6144 + 2048 + colb + bj * HALF; g[bj][0] = *(const f32x4*)gp; g[bj][1] = *(const f32x4*)(gp + 4); }
#pragma unroll
        for (int ai = 0; ai < 2; ++ai)
#pragma unroll
            for (int mh = 0; mh < 2; ++mh) {
                f32x4 xv[2][2][2]; float ssq[2] = {0.f, 0.f};
#pragma unroll
                for (int mm_ = 0; mm_ < 2; ++mm_)
#pragma unroll
                    for (int bj = 0; bj < 2; ++bj) { const float* xp = x + (size_t)(u.row0 + ai * HALF + wr * 64 + (2 * mh + mm_) * 16 + fr) * DM + colb + bj * HALF; xv[mm_][bj][0] = *(const f32x4*)xp; xv[mm_][bj][1] = *(const f32x4*)(xp + 4); }
#pragma unroll
                for (int mm_ = 0; mm_ < 2; ++mm_)
#pragma unroll
                    for (int bj = 0; bj < 2; ++bj) { const int m = 2 * mh + mm_; const size_t o = (size_t)(u.row0 + ai * HALF + wr * 64 + m * 16 + fr) * DM + colb + bj * HALF;
                        const u32x4 pw = pack8(xv[mm_][bj][0] + g[bj][0] * acc[ai][bj][m][0], xv[mm_][bj][1] + g[bj][1] * acc[ai][bj][m][1]);
                        *(u32x4*)(X1 + o) = pw;
                        const float q0 = bflo(pw.x), q1 = bfhi(pw.x), q2 = bflo(pw.y), q3 = bfhi(pw.y), q4 = bflo(pw.z), q5 = bfhi(pw.z), q6 = bflo(pw.w), q7 = bfhi(pw.w);
                        ssq[mm_] += (q0 * q0 + q1 * q1) + (q2 * q2 + q3 * q3) + (q4 * q4 + q5 * q5) + (q6 * q6 + q7 * q7); }
#pragma unroll
                for (int mm_ = 0; mm_ < 2; ++mm_) { float s = ssq[mm_]; s += __shfl_xor(s, 16); s += __shfl_xor(s, 32);
                    if (fq == 0) SSP[(size_t)(u.row0 + ai * HALF + wr * 64 + (2 * mh + mm_) * 16 + fr) * 16 + (u.col0 >> 8) * 4 + wc] = s; }
                asm volatile("" ::: "memory");
            }
    }
};

template <class Epi, class Sched, bool GATHER, bool ALIGN_EPI = true, bool SP2 = true>
__device__ __forceinline__ void gemm_phase(LAS unsigned char* lds, const Gemm g, const Sched& S, const Epi& E) {
    int tid = threadIdx.x; asm volatile("" : "+v"(tid));
    const int wid = __builtin_amdgcn_readfirstlane(tid >> 6), lane = tid & 63, wr = wid >> 2, wc = wid & 3, fr = lane & 15, fq = lane >> 4;
    const int K = g.K, nt = K / BK;
    int Rr[2], Cc[2]; unsigned voffB[2];
#pragma unroll
    for (int i = 0; i < 2; ++i) { stage_rc(tid * 16 + i * 8192, Rr[i], Cc[i]); const int Rb = (Rr[i] & ~31) + perm32(Rr[i] & 31); voffB[i] = (unsigned)(Rb * K + Cc[i]) * 2u; }
    const size_t kstep = (size_t)(BK * 2);
    const size_t hstep = (size_t)HALF * K * 2;
    const unsigned ldsw = (unsigned)wid * 1024u;
    const int aoff = lds_byte(wr * 64 + fr, fq * 8), boff = lds_byte(wc * 32 + fr, fq * 8);
#define PG8_MKOFF(u, vo) do { _Pragma("unroll") for (int _h = 0; _h < 2; ++_h) _Pragma("unroll") for (int _i = 0; _i < 2; ++_i) { \
        if (GATHER) { const int _pos = (u).gp + _h * HALF + Rr[_i]; const int _tok = g.LIST[(u).ge * NTOK + (_pos < g.mm[(u).ge] ? _pos : 0)]; (vo)[_h][_i] = (unsigned)(_tok * K + Cc[_i]) * 2u; } \
        else (vo)[_h][_i] = (unsigned)((_h * HALF + Rr[_i]) * K + Cc[_i]) * 2u; } } while (0)
#define PG8_SA(b, h) (((b) * 2 + (h)) * HTB)
#define PG8_SB(b, h) ((4 + (b) * 2 + (h)) * HTB)
#define PG8_STAGE(bufoff, gbase, voff) do { _Pragma("unroll") for (int _i = 0; _i < 2; ++_i) \
        __builtin_amdgcn_global_load_lds((const unsigned*)((const char*)(gbase) + (voff)[_i]), (LAS unsigned*)(lds + (bufoff) + ldsw + _i * 8192), 16, 0, 0); } while (0)
#define PG8_LDA(dst, b, h) do { _Pragma("unroll") for (int m = 0; m < 4; ++m) _Pragma("unroll") for (int k = 0; k < 2; ++k) dst[m][k] = *(const LAS bf16x8*)(lds + PG8_SA(b, h) + aoff + m * 2048 + k * 1024); } while (0)
#define PG8_LDB(dst, b, h) do { _Pragma("unroll") for (int n = 0; n < 2; ++n) _Pragma("unroll") for (int k = 0; k < 2; ++k) dst[n][k] = *(const LAS bf16x8*)(lds + PG8_SB(b, h) + boff + n * 2048 + k * 1024); } while (0)
#define PG8_MMA(ai, bj, At, Bt) do { __builtin_amdgcn_s_setprio(1); _Pragma("unroll") for (int m = 0; m < 4; ++m) _Pragma("unroll") for (int n = 0; n < 2; ++n) _Pragma("unroll") for (int k = 0; k < 2; ++k) \
        acc[ai][bj][m][n] = __builtin_amdgcn_mfma_f32_16x16x32_bf16(Bt[n][k], At[m][k], acc[ai][bj][m][n], 0, 0, 0); __builtin_amdgcn_s_setprio(0); } while (0)
#define PG8_WAIT_V(n) asm volatile("s_waitcnt vmcnt(" #n ")" ::: "memory")
#define PG8_WAIT_L(n) asm volatile("s_waitcnt lgkmcnt(" #n ")" ::: "memory")
#define PG8_BAR __builtin_amdgcn_s_barrier()
#define PG8_SCHED __builtin_amdgcn_sched_barrier(0)
    Unit cur, nxt; int ui = 0;
    if (!S.next(0, cur)) return;
    f32x4 acc[2][2][4][2];
#pragma unroll
    for (int a = 0; a < 2; ++a)
#pragma unroll
        for (int b = 0; b < 2; ++b)
#pragma unroll
            for (int m = 0; m < 4; ++m)
#pragma unroll
                for (int n = 0; n < 2; ++n) acc[a][b][m][n] = (f32x4){0.f, 0.f, 0.f, 0.f};
    bf16x8 At[4][2], B0[2][2], B1[2][2];
    unsigned voffA[2][2], nvoffA[2][2];
    PG8_MKOFF(cur, voffA);
    const char* cA = cur.A; const char* cB = cur.B;
    if constexpr (SP2) {
        PG8_STAGE(PG8_SB(0, 0), cB, voffB); PG8_STAGE(PG8_SB(0, 1), cB + hstep, voffB); PG8_STAGE(PG8_SA(0, 0), cA, voffA[0]); PG8_STAGE(PG8_SA(0, 1), cA, voffA[1]);
        if (wr == 1) PG8_BAR;
        PG8_WAIT_V(2); PG8_BAR;
        PG8_STAGE(PG8_SB(1, 0), cB + kstep, voffB); PG8_STAGE(PG8_SA(1, 0), cA + kstep, voffA[0]); PG8_STAGE(PG8_SB(1, 1), cB + hstep + kstep, voffB);
        PG8_WAIT_V(6); PG8_BAR;
    } else {
        PG8_STAGE(PG8_SB(0, 0), cB, voffB); PG8_STAGE(PG8_SA(0, 0), cA, voffA[0]); PG8_STAGE(PG8_SB(0, 1), cB + hstep, voffB); PG8_STAGE(PG8_SA(0, 1), cA, voffA[1]);
        if (wr == 1) PG8_BAR;
        PG8_WAIT_V(4); PG8_BAR;
        PG8_STAGE(PG8_SB(1, 0), cB + kstep, voffB); PG8_STAGE(PG8_SA(1, 0), cA + kstep, voffA[0]); PG8_STAGE(PG8_SB(1, 1), cB + hstep + kstep, voffB);
        PG8_WAIT_V(6); PG8_BAR;
    }
    for (;;) {
        const bool has_next = S.next(ui + 1, nxt);
        if (has_next) { PG8_MKOFF(nxt, nvoffA); }
        else {
#pragma unroll
            for (int h = 0; h < 2; ++h)
#pragma unroll
                for (int i = 0; i < 2; ++i) nvoffA[h][i] = voffA[h][i]; }
        const char* nA = has_next ? nxt.A : cA; const char* nB = has_next ? nxt.B : cB;
        for (int t = 0; t < nt; t += 2) {
            const bool last = (t == nt - 2);
            const char* a1 = cA + (size_t)(t + 1) * kstep;
            const char* a2 = last ? nA : cA + (size_t)(t + 2) * kstep; const char* b2 = last ? nB : cB + (size_t)(t + 2) * kstep;
            const char* a3 = a2 + kstep; const char* b3 = b2 + kstep;
            unsigned v2[2][2];
#pragma unroll
            for (int h = 0; h < 2; ++h)
#pragma unroll
                for (int i = 0; i < 2; ++i) v2[h][i] = last ? nvoffA[h][i] : voffA[h][i];
            if constexpr (SP2) {
            PG8_LDB(B0, 0, 0); PG8_LDB(B1, 0, 1); PG8_SCHED; PG8_LDA(At, 0, 0); PG8_STAGE(PG8_SA(1, 1), a1, voffA[1]);
            PG8_WAIT_V(8); PG8_WAIT_L(0); PG8_BAR; PG8_MMA(0, 0, At, B0); PG8_MMA(0, 1, At, B1); PG8_BAR; PG8_SCHED;
            PG8_LDA(At, 0, 1); PG8_STAGE(PG8_SB(0, 0), b2, voffB); PG8_STAGE(PG8_SB(0, 1), b2 + hstep, voffB); PG8_STAGE(PG8_SA(0, 0), a2, v2[0]);
            PG8_WAIT_V(8); PG8_WAIT_L(0); PG8_BAR; PG8_MMA(1, 0, At, B0); PG8_MMA(1, 1, At, B1); PG8_BAR; PG8_SCHED;
            PG8_LDB(B0, 1, 0); PG8_LDB(B1, 1, 1); PG8_SCHED; PG8_LDA(At, 1, 0); PG8_STAGE(PG8_SA(0, 1), a2, v2[1]);
            PG8_WAIT_V(8); PG8_WAIT_L(0); PG8_BAR; PG8_MMA(0, 0, At, B0); PG8_MMA(0, 1, At, B1); PG8_BAR; PG8_SCHED;
            PG8_LDA(At, 1, 1); PG8_STAGE(PG8_SB(1, 0), b3, voffB); PG8_STAGE(PG8_SB(1, 1), b3 + hstep, voffB); PG8_STAGE(PG8_SA(1, 0), a3, v2[0]);
            PG8_WAIT_V(8); PG8_WAIT_L(0); PG8_BAR; PG8_MMA(1, 0, At, B0); PG8_MMA(1, 1, At, B1); PG8_BAR; PG8_SCHED;
            } else {
            PG8_LDB(B0, 0, 0); PG8_SCHED; PG8_LDA(At, 0, 0); PG8_STAGE(PG8_SA(1, 1), a1, voffA[1]);
            PG8_WAIT_L(8); PG8_BAR; PG8_WAIT_L(0); PG8_MMA(0, 0, At, B0); PG8_BAR; PG8_SCHED;
            PG8_LDB(B1, 0, 1); PG8_STAGE(PG8_SB(0, 0), b2, voffB);
            PG8_BAR; PG8_WAIT_L(0); PG8_MMA(0, 1, At, B1); PG8_BAR;
            PG8_LDA(At, 0, 1); PG8_STAGE(PG8_SA(0, 0), a2, v2[0]);
            PG8_BAR; PG8_WAIT_L(0); PG8_MMA(1, 0, At, B0); PG8_BAR; PG8_SCHED;
            PG8_STAGE(PG8_SB(0, 1), b2 + hstep, voffB);
            PG8_WAIT_V(6); PG8_BAR; PG8_MMA(1, 1, At, B1); PG8_BAR;
            PG8_LDB(B0, 1, 0); PG8_SCHED; PG8_LDA(At, 1, 0); PG8_STAGE(PG8_SA(0, 1), a2, v2[1]);
            PG8_WAIT_L(8); PG8_BAR; PG8_WAIT_L(0); PG8_MMA(0, 0, At, B0); PG8_BAR; PG8_SCHED;
            PG8_LDB(B1, 1, 1); PG8_STAGE(PG8_SB(1, 0), b3, voffB);
            PG8_BAR; PG8_WAIT_L(0); PG8_MMA(0, 1, At, B1); PG8_BAR;
            PG8_LDA(At, 1, 1); PG8_STAGE(PG8_SA(1, 0), a3, v2[0]);
            PG8_BAR; PG8_WAIT_L(0); PG8_MMA(1, 0, At, B0); PG8_BAR; PG8_SCHED;
            PG8_STAGE(PG8_SB(1, 1), b3 + hstep, voffB);
            PG8_WAIT_V(6); PG8_BAR; PG8_MMA(1, 1, At, B1); PG8_BAR;
            }
        }
        if constexpr (ALIGN_EPI) { if (wr == 0) PG8_BAR; }
        E(acc, cur, wr, wc, fr, fq);
        if (!has_next) break;
#pragma unroll
        for (int a = 0; a < 2; ++a)
#pragma unroll
            for (int b = 0; b < 2; ++b)
#pragma unroll
                for (int m = 0; m < 4; ++m)
#pragma unroll
                    for (int n = 0; n < 2; ++n) acc[a][b][m][n] = (f32x4){0.f, 0.f, 0.f, 0.f};
        cur = nxt; cA = nA; cB = nB; ++ui;
#pragma unroll
        for (int h = 0; h < 2; ++h)
#pragma unroll
            for (int i = 0; i < 2; ++i) voffA[h][i] = nvoffA[h][i];
        if constexpr (ALIGN_EPI) { if (wr == 1) PG8_BAR; }
    }
    PG8_WAIT_V(0);
    if constexpr (!ALIGN_EPI) { if (wr == 0) PG8_BAR; }
    PG8_BAR;
#undef PG8_MKOFF
#undef PG8_SA
#undef PG8_SB
#undef PG8_STAGE
#undef PG8_LDA
#undef PG8_LDB
#undef PG8_MMA
#undef PG8_WAIT_V
#undef PG8_WAIT_L
#undef PG8_BAR
#undef PG8_SCHED
}
__device__ __forceinline__ int xcd_remap(int L, int nwg) { const int q = nwg / 8, r = nwg % 8, xcd = L % 8, off = L / 8; return (xcd < r ? xcd * (q + 1) : r * (q + 1) + (xcd - r) * q) + off; }
}

constexpr int LDS_MM_OFF = 131072;

struct OrderInProj { int G, c; const char* H; const char* W;
    __device__ __forceinline__ bool next(int i, pg8::Unit& u) const {
        const int L = i * G + c; if (L >= 1792) return false;
        int pmg, pn;
        if (L < 1664) { const int wgid = pg8::xcd_remap(L, 1664); const int nig = 8 * 13, gid = wgid / nig, p = gid * 8 + ((wgid % nig) & 7); pn = (wgid % nig) >> 3; pmg = (p >> 3) * 9 + 1 + (p & 7); }
        else { const int idx = L - 1664, p = idx & 15, ci = idx >> 4; pmg = p * 9; pn = ci < 4 ? 2 + ci : (ci < 7 ? 3 + ci : 12); }
        u.A = H + (size_t)pmg * 256 * 2048; u.B = W + (size_t)pn * 256 * 2048; u.row0 = pmg * 256; u.col0 = pn * 256; u.ge = -1; u.gp = 0; return true; } };
struct OrderOutProj { int G, c; const char* A; const char* W;
    __device__ __forceinline__ bool next(int i, pg8::Unit& u) const {
        const int L = i * G + c; if (L >= 512) return false;
        const int wgid = pg8::xcd_remap(L, 512); const int nig = 8 * 4, gid = wgid / nig, pm = gid * 8 + ((wgid % nig) & 7), pn = (wgid % nig) >> 3;
        u.A = A + (size_t)pm * 256 * 2048; u.B = W + (size_t)pn * 256 * 2048; u.row0 = pm * 256; u.col0 = pn * 256; u.ge = -1; u.gp = 0; return true; } };
struct OrderGateUp { int G, c; const char* H2; const char* W; const LAS int* mm;
    __device__ __forceinline__ bool next(int i, pg8::Unit& u) const {
        const int nwg = mm[64] * 4, L = i * G + c; if (L >= nwg) return false;
        const int wgid = pg8::xcd_remap(L, nwg), tt = wgid >> 2, pn = wgid & 3, e = moe_tile_expert(mm, tt);
        u.A = H2; u.B = W + ((size_t)e * 1024 + pn * 256) * 2048; u.row0 = tt * 256; u.col0 = pn * 256; u.ge = e; u.gp = (tt - mm[32 + e]) * 256; return true; } };
struct OrderDown { int G, c; const char* HM; const char* W; const LAS int* mm;
    __device__ __forceinline__ bool next(int i, pg8::Unit& u) const {
        const int nwg = mm[64] * 4, L = i * G + c; if (L >= nwg) return false;
        const int wgid = pg8::xcd_remap(L, nwg), tt = wgid >> 2, pn = wgid & 3, e = moe_tile_expert(mm, tt);
        u.A = HM + (size_t)tt * 256 * 1024; u.B = W + ((size_t)e * 1024 + pn * 256) * 1024; u.row0 = tt * 256; u.col0 = pn * 256; u.ge = -1; u.gp = 0; return true; } };

__device__ __forceinline__ void ph_inproj(const Ctx& c, LAS unsigned char* lds) {
    const int nh = gridDim.x >= 16 ? (int)gridDim.x / 8 : 0, G = (int)gridDim.x - nh;
    if ((int)blockIdx.x >= G) { ph_convert(c, lds, (int)blockIdx.x - G, nh); return; }
    pg8::Gemm g{1024, nullptr, nullptr}; OrderInProj S{G, (int)blockIdx.x, (const char*)(c.ws + WS_H), (const char*)(c.ws + WS_WIN_T)};
    pg8::EpiInProjF E{c.ws};
    pg8::gemm_phase<pg8::EpiInProjF, OrderInProj, false>(lds, g, S, E);
    if (nh == 0) ph_convert(c, lds, (int)blockIdx.x, (int)gridDim.x);
}
__device__ __forceinline__ void ph_outproj(const Ctx& c, LAS unsigned char* lds) {
    pg8::Gemm g{1024, nullptr, nullptr}; OrderOutProj S{(int)gridDim.x, (int)blockIdx.x, (const char*)(c.ws + WS_MIX), (const char*)(c.ws + WS_WOUT_T)};
    pg8::EpiOutProjB E{c.x, (const float*)(c.ws + WS_MOD), (bf16*)(c.ws + WS_X1), (float*)(c.ws + WS_SSP)};
    pg8::gemm_phase<pg8::EpiOutProjB, OrderOutProj, false>(lds, g, S, E);
}
__device__ __forceinline__ void ph_gateup(const Ctx& c, LAS unsigned char* lds) {
    LAS int* mm = (LAS int*)(lds + LDS_MM_OFF); moe_build(mm, (const unsigned*)(c.ws + WS_CTL));
    pg8::Gemm g{1024, (const int*)(c.ws + WS_LIST), mm}; OrderGateUp S{(int)gridDim.x, (int)blockIdx.x, (const char*)(c.ws + WS_H2), (const char*)(c.ws + WS_WGU_T), mm};
    pg8::Epi8<EpiGateUp> E{EpiGateUp{(bf16*)(c.ws + WS_HMID)}};
    pg8::gemm_phase<pg8::Epi8<EpiGateUp>, OrderGateUp, true>(lds, g, S, E);
}
__device__ __forceinline__ void ph_down(const Ctx& c, LAS unsigned char* lds) {
    LAS int* mm = (LAS int*)(lds + LDS_MM_OFF);
    pg8::Gemm g{512, nullptr, mm}; OrderDown S{(int)gridDim.x, (int)blockIdx.x, (const char*)(c.ws + WS_HMID), (const char*)(c.ws + WS_WD_T), mm};
    pg8::Epi8<EpiDown> E{EpiDown{(bf16*)(c.ws + WS_YB)}};
    pg8::gemm_phase<pg8::Epi8<EpiDown>, OrderDown, false>(lds, g, S, E);
}

__device__ __forceinline__ float da_lambda_full(const float* lp) {
    float s0 = 0.f, s1 = 0.f;
    for (int i = 0; i < 64; ++i) { s0 += lp[i] * lp[64 + i]; s1 += lp[128 + i] * lp[192 + i]; }
    return expf(s0) - expf(s1) + LAMBDA_INIT;
}
namespace da {
typedef short bf16x8 __attribute__((ext_vector_type(8)));
typedef short s16x4 __attribute__((ext_vector_type(4)));
typedef float f32x16 __attribute__((ext_vector_type(16)));
typedef float f32x2_t __attribute__((ext_vector_type(2))); typedef __bf16 bf16x2_t __attribute__((ext_vector_type(2)));
__device__ __forceinline__ unsigned cvtpk(float lo, float hi) { f32x2_t v = {lo, hi}; bf16x2_t b = __builtin_convertvector(v, bf16x2_t); return __builtin_bit_cast(unsigned, b); }
__device__ __forceinline__ bf16x8 pack_half(const f32x16& x, int s) {
    u32x4 p; p.x = cvtpk(x[8 * s], x[8 * s + 1]); p.y = cvtpk(x[8 * s + 2], x[8 * s + 3]); p.z = cvtpk(x[8 * s + 4], x[8 * s + 5]); p.w = cvtpk(x[8 * s + 6], x[8 * s + 7]);
    return __builtin_bit_cast(bf16x8, p); }
__device__ __forceinline__ s16x4 vtr(const LAS unsigned char* p) { return __builtin_bit_cast(s16x4, __builtin_amdgcn_ds_read_tr16_b64_v4i16((LAS s16x4*)p)); }
#define DA_MFMA(a, b, c) __builtin_amdgcn_mfma_f32_32x32x16_bf16((a), (b), (c), 0, 0, 0)
constexpr int NT = KVL / 64;
constexpr int QS_OFF = 81920;

template <int KB> __device__ __forceinline__ void qk_tile(const LAS unsigned char* kq, const bf16x8 (&qf)[4], const f32x16& negm, f32x16& s0, f32x16& s1) {
#pragma unroll
    for (int ks = 0; ks < 4; ++ks) {
        const bf16x8 k0 = *(const LAS bf16x8*)(kq + KB + ks * 2048), k1 = *(const LAS bf16x8*)(kq + KB + ks * 2048 + 512), qq = qf[ks];
        if (ks == 0) { s0 = DA_MFMA(k0, qq, negm); s1 = DA_MFMA(k1, qq, negm); } else { s0 = DA_MFMA(k0, qq, s0); s1 = DA_MFMA(k1, qq, s1); } }
}
__device__ __forceinline__ float max3f(float a, float b, float c) { return fmaxf(fmaxf(a, b), c); }
template <int VB> __device__ __forceinline__ void softmax_pv(const LAS unsigned char* lds, int vlane, f32x16& s0, f32x16& s1, f32x16 (&O)[4], f32x16& negm, float& lrun) {
    float ma = max3f(s0[0], s0[1], s1[0]), mb = max3f(s0[2], s0[3], s1[1]); ma = max3f(ma, s1[2], s1[3]);
#pragma unroll
    for (int r = 4; r < 16; r += 4) { ma = max3f(ma, s0[r], s0[r + 1]); mb = max3f(mb, s0[r + 2], s0[r + 3]); ma = max3f(ma, s1[r], s1[r + 1]); mb = max3f(mb, s1[r + 2], s1[r + 3]); }
    float mx = fmaxf(ma, mb);
    if (__any(mx > 8.0f)) {
        mx = fmaxf(mx, __shfl_xor(mx, 32));
        const float dl = fmaxf(mx, 0.f), alpha = __builtin_amdgcn_exp2f(-dl);
        lrun *= alpha;
#pragma unroll
        for (int r = 0; r < 16; ++r) { s0[r] -= dl; s1[r] -= dl; negm[r] -= dl; }
#pragma unroll
        for (int dt = 0; dt < 4; ++dt)
#pragma unroll
            for (int r = 0; r < 16; ++r) O[dt][r] *= alpha;
    }
    const unsigned vb = (unsigned)(size_t)(lds + VB + vlane);
    s16x4 fa[8], fb[8]; bf16x8 Pa, Pb; float ps = 0.f;
#define DA_VRDK(dst, ks) do { _Pragma("unroll") for (int _d = 0; _d < 4; ++_d) { \
        asm volatile("ds_read_b64_tr_b16 %0, %1 offset:%2" : "=&v"(dst[2 * _d]) : "v"(vb), "n"((_d * 4 + (ks)) * 1024) : "memory"); \
        asm volatile("ds_read_b64_tr_b16 %0, %1 offset:%2" : "=&v"(dst[2 * _d + 1]) : "v"(vb), "n"((_d * 4 + (ks)) * 1024 + 512) : "memory"); } } while (0)
#define DA_VWAIT(N, f) asm volatile("s_waitcnt lgkmcnt(" #N ")" : "+v"(f[0]), "+v"(f[1]), "+v"(f[2]), "+v"(f[3]), "+v"(f[4]), "+v"(f[5]), "+v"(f[6]), "+v"(f[7]) :: "memory")
#define DA_EXP2(S, r0) do { S[r0] = __builtin_amdgcn_exp2f(S[r0]); S[(r0) + 1] = __builtin_amdgcn_exp2f(S[(r0) + 1]); ps += S[r0] + S[(r0) + 1]; } while (0)
#define DA_MX(f, Pcur, d, S, r0) do { O[d] = DA_MFMA(__builtin_shufflevector(f[2 * (d)], f[2 * (d) + 1], 0, 1, 2, 3, 4, 5, 6, 7), Pcur, O[d]); DA_EXP2(S, r0); __builtin_amdgcn_sched_barrier(0); } while (0)
    DA_VRDK(fa, 0); DA_VRDK(fb, 1);
    DA_EXP2(s0, 0); DA_EXP2(s0, 2); DA_EXP2(s0, 4); DA_EXP2(s0, 6); Pa = pack_half(s0, 0);
    DA_VWAIT(8, fa); __builtin_amdgcn_sched_barrier(0);
    DA_MX(fa, Pa, 0, s0, 8); DA_MX(fa, Pa, 1, s0, 10); DA_MX(fa, Pa, 2, s0, 12); DA_MX(fa, Pa, 3, s0, 14); Pb = pack_half(s0, 1);
    DA_VRDK(fa, 2); DA_VWAIT(8, fb); __builtin_amdgcn_sched_barrier(0);
    DA_MX(fb, Pb, 0, s1, 0); DA_MX(fb, Pb, 1, s1, 2); DA_MX(fb, Pb, 2, s1, 4); DA_MX(fb, Pb, 3, s1, 6); Pa = pack_half(s1, 0);
    DA_VRDK(fb, 3); DA_VWAIT(8, fa); __builtin_amdgcn_sched_barrier(0);
    DA_MX(fa, Pa, 0, s1, 8); DA_MX(fa, Pa, 1, s1, 10); DA_MX(fa, Pa, 2, s1, 12); DA_MX(fa, Pa, 3, s1, 14); Pb = pack_half(s1, 1);
    DA_VWAIT(0, fb); __builtin_amdgcn_sched_barrier(0);
#pragma unroll
    for (int d = 0; d < 4; ++d) O[d] = DA_MFMA(__builtin_shufflevector(fb[2 * d], fb[2 * d + 1], 0, 1, 2, 3, 4, 5, 6, 7), Pb, O[d]);
    lrun += ps;
#undef DA_VRDK
#undef DA_VWAIT
#undef DA_EXP2
#undef DA_MX
}

template <int m> __device__ __forceinline__ void attn_body(const Ctx& c, LAS unsigned char* lds) {
    const int tid = threadIdx.x, lane = tid & 63, wid = __builtin_amdgcn_readfirstlane(tid >> 6), r32 = lane & 31, hi = lane >> 5;
    const int qsub = wid & 3;
    const bf16* Q = (const bf16*)(c.ws + WS_QDA); const bf16* K = (const bf16*)(c.ws + WS_KDA); const bf16* V = (const bf16*)(c.ws + WS_VDA); bf16* MIX = (bf16*)(c.ws + WS_MIX);
    const float lam = da_lambda_full(c.da_lambda);
    const int vlane = (4 * hi + ((lane & 15) >> 2)) * 64 + ((lane >> 4) & 1) * 32 + (lane & 3) * 8;
    const LAS unsigned char* kq = lds + (m * 8 + hi) * 1024 + r32 * 16;
    const unsigned kgo0 = (unsigned)(lane * 512 + (wid * 2) * 8) * 2u, kgo1 = kgo0 + 16u;
    const unsigned vgo0 = (unsigned)((((wid * 2) & 3) * 16 + (lane >> 2)) * 512 + ((wid * 2) >> 2) * 32 + (lane & 3) * 8) * 2u, vgo1 = vgo0 + 16u * 512u * 2u;
    bf16x8 qf[4];
    if constexpr (m == 1) __builtin_amdgcn_s_setprio(1);
    for (int it = 0;; ++it) {
        const int L = it * (int)gridDim.x + (int)blockIdx.x; if (L >= 1024) break;
        const int wg = pg8::xcd_remap(L, 1024), bh = wg >> 4, qb = wg & 15, b = bh >> 2, h = bh & 3;
        const char* Kb = (const char*)(K + (size_t)b * KVL * 512 + h * 128); const char* Vb = (const char*)(V + (size_t)b * KVL * 512 + h * 128);
        const size_t qrow = (size_t)b * SEQ + qb * 128 + qsub * 32 + r32;
        const int Ln = L + (int)gridDim.x; const bool hasn = Ln < 1024;
        const int wgn = pg8::xcd_remap(hasn ? Ln : L, 1024), bhn = wgn >> 4, qbn = wgn & 15, bn = bhn >> 2, hn = bhn & 3;
        const char* Kbn = (const char*)(K + (size_t)bn * KVL * 512 + hn * 128); const char* Vbn = (const char*)(V + (size_t)bn * KVL * 512 + hn * 128);
#define DA_DMA_KB(base, t, bo) do { const size_t _to = (size_t)(t) * (64 * 512 * 2); \
            __builtin_amdgcn_global_load_lds((const unsigned*)((base) + _to + kgo0), (LAS unsigned*)(lds + (bo) + (wid * 2) * 1024), 16, 0, 0); \
            __builtin_amdgcn_global_load_lds((const unsigned*)((base) + _to + kgo1), (LAS unsigned*)(lds + (bo) + (wid * 2 + 1) * 1024), 16, 0, 0); } while (0)
#define DA_DMA_VB(base, t, bo) do { const size_t _to = (size_t)(t) * (64 * 512 * 2); \
            __builtin_amdgcn_global_load_lds((const unsigned*)((base) + _to + vgo0), (LAS unsigned*)(lds + (bo) + (wid * 2) * 1024), 16, 0, 0); \
            __builtin_amdgcn_global_load_lds((const unsigned*)((base) + _to + vgo1), (LAS unsigned*)(lds + (bo) + (wid * 2 + 1) * 1024), 16, 0, 0); } while (0)
#define DA_DMA_K(t, bo) DA_DMA_KB(Kb, t, bo)
#define DA_DMA_V(t, bo) DA_DMA_VB(Vb, t, bo)
        if (it == 0) { DA_DMA_K(0, 0); DA_DMA_K(1, 16384); DA_DMA_K(2, 32768); DA_DMA_V(0, 65536); DA_DMA_V(1, 81920);
#pragma unroll
            for (int ks = 0; ks < 4; ++ks) qf[ks] = *(const bf16x8*)(Q + qrow * 512 + h * 128 + m * 64 + ks * 16 + hi * 8); }
        f32x16 O[4];
#pragma unroll
        for (int dt = 0; dt < 4; ++dt)
#pragma unroll
            for (int r = 0; r < 16; ++r) O[dt][r] = 0.f;
        float lrun = 0.f; f32x16 negm, s0, s1;
#pragma unroll
        for (int r = 0; r < 16; ++r) negm[r] = 0.f;
        asm volatile("s_waitcnt vmcnt(0) lgkmcnt(0)\n\ts_barrier" ::: "memory");
        if constexpr (m == 1) qk_tile<0>(kq, qf, negm, s0, s1);
#define DA_STEP(tt, KBC, KBN, KB3, VBC, VB2) do { \
            if ((tt) + 3 < NT) DA_DMA_K((tt) + 3, KB3); else DA_DMA_KB(Kbn, (tt) + 3 - NT, KB3); \
            if ((tt) + 2 < NT) DA_DMA_V((tt) + 2, VB2); else DA_DMA_VB(Vbn, (tt) + 2 - NT, VB2); \
            if constexpr (m == 0) { qk_tile<KBC>(kq, qf, negm, s0, s1); softmax_pv<VBC>(lds, vlane, s0, s1, O, negm, lrun); } \
            else { softmax_pv<VBC>(lds, vlane, s0, s1, O, negm, lrun); if ((tt) + 1 < NT) qk_tile<KBN>(kq, qf, negm, s0, s1); } \
            asm volatile("s_waitcnt vmcnt(4) lgkmcnt(0)\n\ts_barrier" ::: "memory"); } while (0)
        for (int t = 0; t < NT; t += 12) {
            DA_STEP(t + 0, 0, 16384, 49152, 65536, 98304);
            DA_STEP(t + 1, 16384, 32768, 0, 81920, 65536);
            DA_STEP(t + 2, 32768, 49152, 16384, 98304, 81920);
            DA_STEP(t + 3, 49152, 0, 32768, 65536, 98304);
            DA_STEP(t + 4, 0, 16384, 49152, 81920, 65536);
            DA_STEP(t + 5, 16384, 32768, 0, 98304, 81920);
            DA_STEP(t + 6, 32768, 49152, 16384, 65536, 98304);
            DA_STEP(t + 7, 49152, 0, 32768, 81920, 65536);
            DA_STEP(t + 8, 0, 16384, 49152, 98304, 81920);
            DA_STEP(t + 9, 16384, 32768, 0, 65536, 98304);
            DA_STEP(t + 10, 32768, 49152, 16384, 81920, 65536);
            DA_STEP(t + 11, 49152, 0, 32768, 98304, 81920);
        }
#undef DA_STEP
        asm volatile("s_waitcnt vmcnt(0) lgkmcnt(0)\n\ts_barrier" ::: "memory");
        if (hasn) { const size_t qrown = (size_t)bn * SEQ + qbn * 128 + qsub * 32 + r32;
#pragma unroll
            for (int ks = 0; ks < 4; ++ks) qf[ks] = *(const bf16x8*)(Q + qrown * 512 + hn * 128 + m * 64 + ks * 16 + hi * 8); }
        const float lt = lrun + __shfl_xor(lrun, 32);
        LAS unsigned char* ereg = lds + 98304 + qsub * 8704;
        LAS unsigned* xch = (LAS unsigned*)ereg + lane;
        if (m == 1) { const float sc = lam / lt;
#pragma unroll
            for (int dt = 0; dt < 4; ++dt)
#pragma unroll
                for (int p = 0; p < 8; ++p) xch[(dt * 8 + p) * 64] = cvtpk(O[dt][2 * p] * sc, O[dt][2 * p + 1] * sc); }
        __syncthreads();
        if (m == 0) { const float i1 = 1.0f / lt; float ss = 0.f;
#pragma unroll
            for (int dt = 0; dt < 4; ++dt)
#pragma unroll
                for (int p = 0; p < 8; ++p) { const unsigned u2 = xch[(dt * 8 + p) * 64]; const float a0 = O[dt][2 * p] * i1 - bflo(u2), a1 = O[dt][2 * p + 1] * i1 - bfhi(u2);
                    O[dt][2 * p] = a0; O[dt][2 * p + 1] = a1; ss += a0 * a0 + a1 * a1; }
            ss += __shfl_xor(ss, 32);
            const float rstd = rsqrtf(ss * (1.0f / 128.0f) + NORM_EPS) * (1.0f - LAMBDA_INIT);
            LAS unsigned char* ost = ereg;
#pragma unroll
            for (int dt = 0; dt < 4; ++dt)
#pragma unroll
                for (int g4 = 0; g4 < 4; ++g4) { const int d0 = 32 * dt + 8 * g4 + 4 * hi; const f32x4 gg = *(const f32x4*)(c.da_subln_g + d0);
                    u32x2 w; w.x = cvtpk(O[dt][4 * g4] * rstd * gg.x, O[dt][4 * g4 + 1] * rstd * gg.y); w.y = cvtpk(O[dt][4 * g4 + 2] * rstd * gg.z, O[dt][4 * g4 + 3] * rstd * gg.w);
                    *(LAS u32x2*)(ost + r32 * 272 + d0 * 2) = w; }
            asm volatile("s_waitcnt lgkmcnt(0)" ::: "memory");
            bf16* obase = MIX + ((size_t)b * SEQ + qb * 128 + qsub * 32) * 1024 + h * 128;
#pragma unroll 2
            for (int i = 0; i < 8; ++i) { const int q = lane + 64 * i, row = q >> 4, ch = q & 15; *(u32x4*)(obase + (size_t)row * 1024 + ch * 8) = *(const LAS u32x4*)(ost + row * 272 + ch * 16); } }
        __syncthreads();
#undef DA_DMA_K
#undef DA_DMA_V
#undef DA_DMA_KB
#undef DA_DMA_VB
    }
    if constexpr (m == 1) __builtin_amdgcn_s_setprio(0);
}
__device__ __forceinline__ void attn_phase(const Ctx& c, LAS unsigned char* lds) {
    if (__builtin_amdgcn_readfirstlane((int)threadIdx.x >> 8) == 0) attn_body<0>(c, lds); else attn_body<1>(c, lds);
}
#undef DA_MFMA
}

namespace gla {
using da::bf16x8; using da::s16x4; using da::f32x16; using da::cvtpk; using da::pack_half; using da::vtr;
#define GL_MFMA(a, b, c) __builtin_amdgcn_mfma_f32_32x32x16_bf16((a), (b), (c), 0, 0, 0)
constexpr int NTASK = NB * 4 * 2 * 36;
constexpr int PT64_BYTES = 8192;
constexpr int PTV_BYTES = 16384;

template <int CTRL, int RM, bool BC> __device__ __forceinline__ float dpp_get(float x) { return __builtin_bit_cast(float, __builtin_amdgcn_update_dpp(0, __builtin_bit_cast(int, x), CTRL, RM, 0xf, BC)); }
__device__ __forceinline__ float scan32(float x) {
    x += dpp_get<0x111, 0xf, true>(x); x += dpp_get<0x112, 0xf, true>(x); x += dpp_get<0x114, 0xf, true>(x); x += dpp_get<0x118, 0xf, true>(x);
    x += dpp_get<0x142, 0xa, false>(x);
    return x; }
__device__ __forceinline__ float last32(float x, int hi) {
    return __builtin_bit_cast(float, __builtin_amdgcn_ds_swizzle(__builtin_bit_cast(int, x), 0x3E0)); }
template <int DK0, int DK1, int G40 = 0, int G41 = 4> __device__ __forceinline__ void g0_task(const Ctx& c, const LAS unsigned char* w2f, const LAS float* gbs, int u, int lane, int r32, int hi) {
    bf16* KE = (bf16*)(c.ws + WS_KEND); bf16* QD = (bf16*)(c.ws + WS_QD); bf16* KI = (bf16*)(c.ws + WS_KI); float* DB = (float*)(c.ws + WS_DB);
        const int cc = u % 36, chain = u / 36, dir = chain & 1, h = (chain >> 1) & 3, b = chain >> 3, bh = chain >> 1;
        const bool lat = cc >= 4;
        const size_t row0 = (size_t)b * KVL + cc * 64 + r32;
        bf16x8 lrh[2], lrl[2];
#pragma unroll
        for (int T = 0; T < 2; ++T) { const float* lr = (const float*)(c.ws + WS_LR) + (row0 + 32 * T) * 32 + dir * 16 + 8 * hi;
            const f32x4 x0 = *(const f32x4*)lr, x1 = *(const f32x4*)(lr + 4);
            u32x4 ph; ph.x = pk2(x0.x, x0.y); ph.y = pk2(x0.z, x0.w); ph.z = pk2(x1.x, x1.y); ph.w = pk2(x1.z, x1.w);
            u32x4 pl; pl.x = pk2(x0.x - bflo(ph.x), x0.y - bfhi(ph.x)); pl.y = pk2(x0.z - bflo(ph.y), x0.w - bfhi(ph.y)); pl.z = pk2(x1.x - bflo(ph.z), x1.y - bfhi(ph.z)); pl.w = pk2(x1.z - bflo(ph.w), x1.w - bfhi(ph.w));
            lrh[T] = __builtin_bit_cast(bf16x8, ph); lrl[T] = __builtin_bit_cast(bf16x8, pl); }
        const bf16* kbase = (const bf16*)(c.ws + WS_GK) + ((size_t)(b * 36 + cc) * 4 + h) * 4096 + r32 * 8 + 4 * hi;
        const bf16* qbase = (const bf16*)(c.ws + WS_GQ) + ((size_t)(b * 32 + (lat ? cc - 4 : 0)) * 4 + h) * 4096 + r32 * 8 + 4 * hi;
        bf16* kebase = KE + (size_t)u * 4096 + r32 * 8 + 4 * hi;
        const size_t qo = ((size_t)(dir * 64 + bh) * 32 + (lat ? cc - 4 : 0)) * 4096 + r32 * 8 + 4 * hi;
#pragma unroll
        for (int Dk = DK0; Dk < DK1; ++Dk) {
            const LAS unsigned char* wf = w2f + (((dir * 4 + h) * 2 + Dk) * 64 + lane) * 32;
            const bf16x8 wh = *(const LAS bf16x8*)wf, wl = *(const LAS bf16x8*)(wf + 16);
            f32x16 z[2];
#pragma unroll
            for (int T = 0; T < 2; ++T) {
#pragma unroll
                for (int r = 0; r < 16; ++r) z[T][r] = 0.f;
                z[T] = GL_MFMA(wh, lrh[T], z[T]); z[T] = GL_MFMA(wl, lrh[T], z[T]); z[T] = GL_MFMA(wh, lrl[T], z[T]); }
            u32x2 kv[2][4], qv[2][4];
#pragma unroll
            for (int T = 0; T < 2; ++T)
#pragma unroll
                for (int g4 = G40; g4 < G41; ++g4) { const int to = (Dk * 4 + g4) * 512 + T * 256; kv[T][g4] = *(const u32x2*)(kbase + to); qv[T][g4] = *(const u32x2*)(qbase + to); }
            float g[2][16], inc[2][16], dtot[16], tot[16];
#pragma unroll
            for (int g4 = G40; g4 < G41; ++g4) { const f32x4 bs = *(const LAS f32x4*)(gbs + dir * 256 + h * 64 + 32 * Dk + 8 * g4 + 4 * hi);
#pragma unroll
                for (int j = 0; j < 4; ++j)
#pragma unroll
                    for (int T = 0; T < 2; ++T) { const float zz = z[T][4 * g4 + j] + bs[j];
                        const float t = __builtin_amdgcn_exp2f(-fabsf(zz) * 1.4426950408889634f);
                        g[T][4 * g4 + j] = (fminf(zz, 0.f) - __builtin_amdgcn_logf(1.0f + t) * 0.6931471805599453f) * (1.0f / 16.0f); } }
#pragma unroll
            for (int r = 4 * G40; r < 4 * G41; ++r) { inc[0][r] = scan32(g[0][r]); const float l0 = last32(inc[0][r], hi); inc[1][r] = scan32(g[1][r]) + l0; tot[r] = last32(inc[1][r], hi); dtot[r] = __builtin_amdgcn_exp2f(tot[r] * 1.4426950408889634f); }
#pragma unroll
            for (int T = 0; T < 2; ++T)
#pragma unroll
                for (int g4 = G40; g4 < G41; ++g4) { const int to = (Dk * 4 + g4) * 512 + T * 256;
                    float eq[4], ek[4], ee[4];
#pragma unroll
                    for (int j = 0; j < 4; ++j) { const int r = 4 * g4 + j; const float bc = dir == 0 ? inc[T][r] : tot[r] - inc[T][r] + g[T][r];
                        eq[j] = __builtin_amdgcn_exp2f(bc * 1.4426950408889634f); ek[j] = __builtin_amdgcn_rcpf(eq[j]); ee[j] = ek[j] * dtot[r]; }
                    const float k0 = bflo(kv[T][g4].x), k1 = bfhi(kv[T][g4].x), k2 = bflo(kv[T][g4].y), k3 = bfhi(kv[T][g4].y);
                    u32x2 e2; e2.x = cvtpk(k0 * ee[0], k1 * ee[1]); e2.y = cvtpk(k2 * ee[2], k3 * ee[3]);
                    *(u32x2*)(kebase + to) = e2;
                    if (lat) { const float q0 = bflo(qv[T][g4].x), q1 = bfhi(qv[T][g4].x), q2 = bflo(qv[T][g4].y), q3 = bfhi(qv[T][g4].y);
                        u32x2 a2, k2v; a2.x = cvtpk(q0 * eq[0], q1 * eq[1]); a2.y = cvtpk(q2 * eq[2], q3 * eq[3]); k2v.x = cvtpk(k0 * ek[0], k1 * ek[1]); k2v.y = cvtpk(k2 * ek[2], k3 * ek[3]);
                        *(u32x2*)(QD + qo + to) = a2; *(u32x2*)(KI + qo + to) = k2v; } }
            if (r32 == 0) {
#pragma unroll
                for (int g4 = G40; g4 < G41; ++g4) *(f32x4*)(DB + (size_t)u * 64 + 32 * Dk + 8 * g4 + 4 * hi) = (f32x4){dtot[4 * g4], dtot[4 * g4 + 1], dtot[4 * g4 + 2], dtot[4 * g4 + 3]}; }
        }
    }
__device__ __forceinline__ void g0_phase(const Ctx& c, LAS unsigned char* lds) {
    const int tid = threadIdx.x, lane = tid & 63, w = __builtin_amdgcn_readfirstlane(tid >> 6), r32 = lane & 31, hi = lane >> 5;
    LAS unsigned char* w2f = lds;
    LAS float* gbs = (LAS float*)(lds + 32768);
    for (int q = tid; q < 16 * 64; q += 512) { const int combo = q >> 6, l = q & 63, dir = combo >> 3, h = (combo >> 1) & 3, Dk = combo & 1, dk = h * 64 + 32 * Dk + (l & 31), hh = l >> 5;
        float v[8];
#pragma unroll
        for (int j = 0; j < 8; ++j) v[j] = c.gate_w2[(dir * 16 + 8 * hh + j) * 256 + dk];
        u32x4 ph; ph.x = pk2(v[0], v[1]); ph.y = pk2(v[2], v[3]); ph.z = pk2(v[4], v[5]); ph.w = pk2(v[6], v[7]);
        u32x4 pl; pl.x = pk2(v[0] - bflo(ph.x), v[1] - bfhi(ph.x)); pl.y = pk2(v[2] - bflo(ph.y), v[3] - bfhi(ph.y)); pl.z = pk2(v[4] - bflo(ph.z), v[5] - bfhi(ph.z)); pl.w = pk2(v[6] - bflo(ph.w), v[7] - bfhi(ph.w));
        *(LAS u32x4*)(w2f + q * 32) = ph; *(LAS u32x4*)(w2f + q * 32 + 16) = pl; }
    if (tid < 128) *(LAS f32x4*)(gbs + 4 * tid) = *(const f32x4*)(c.gate_b + 4 * tid);
    __syncthreads();
    const int gwv = blockIdx.x * 8 + w, ngw = gridDim.x * 8, nfull = (NTASK / ngw) * ngw;
    for (int u = gwv; u < nfull; u += ngw) g0_task<0, 2>(c, w2f, gbs, u, lane, r32, hi);
    for (int uq = gwv; uq < 4 * (NTASK - nfull); uq += ngw) { const int tsk = nfull + (uq >> 2), part = uq & 3;
        if (part == 0) g0_task<0, 1, 0, 2>(c, w2f, gbs, tsk, lane, r32, hi); else if (part == 1) g0_task<0, 1, 2, 4>(c, w2f, gbs, tsk, lane, r32, hi);
        else if (part == 2) g0_task<1, 2, 0, 2>(c, w2f, gbs, tsk, lane, r32, hi); else g0_task<1, 2, 2, 4>(c, w2f, gbs, tsk, lane, r32, hi); }
    __syncthreads();
}
__device__ __forceinline__ void dma_piece(const bf16* base, int pitch, int p, LAS unsigned char* dst, int lane) {
    __builtin_amdgcn_global_load_lds((const unsigned*)(base + (size_t)((p & 3) * 16 + (lane >> 2)) * pitch + (p >> 2) * 32 + (lane & 3) * 8), (LAS unsigned*)(dst + p * 1024), 16, 0, 0);
}
__device__ __forceinline__ void dma_chunk(const bf16* tile, int row0, int ch, LAS unsigned char* dst, int lane) {
    __builtin_amdgcn_global_load_lds((const unsigned*)(tile + ch * 512 + (row0 + lane) * 8), (LAS unsigned*)dst, 16, 0, 0);
}
__device__ __forceinline__ void dma_piece_t(const bf16* tile, int p, LAS unsigned char* dst, int lane) {
    __builtin_amdgcn_global_load_lds((const unsigned*)(tile + ((p >> 2) * 4 + (lane & 3)) * 512 + ((p & 3) * 16 + (lane >> 2)) * 8), (LAS unsigned*)(dst + p * 1024), 16, 0, 0);
}
__device__ __forceinline__ void g1_phase(const Ctx& c, LAS unsigned char* lds) {
    const int tid = threadIdx.x, lane = tid & 63, w = __builtin_amdgcn_readfirstlane(tid >> 6), hi = lane >> 5, dir = w >> 2, dvt = w & 3;
    const int vlane = (4 * hi + ((lane & 15) >> 2)) * 64 + ((lane >> 4) & 1) * 32 + (lane & 3) * 8;
    const bf16* KE = (const bf16*)(c.ws + WS_KEND); const bf16* GV = (const bf16*)(c.ws + WS_GV); bf16* UT = (bf16*)(c.ws + WS_UT);
    constexpr int BUF = 32768;
    const int nun = NB * 4 * 36, G = (int)gridDim.x;
#define G1_STAGE(un, bo) do { const int _cc = (un) % 36, _bh = (un) / 36, _b = _bh >> 2, _h = _bh & 3; \
        dma_piece(GV + ((size_t)_b * KVL + _cc * 64) * 512 + _h * 128, 512, w * 2, lds + (bo), lane); dma_piece(GV + ((size_t)_b * KVL + _cc * 64) * 512 + _h * 128, 512, w * 2 + 1, lds + (bo), lane); \
        dma_piece_t(KE + ((size_t)(_bh * 2) * 36 + _cc) * 4096, w, lds + (bo) + 16384, lane); dma_piece_t(KE + ((size_t)(_bh * 2 + 1) * 36 + _cc) * 4096, w, lds + (bo) + 24576, lane); } while (0)
#define G1_RD(dst, base, off) asm volatile("ds_read_b64_tr_b16 %0, %1 offset:%2" : "=&v"(dst) : "v"(base), "n"(off) : "memory")
    int un = blockIdx.x;
    if (un >= nun) return;
    G1_STAGE(un, 0); { const int u1 = un + G < nun ? un + G : un; G1_STAGE(u1, BUF); }
    int slot = 0;
    for (int it = 0; un < nun; un += G, ++it) {
        if (it == 0) asm volatile("s_waitcnt vmcnt(4)" ::: "memory"); else if (it == 1) asm volatile("s_waitcnt vmcnt(12)" ::: "memory"); else asm volatile("s_waitcnt vmcnt(20)" ::: "memory");
        __builtin_amdgcn_s_barrier(); asm volatile("" ::: "memory");
        { const int u2 = un + 2 * G < nun ? un + 2 * G : un; const int s2 = slot >= 1 ? slot - 1 : 2; G1_STAGE(u2, s2 * BUF); }
        const int cc = un % 36, bh = un / 36;
        const unsigned vb = (unsigned)(slot * BUF + dvt * 4096 + vlane), ka = (unsigned)(slot * BUF + 16384 + dir * 8192 + vlane);
        s16x4 fb[4][2], fa[2][4][2];
#pragma unroll
        for (int ks = 0; ks < 4; ++ks) { G1_RD(fb[ks][0], vb, ks * 1024); G1_RD(fb[ks][1], vb, ks * 1024 + 512);
#pragma unroll
            for (int dkt = 0; dkt < 2; ++dkt) { G1_RD(fa[dkt][ks][0], ka, (dkt * 4 + ks) * 1024); G1_RD(fa[dkt][ks][1], ka, (dkt * 4 + ks) * 1024 + 512); } }
        asm volatile("s_waitcnt lgkmcnt(0)" : "+v"(fb[0][0]), "+v"(fb[0][1]), "+v"(fb[1][0]), "+v"(fb[1][1]), "+v"(fb[2][0]), "+v"(fb[2][1]), "+v"(fb[3][0]), "+v"(fb[3][1]),
            "+v"(fa[0][0][0]), "+v"(fa[0][0][1]), "+v"(fa[0][1][0]), "+v"(fa[0][1][1]), "+v"(fa[0][2][0]), "+v"(fa[0][2][1]), "+v"(fa[0][3][0]), "+v"(fa[0][3][1]),
            "+v"(fa[1][0][0]), "+v"(fa[1][0][1]), "+v"(fa[1][1][0]), "+v"(fa[1][1][1]), "+v"(fa[1][2][0]), "+v"(fa[1][2][1]), "+v"(fa[1][3][0]), "+v"(fa[1][3][1]) :: "memory");
        f32x16 U[2];
#pragma unroll
        for (int dkt = 0; dkt < 2; ++dkt)
#pragma unroll
            for (int r = 0; r < 16; ++r) U[dkt][r] = 0.f;
#pragma unroll
        for (int ks = 0; ks < 4; ++ks) { const bf16x8 bfr = __builtin_shufflevector(fb[ks][0], fb[ks][1], 0, 1, 2, 3, 4, 5, 6, 7);
#pragma unroll
            for (int dkt = 0; dkt < 2; ++dkt) U[dkt] = GL_MFMA(__builtin_shufflevector(fa[dkt][ks][0], fa[dkt][ks][1], 0, 1, 2, 3, 4, 5, 6, 7), bfr, U[dkt]); }
        const size_t task = ((size_t)(bh * 2 + dir)) * 36 + cc;
#pragma unroll
        for (int dkt = 0; dkt < 2; ++dkt) { bf16* up = UT + task * 8192 + (size_t)(dvt * 2048 + dkt * 1024 + (lane & 31) * 8 + 4 * hi);
#pragma unroll
            for (int g4 = 0; g4 < 4; ++g4) { u32x2 wv; wv.x = cvtpk(U[dkt][4 * g4], U[dkt][4 * g4 + 1]); wv.y = cvtpk(U[dkt][4 * g4 + 2], U[dkt][4 * g4 + 3]);
                asm volatile("global_store_dwordx2 %0, %1, off" :: "v"(up + 256 * g4), "v"(wv) : "memory"); } }
        slot = slot == 2 ? 0 : slot + 1;
    }
    asm volatile("s_waitcnt vmcnt(0)" ::: "memory"); __syncthreads();
#undef G1_STAGE
#undef G1_RD
}
__device__ __forceinline__ void g12_phase(const Ctx& c, LAS unsigned char* lds) {
    const int tid = threadIdx.x, lane = tid & 63, w = __builtin_amdgcn_readfirstlane(tid >> 6), hi = lane >> 5;
    const int vlane = (4 * hi + ((lane & 15) >> 2)) * 64 + ((lane >> 4) & 1) * 32 + (lane & 3) * 8;
    const bf16* KE = (const bf16*)(c.ws + WS_KEND); const bf16* GV = (const bf16*)(c.ws + WS_GV); bf16* ST = (bf16*)(c.ws + WS_ST); const float* DB = (const float*)(c.ws + WS_DB);
    bf16* DUMP = (bf16*)(c.ws + WS_UT) + (size_t)blockIdx.x * 8192;
    constexpr int SLOT = 16384;
    LAS float* dbl = (LAS float*)(lds + 3 * SLOT);
#define G12_CC(s) (dir == 0 ? (s) : ((s) < 4 ? 3 - (s) : 39 - (s)))
#define G12_STAGE(s, so) do { const int _cc = G12_CC(s); dma_piece(GV + ((size_t)b * KVL + _cc * 64) * 512 + h * 128 + dvh * 64, 512, w, lds + (so), lane); \
        dma_piece_t(KE + ((size_t)chain * 36 + _cc) * 4096, w, lds + (so) + 8192, lane); } while (0)
#define G12_RD(dst, base, off) asm volatile("ds_read_b64_tr_b16 %0, %1 offset:%2" : "=&v"(dst) : "v"(base), "n"(off) : "memory")
    for (int job = blockIdx.x; job < 256; job += gridDim.x) {
        const int dvh = (job >> 3) & 1, chain = (job >> 4) * 8 + (job & 7), dir = chain & 1, bh = chain >> 1, b = bh >> 2, h = bh & 3;
        __syncthreads();
        for (int i = tid; i < 576; i += 512) *(LAS f32x4*)(dbl + 4 * i) = *(const f32x4*)(DB + (size_t)chain * 36 * 64 + 4 * i);
        __syncthreads();
        G12_STAGE(0, 0); G12_STAGE(1, SLOT);
        f32x16 S;
#pragma unroll
        for (int r = 0; r < 16; ++r) S[r] = 0.f;
        const int dvl = (w >> 1) & 1, dkt = w & 1;
        int slot = 0;
        for (int s = 0; s < 36; ++s) {
            if (w < 4) { if (s == 0) asm volatile("s_waitcnt vmcnt(2)" ::: "memory"); else if (s == 1) asm volatile("s_waitcnt vmcnt(6)" ::: "memory"); else asm volatile("s_waitcnt vmcnt(10)" ::: "memory"); }
            else asm volatile("s_waitcnt vmcnt(2)" ::: "memory");
            __builtin_amdgcn_s_barrier(); asm volatile("" ::: "memory");
            { const int s2 = s + 2 < 36 ? s + 2 : s; const int sl2 = slot >= 1 ? slot - 1 : 2; G12_STAGE(s2, sl2 * SLOT); }
            if (w < 4) {
                const int cc = G12_CC(s);
                const unsigned vb = (unsigned)(slot * SLOT + dvl * 4096 + vlane), ka = (unsigned)(slot * SLOT + 8192 + dkt * 4096 + vlane);
                s16x4 fb[4][2], fa[4][2];
#pragma unroll
                for (int ks = 0; ks < 4; ++ks) { G12_RD(fb[ks][0], vb, ks * 1024); G12_RD(fb[ks][1], vb, ks * 1024 + 512); G12_RD(fa[ks][0], ka, ks * 1024); G12_RD(fa[ks][1], ka, ks * 1024 + 512); }
                asm volatile("s_waitcnt lgkmcnt(0)" : "+v"(fb[0][0]), "+v"(fb[0][1]), "+v"(fb[1][0]), "+v"(fb[1][1]), "+v"(fb[2][0]), "+v"(fb[2][1]), "+v"(fb[3][0]), "+v"(fb[3][1]),
                    "+v"(fa[0][0]), "+v"(fa[0][1]), "+v"(fa[1][0]), "+v"(fa[1][1]), "+v"(fa[2][0]), "+v"(fa[2][1]), "+v"(fa[3][0]), "+v"(fa[3][1]) :: "memory");
                f32x16 U;
#pragma unroll
                for (int r = 0; r < 16; ++r) U[r] = 0.f;
#pragma unroll
                for (int ks = 0; ks < 4; ++ks) U = GL_MFMA(__builtin_shufflevector(fa[ks][0], fa[ks][1], 0, 1, 2, 3, 4, 5, 6, 7), __builtin_shufflevector(fb[ks][0], fb[ks][1], 0, 1, 2, 3, 4, 5, 6, 7), U);
                bf16* sp = (cc >= 4 ? ST + ((size_t)(dir * 64 + bh) * 32 + (cc - 4)) * 8192 : DUMP) + (size_t)((dvh * 2 + dvl) * 2048 + dkt * 1024 + (lane & 31) * 8 + 4 * hi);
#pragma unroll
                for (int g4 = 0; g4 < 4; ++g4) { u32x2 wv; wv.x = cvtpk(S[4 * g4], S[4 * g4 + 1]); wv.y = cvtpk(S[4 * g4 + 2], S[4 * g4 + 3]);
                    asm volatile("global_store_dwordx2 %0, %1, off" :: "v"(sp + 256 * g4), "v"(wv) : "memory"); }
#pragma unroll
                for (int g4 = 0; g4 < 4; ++g4) { const f32x4 d = *(const LAS f32x4*)(dbl + cc * 64 + dkt * 32 + 8 * g4 + 4 * hi);
                    S[4 * g4] = S[4 * g4] * d.x + U[4 * g4]; S[4 * g4 + 1] = S[4 * g4 + 1] * d.y + U[4 * g4 + 1]; S[4 * g4 + 2] = S[4 * g4 + 2] * d.z + U[4 * g4 + 2]; S[4 * g4 + 3] = S[4 * g4 + 3] * d.w + U[4 * g4 + 3]; }
            }
            slot = slot == 2 ? 0 : slot + 1;
        }
        asm volatile("s_waitcnt vmcnt(0)" ::: "memory");
    }
    __syncthreads();
#undef G12_CC
#undef G12_STAGE
#undef G12_RD
}
__device__ __forceinline__ void g2_phase(const Ctx& c) {
    const bf16* UT = (const bf16*)(c.ws + WS_UT); const float* DB = (const float*)(c.ws + WS_DB); bf16* ST = (bf16*)(c.ws + WS_ST);
    for (int i = blockIdx.x * blockDim.x + threadIdx.x; i < 128 * 1024; i += gridDim.x * blockDim.x) {
        const int chain = i >> 10, e8 = i & 1023, dk0 = ((e8 >> 5) & 7) * 8, dir = chain & 1, bh = chain >> 1;
        float S[8];
#pragma unroll
        for (int j = 0; j < 8; ++j) S[j] = 0.f;
        u32x4 ua[6], ub[6]; f32x4 da[6][2], db[6][2];
#define G2_CC(s) (dir == 0 ? (s) : ((s) < 4 ? 3 - (s) : 39 - (s)))
#define G2_LOAD(U, D, blk) _Pragma("unroll") for (int j = 0; j < 6; ++j) { const size_t u = (size_t)chain * 36 + G2_CC((blk) * 6 + j); \
            U[j] = *(const u32x4*)(UT + u * 8192 + (size_t)e8 * 8); D[j][0] = *(const f32x4*)(DB + u * 64 + dk0); D[j][1] = *(const f32x4*)(DB + u * 64 + dk0 + 4); }
#define G2_PROC(U, D, blk) _Pragma("unroll") for (int j = 0; j < 6; ++j) { const int cc = G2_CC((blk) * 6 + j); \
            if (cc >= 4) { u32x4 o; o.x = cvtpk(S[0], S[1]); o.y = cvtpk(S[2], S[3]); o.z = cvtpk(S[4], S[5]); o.w = cvtpk(S[6], S[7]); \
                *(u32x4*)(ST + ((size_t)(dir * 64 + bh) * 32 + (cc - 4)) * 8192 + (size_t)e8 * 8) = o; } \
            S[0] = S[0] * D[j][0].x + bflo(U[j].x); S[1] = S[1] * D[j][0].y + bfhi(U[j].x); S[2] = S[2] * D[j][0].z + bflo(U[j].y); S[3] = S[3] * D[j][0].w + bfhi(U[j].y); \
            S[4] = S[4] * D[j][1].x + bflo(U[j].z); S[5] = S[5] * D[j][1].y + bfhi(U[j].z); S[6] = S[6] * D[j][1].z + bflo(U[j].w); S[7] = S[7] * D[j][1].w + bfhi(U[j].w); }
        G2_LOAD(ua, da, 0)
        G2_LOAD(ub, db, 1) G2_PROC(ua, da, 0)
        G2_LOAD(ua, da, 2) G2_PROC(ub, db, 1)
        G2_LOAD(ub, db, 3) G2_PROC(ua, da, 2)
        G2_LOAD(ua, da, 4) G2_PROC(ub, db, 3)
        G2_LOAD(ub, db, 5) G2_PROC(ua, da, 4)
        G2_PROC(ub, db, 5)
#undef G2_CC
#undef G2_LOAD
#undef G2_PROC
    }
}
__device__ __forceinline__ void g3_phase(const Ctx& c, LAS unsigned char* lds) {
    const int tid = threadIdx.x, lane = tid & 63, w = __builtin_amdgcn_readfirstlane(tid >> 6), r32 = lane & 31, hi = lane >> 5, ih = w >> 2, dq = w & 3;
    const int vlane = (4 * hi + ((lane & 15) >> 2)) * 64 + ((lane >> 4) & 1) * 32 + (lane & 3) * 8;
    const bf16* ST = (const bf16*)(c.ws + WS_ST); const bf16* GR = (const bf16*)(c.ws + WS_GR); const bf16* GV = (const bf16*)(c.ws + WS_GV); bf16* MIX = (bf16*)(c.ws + WS_MIX);
    const bf16* QD = (const bf16*)(c.ws + WS_QD); const bf16* KI = (const bf16*)(c.ws + WS_KI);
    constexpr int BUF = 49152;
    LAS float* ssx = (LAS float*)(lds + 2 * BUF);
    const int nun = NB * 4 * 32;
#define G3_STAGE(un, bo) do { const int _cl = (un) & 31, _bh = (un) >> 5, _b = _bh >> 2, _h = _bh & 3; \
        dma_piece(GV + ((size_t)_b * KVL + (_cl + 4) * 64) * 512 + _h * 128, 512, w * 2, lds + (bo), lane); dma_piece(GV + ((size_t)_b * KVL + (_cl + 4) * 64) * 512 + _h * 128, 512, w * 2 + 1, lds + (bo), lane); \
        _Pragma("unroll") for (int _d = 0; _d < 2; ++_d) { const size_t _tb = ((size_t)(_d * 64 + _bh) * 32 + _cl) * 4096; \
            dma_chunk(QD + _tb, 0, w, lds + (bo) + 16384 + _d * 8192 + w * 1024, lane); dma_chunk(KI + _tb, 0, w, lds + (bo) + 32768 + _d * 8192 + w * 1024, lane); } } while (0)
#define G3_LOADS(u_, sa_, gr_) do { const int _cl = (u_) & 31, _bh = (u_) >> 5, _b = _bh >> 2, _h = _bh & 3; const size_t _tl = (size_t)_b * SEQ + _cl * 64 + ih * 32 + r32; \
        _Pragma("unroll") for (int _d = 0; _d < 2; ++_d) _Pragma("unroll") for (int _k = 0; _k < 4; ++_k) sa_[_d][_k] = *(const bf16x8*)(ST + ((size_t)(_d * 64 + _bh) * 32 + _cl) * 8192 + (size_t)(((dq * 4 + _k) * 2 + hi) * 32 + r32) * 8); \
        _Pragma("unroll") for (int _g = 0; _g < 4; ++_g) gr_[_g] = *(const u32x2*)(GR + ((size_t)(((_b * 32 + _cl) * 4 + _h) * 16 + dq * 4 + _g) * 512 + (ih * 32 + r32) * 8 + 4 * hi)); } while (0)
    int un = blockIdx.x, par = 0;
    bf16x8 sa[2][4], san[2][4]; u32x2 gr[4], grn[4];
    f32x4 gnv[4];
#pragma unroll
    for (int g4 = 0; g4 < 4; ++g4) gnv[g4] = *(const f32x4*)(c.gla_norm_g + dq * 32 + 8 * g4 + 4 * hi);
    if (un < nun) { G3_LOADS(un, sa, gr); G3_STAGE(un, 0); }
    asm volatile("s_waitcnt vmcnt(0)" ::: "memory"); __syncthreads();
    for (; un < nun; un += gridDim.x, par ^= 1) {
        const int bo = par * BUF, nx = un + (int)gridDim.x;
        const int cl = un & 31, bh = un >> 5, b = bh >> 2, h = bh & 3;
        const size_t tl = (size_t)b * SEQ + cl * 64 + ih * 32 + r32;
        if (nx < nun) { G3_LOADS(nx, san, grn); G3_STAGE(nx, BUF - bo); }
        const LAS unsigned char* vpt = lds + bo; const LAS unsigned char* qimg = lds + bo + 16384; const LAS unsigned char* kimg = lds + bo + 32768;
        f32x16 At[2];
#pragma unroll
        for (int jt = 0; jt < 2; ++jt)
#pragma unroll
            for (int r = 0; r < 16; ++r) At[jt][r] = 0.f;
        bf16x8 qf[2][4];
#pragma unroll
        for (int dir = 0; dir < 2; ++dir) {
#pragma unroll
            for (int ks = 0; ks < 4; ++ks) qf[dir][ks] = *(const LAS bf16x8*)(qimg + dir * 8192 + (2 * ks + hi) * 1024 + (ih * 32 + r32) * 16);
#pragma unroll
            for (int jt = 0; jt < 2; ++jt) { f32x16 T;
#pragma unroll
                for (int r = 0; r < 16; ++r) T[r] = 0.f;
#pragma unroll
                for (int ks = 0; ks < 4; ++ks) { const bf16x8 a = *(const LAS bf16x8*)(kimg + dir * 8192 + (2 * ks + hi) * 1024 + (jt * 32 + r32) * 16); T = GL_MFMA(a, qf[dir][ks], T); }
                const int icol = ih * 32 + r32;
#pragma unroll
                for (int r = 0; r < 16; ++r) { const int j = jt * 32 + (r & 3) + 8 * (r >> 2) + 4 * hi; const bool keep = dir == 0 ? (j <= icol) : (j >= icol); At[jt][r] += keep ? T[r] : 0.f; } }
        }
        bf16x8 P[4];
        P[0] = pack_half(At[0], 0); P[1] = pack_half(At[0], 1); P[2] = pack_half(At[1], 0); P[3] = pack_half(At[1], 1);
        f32x16 O;
#pragma unroll
        for (int r = 0; r < 16; ++r) O[r] = 0.f;
        {
            const unsigned vb = (unsigned)(size_t)(vpt + dq * 4096 + vlane); s16x4 fv[8];
#pragma unroll
            for (int ks = 0; ks < 4; ++ks) { asm volatile("ds_read_b64_tr_b16 %0, %1 offset:%2" : "=&v"(fv[2 * ks]) : "v"(vb), "n"(ks * 1024) : "memory");
                                             asm volatile("ds_read_b64_tr_b16 %0, %1 offset:%2" : "=&v"(fv[2 * ks + 1]) : "v"(vb), "n"(ks * 1024 + 512) : "memory"); }
            asm volatile("s_waitcnt lgkmcnt(0)" : "+v"(fv[0]), "+v"(fv[1]), "+v"(fv[2]), "+v"(fv[3]), "+v"(fv[4]), "+v"(fv[5]), "+v"(fv[6]), "+v"(fv[7]) :: "memory");
#pragma unroll
            for (int ks = 0; ks < 4; ++ks) O = GL_MFMA(__builtin_shufflevector(fv[2 * ks], fv[2 * ks + 1], 0, 1, 2, 3, 4, 5, 6, 7), P[ks], O); }
#pragma unroll
        for (int dir = 0; dir < 2; ++dir)
#pragma unroll
            for (int ks = 0; ks < 4; ++ks) O = GL_MFMA(sa[dir][ks], qf[dir][ks], O);
        float ss = 0.f;
#pragma unroll
        for (int r = 0; r < 16; ++r) ss += O[r] * O[r];
        ss += __shfl_xor(ss, 32);
        if (hi == 0) ssx[dq * 64 + ih * 32 + r32] = ss;
        __syncthreads();
        const int tokl = ih * 32 + r32; const float tot = ssx[tokl] + ssx[64 + tokl] + ssx[128 + tokl] + ssx[192 + tokl];
        const float rstd = rsqrtf(tot * (1.0f / 128.0f) + NORM_EPS);
#pragma unroll
        for (int g4 = 0; g4 < 4; ++g4) { const int dv = dq * 32 + 8 * g4 + 4 * hi; const f32x4 gn = gnv[g4];
            u32x2 wv; wv.x = cvtpk(O[4 * g4] * rstd * gn.x * silu_f(bflo(gr[g4].x)), O[4 * g4 + 1] * rstd * gn.y * silu_f(bfhi(gr[g4].x)));
            wv.y = cvtpk(O[4 * g4 + 2] * rstd * gn.z * silu_f(bflo(gr[g4].y)), O[4 * g4 + 3] * rstd * gn.w * silu_f(bfhi(gr[g4].y)));
            *(LAS u32x2*)(lds + bo + tokl * 272 + dv * 2) = wv; }
        __syncthreads();
        u32x4 ov[2];
#pragma unroll
        for (int i = 0; i < 2; ++i) { const int q = tid + 512 * i, row = q >> 4, ch = q & 15; ov[i] = *(const LAS u32x4*)(lds + bo + row * 272 + ch * 16); }
        asm volatile("s_waitcnt vmcnt(0)" ::: "memory");
#pragma unroll
        for (int i = 0; i < 2; ++i) { const int q = tid + 512 * i, row = q >> 4, ch = q & 15; *(u32x4*)(MIX + ((size_t)b * SEQ + cl * 64 + row) * 1024 + 512 + h * 128 + ch * 8) = ov[i]; }
        asm volatile("s_waitcnt lgkmcnt(0)" ::: "memory"); __builtin_amdgcn_s_barrier(); asm volatile("" ::: "memory");
#pragma unroll
        for (int d = 0; d < 2; ++d)
#pragma unroll
            for (int k = 0; k < 4; ++k) sa[d][k] = san[d][k];
#pragma unroll
        for (int g4 = 0; g4 < 4; ++g4) gr[g4] = grn[g4];
    }
#undef G3_STAGE
#undef G3_LOADS
}
#undef GL_MFMA
}

template <bool DRY> __device__ __forceinline__ void ph_router(const Ctx& c, LAS unsigned char* lds) {
    typedef short bf16x8 __attribute__((ext_vector_type(8)));
    const int tid = threadIdx.x, lane = tid & 63, wave = __builtin_amdgcn_readfirstlane(tid >> 6), tk = lane & 15, kg = lane >> 4;
    const float* MOD = (const float*)(c.ws + WS_MOD); const bf16* X1 = (const bf16*)(c.ws + WS_X1); bf16* H2 = (bf16*)(c.ws + WS_H2);
    const bf16* WRT = (const bf16*)(c.ws + WS_WRT);
    int* ROUTE = (int*)(c.ws + WS_ROUTE); int* LIST = (int*)(c.ws + WS_LIST); unsigned* ctl = (unsigned*)(c.ws + WS_CTL);
    constexpr int WROW = 1040, WHALF = 36 * WROW;
    LAS unsigned char* whi = lds; LAS unsigned char* wlo = lds + WHALF;
    LAS int* bcnt = (LAS int*)(lds + 2 * WHALF);
    LAS int* rt = bcnt + 64;
    LAS float* mA = (LAS float*)(lds + 2 * WHALF + 256 + 3072); LAS float* mB = mA + 512;
    for (int base = blockIdx.x * 128; base < NTOK; base += gridDim.x * 128) {
        if (tid < 32) bcnt[tid] = 0;
        const int lt = wave * 16 + tk, tok = base + lt, bb = tok / SEQ;
        const bf16* xr = X1 + (size_t)tok * DM + 8 * kg;
        u32x4 xw[16];
#pragma unroll
        for (int s = 0; s < 16; ++s) xw[s] = *(const u32x4*)(xr + 32 * s);
        f32x4 acc[3];
#pragma unroll
        for (int ct = 0; ct < 3; ++ct) acc[ct] = (f32x4){0.f, 0.f, 0.f, 0.f};
        const int arow0 = tk, arow1 = 16 + tk, arow2 = (32 + tk) < 36 ? 32 + tk : 35;
        float rstd; { const float* sp = (const float*)(c.ws + WS_SSP) + (size_t)tok * 16; const f32x4 p0 = *(const f32x4*)sp, p1 = *(const f32x4*)(sp + 4), p2 = *(const f32x4*)(sp + 8), p3 = *(const f32x4*)(sp + 12);
            const float ss = (((p0.x + p0.y) + (p0.z + p0.w)) + ((p1.x + p1.y) + (p1.z + p1.w))) + (((p2.x + p2.y) + (p2.z + p2.w)) + ((p3.x + p3.y) + (p3.z + p3.w)));
            rstd = rsqrtf(ss * (1.0f / DM) + NORM_EPS); }
        u32x4 wv[9];
#define RT_WLOAD(kh_) _Pragma("unroll") for (int j = 0; j < 9; ++j) { const int q = tid + 512 * j, which = q / 2304, r = (q % 2304) >> 6, ch = q & 63; wv[j] = *(const u32x4*)(WRT + (size_t)which * 36 * 1024 + r * 1024 + (kh_) * 512 + ch * 8); }
        RT_WLOAD(0)
        for (int kh = 0; kh < 2; ++kh) {
            __syncthreads();
#pragma unroll
            for (int j = 0; j < 9; ++j) { const int q = tid + 512 * j, which = q / 2304, r = (q % 2304) >> 6, ch = q & 63; *(LAS u32x4*)((which ? wlo : whi) + r * WROW + ch * 16) = wv[j]; }
            if (kh == 0) { RT_WLOAD(1) }
            { const int k = kh * 512 + tid; mA[tid] = c.g_ffn[k] * (MOD[bb * 6144 + 4096 + k] + 1.0f); mB[tid] = MOD[bb * 6144 + 3072 + k]; }
            __syncthreads();
#pragma unroll
            for (int s = 0; s < 16; ++s) { const int ko = kh * 512 + 32 * s;
                const f32x4 x0 = {bflo(xw[s].x), bfhi(xw[s].x), bflo(xw[s].y), bfhi(xw[s].y)}, x1 = {bflo(xw[s].z), bfhi(xw[s].z), bflo(xw[s].w), bfhi(xw[s].w)};
                const f32x4 a0 = *(const LAS f32x4*)(mA + 32 * s + 8 * kg), a1 = *(const LAS f32x4*)(mA + 32 * s + 8 * kg + 4), h0 = *(const LAS f32x4*)(mB + 32 * s + 8 * kg), h1 = *(const LAS f32x4*)(mB + 32 * s + 8 * kg + 4);
                const f32x4 u0 = (x0 * rstd) * a0 + h0, u1 = (x1 * rstd) * a1 + h1;
                u32x4 hw; hw.x = pk2(u0.x, u0.y); hw.y = pk2(u0.z, u0.w); hw.z = pk2(u1.x, u1.y); hw.w = pk2(u1.z, u1.w);
                *(u32x4*)(H2 + (size_t)tok * DM + 8 * kg + ko) = hw;
                u32x4 lw; lw.x = pk2(u0.x - bflo(hw.x), u0.y - bfhi(hw.x)); lw.y = pk2(u0.z - bflo(hw.y), u0.w - bfhi(hw.y)); lw.z = pk2(u1.x - bflo(hw.z), u1.y - bfhi(hw.z)); lw.w = pk2(u1.z - bflo(hw.w), u1.w - bfhi(hw.w));
                const bf16x8 uh = __builtin_bit_cast(bf16x8, hw), ul = __builtin_bit_cast(bf16x8, lw);
                const int co = (32 * s + 8 * kg) * 2;
#pragma unroll
                for (int ct = 0; ct < 3; ++ct) { const int ar = ct == 0 ? arow0 : (ct == 1 ? arow1 : arow2);
                    const bf16x8 ah = *(const LAS bf16x8*)(whi + ar * WROW + co), al = *(const LAS bf16x8*)(wlo + ar * WROW + co);
                    acc[ct] = __builtin_amdgcn_mfma_f32_16x16x32_bf16(ah, uh, acc[ct], 0, 0, 0);
                    acc[ct] = __builtin_amdgcn_mfma_f32_16x16x32_bf16(al, uh, acc[ct], 0, 0, 0);
                    acc[ct] = __builtin_amdgcn_mfma_f32_16x16x32_bf16(ah, ul, acc[ct], 0, 0, 0); }
            }
            if (kh == 0) {
#pragma unroll
                for (int s = 0; s < 16; ++s) xw[s] = *(const u32x4*)(xr + 512 + 32 * s); }
        }
        float gl[4];
#pragma unroll
        for (int j = 0; j < 4; ++j) gl[j] = __shfl(acc[2][j] + c.b_rg[j], tk);
        int gs = 0; float gm = gl[0];
#pragma unroll
        for (int n = 1; n < 4; ++n) if (gl[n] > gm) { gm = gl[n]; gs = n; }
        float gden = 0.f;
#pragma unroll
        for (int n = 0; n < 4; ++n) gden += expf(gl[n] - gm);
        const float gw_ = 1.0f / gden;
        float cand[4];
#pragma unroll
        for (int j = 0; j < 4; ++j) { const int n = 16 * (gs >> 1) + 4 * kg + j; cand[j] = ((gs >> 1) ? acc[1][j] : acc[0][j]) + c.b_re[n]; }
        float el[8]; const int srcl = tk + 32 * (gs & 1);
#pragma unroll
        for (int j = 0; j < 4; ++j) { el[j] = __shfl(cand[j], srcl); el[4 + j] = __shfl(cand[j], srcl + 16); }
        int i0 = 0; float v0 = el[0];
#pragma unroll
        for (int n = 1; n < 8; ++n) if (el[n] > v0) { v0 = el[n]; i0 = n; }
        int i1 = i0 == 0 ? 1 : 0; float v1 = i0 == 0 ? el[1] : el[0];
#pragma unroll
        for (int n = 1; n < 8; ++n) if (n != i0 && el[n] > v1) { v1 = el[n]; i1 = n; }
        const float e1 = expf(v1 - v0), den = 1.0f + e1; const float w0 = gw_ / den, w1 = gw_ * e1 / den;
        if (DRY) { asm volatile("" :: "v"(w0), "v"(w1), "v"(i0), "v"(i1)); }
        if (kg == 0 && !DRY) { const int e0g = gs * 8 + i0, e1g = gs * 8 + i1; const int r0 = atomicAdd((int*)&bcnt[e0g], 1), r1 = atomicAdd((int*)&bcnt[e1g], 1);
            LAS int* r = rt + lt * 6; r[0] = e0g; r[1] = e1g; r[2] = r0; r[3] = r1; r[4] = __builtin_bit_cast(int, w0); r[5] = __builtin_bit_cast(int, w1); }
        __syncthreads();
        if (DRY) continue;
        if (tid < 32) bcnt[32 + tid] = (int)__hip_atomic_fetch_add(ctl + CW_CNT + 64 * tid, (unsigned)bcnt[tid], __ATOMIC_RELAXED, __HIP_MEMORY_SCOPE_AGENT);
        __syncthreads();
        if (tid < 128) { const LAS int* r = rt + tid * 6; const int tk2 = base + tid; const int e0g = r[0], e1g = r[1], p0 = bcnt[32 + e0g] + r[2], p1 = bcnt[32 + e1g] + r[3];
            int* ro = ROUTE + (size_t)tk2 * 8; ro[0] = e0g; ro[1] = e1g; ro[2] = p0; ro[3] = p1; ro[4] = r[4]; ro[5] = r[5];
            LIST[e0g * NTOK + p0] = tk2; LIST[e1g * NTOK + p1] = tk2; }
        __syncthreads();
    }
}

__device__ __forceinline__ void ph_final(const Ctx& c, LAS unsigned char* lds) {
    const int tid = threadIdx.x, lane = tid & 63, wave = __builtin_amdgcn_readfirstlane(tid >> 6), nw = blockDim.x >> 6;
    const float* MOD = (const float*)(c.ws + WS_MOD); const bf16* X1 = (const bf16*)(c.ws + WS_X1); const bf16* YB = (const bf16*)(c.ws + WS_YB);
    const int* ROUTE = (const int*)(c.ws + WS_ROUTE);
    LAS int* mm = (LAS int*)(lds + LDS_MM_OFF);
    f32x4 g[4];
#pragma unroll
    for (int q = 0; q < 4; ++q) g[q] = *(const f32x4*)(c.g_final + 4 * lane + 256 * q);
    for (int tok = blockIdx.x * nw + wave; tok < NTOK; tok += gridDim.x * nw) {
        const int bb = tok / SEQ; const float* gt = MOD + bb * 6144 + 5120; const int* ro = ROUTE + (size_t)tok * 8;
        const int e0 = ro[0], e1 = ro[1]; const size_t r0 = ((size_t)mm[32 + e0] << 8) + ro[2], r1 = ((size_t)mm[32 + e1] << 8) + ro[3];
        const float w0 = __builtin_bit_cast(float, ro[4]), w1 = __builtin_bit_cast(float, ro[5]);
        f32x4 v[4]; float ss = 0.f;
#pragma unroll
        for (int q = 0; q < 4; ++q) { const int col = 4 * lane + 256 * q; const u32x2 xw = *(const u32x2*)(X1 + (size_t)tok * DM + col); const f32x4 xv = {bflo(xw.x), bfhi(xw.x), bflo(xw.y), bfhi(xw.y)}, gv = *(const f32x4*)(gt + col);
            const u32x2 ya = *(const u32x2*)(YB + r0 * DM + col), yb = *(const u32x2*)(YB + r1 * DM + col);
            f32x4 y; y.x = w0 * bflo(ya.x) + w1 * bflo(yb.x); y.y = w0 * bfhi(ya.x) + w1 * bfhi(yb.x); y.z = w0 * bflo(ya.y) + w1 * bflo(yb.y); y.w = w0 * bfhi(ya.y) + w1 * bfhi(yb.y);
            v[q] = xv + gv * y; ss += (v[q].x * v[q].x + v[q].y * v[q].y) + (v[q].z * v[q].z + v[q].w * v[q].w); }
        const float rstd = rsqrtf(wave_sum(ss) * (1.0f / DM) + NORM_EPS);
#pragma unroll
        for (int q = 0; q < 4; ++q) *(f32x4*)(c.out + (size_t)tok * DM + 4 * lane + 256 * q) = v[q] * rstd * g[q];
    }
}

#define XB_TMO      128
#define XB_XCNT(j)  (256  + 64 * (j))
#define XB_XSUB(j)  (1280 + 64 * (j))
#define XB_XGEN(j)  (2304 + 64 * (j))
#define XB_TOP      3328
#define XB_TOPGEN   3392
#define XCD_BAR_WORDS 3456
#define XB_SPIN_CAP (1u << 18)

__device__ __forceinline__ unsigned xb_ld(unsigned* p)              { return __hip_atomic_load(p, __ATOMIC_RELAXED, __HIP_MEMORY_SCOPE_AGENT); }
__device__ __forceinline__ unsigned xb_add(unsigned* p, unsigned v) { return __hip_atomic_fetch_add(p, v, __ATOMIC_RELAXED, __HIP_MEMORY_SCOPE_AGENT); }
__device__ __forceinline__ unsigned xb_xcc_id() { return (unsigned)__builtin_amdgcn_s_getreg((3 << 11) | 20) & 0xFu; }
#define XB_SPIN(cond, bar) do { unsigned _sp = 0; while (cond) { __builtin_amdgcn_s_sleep(1); \
    if ((++_sp & 255u) == 0u) { if (xb_ld(&(bar)[XB_TMO])) break; if (_sp > XB_SPIN_CAP) { atomicAdd(&(bar)[XB_TMO], 1u); break; } } } } while (0)

struct XcdBarrier {
    unsigned* bar; unsigned x;
    volatile LAS unsigned* st;
};
__device__ __forceinline__ XcdBarrier xcd_barrier_post(unsigned* bar, volatile LAS unsigned* st) {
    XcdBarrier b; b.bar = bar; b.x = xb_xcc_id(); b.st = st;
    if (threadIdx.x == 0) (void)xb_add(&bar[XB_XCNT(b.x)], 1u);
    return b;
}
__device__ __forceinline__ void xcd_barrier_complete(unsigned* bar, unsigned x, unsigned& nloc, unsigned& nx) {
    const unsigned G = gridDim.x * gridDim.y * gridDim.z;
    unsigned sum, cnt, mine, sp = 0u;
    for (;;) {
        sum = 0u; cnt = 0u; mine = 0u;
#pragma unroll
        for (unsigned j = 0; j < 16; ++j) { const unsigned c = xb_ld(&bar[XB_XCNT(j)]); sum += c; cnt += (c > 0u) ? 1u : 0u; mine = (j == x) ? c : mine; }
        if (sum == G) break;
        __builtin_amdgcn_s_sleep(1);
        if ((++sp & 255u) == 0u) { if (xb_ld(&bar[XB_TMO])) break; if (sp > XB_SPIN_CAP) { atomicAdd(&bar[XB_TMO], 1u); break; } }
    }
    nloc = mine > 0u ? mine : 1u; nx = cnt > 0u ? cnt : 1u;
}
__device__ __forceinline__ void xcd_barrier(const XcdBarrier& b) {
    asm volatile("s_waitcnt vmcnt(0)" ::: "memory");
    __syncthreads();
    if (threadIdx.x == 0) {
        unsigned* bar = b.bar;
        __builtin_amdgcn_s_waitcnt(0);
        unsigned nloc = b.st[0], nx = b.st[1];
        if (nloc == 0u) { xcd_barrier_complete(bar, b.x, nloc, nx); b.st[0] = nloc; b.st[1] = nx; }
        const unsigned old = xb_add(&bar[XB_XSUB(b.x)], 1u);
        const unsigned gen = old / nloc;
        if (old + 1u == (gen + 1u) * nloc) {
            __builtin_amdgcn_fence(__ATOMIC_RELEASE, "agent");
            asm volatile("s_waitcnt vmcnt(0)" ::: "memory");
            const unsigned og = xb_add(&bar[XB_TOP], 1u);
            const unsigned tg = og / nx;
            if (og + 1u == (tg + 1u) * nx) xb_add(&bar[XB_TOPGEN], 1u);
            else XB_SPIN(xb_ld(&bar[XB_TOPGEN]) == tg, bar);
            __builtin_amdgcn_fence(__ATOMIC_ACQUIRE, "agent");
            xb_add(&bar[XB_XGEN(b.x)], 1u);
            asm volatile("s_waitcnt vmcnt(0)" ::: "memory");
        } else {
            XB_SPIN(xb_ld(&bar[XB_XGEN(b.x)]) == gen, bar);
            __builtin_amdgcn_fence(__ATOMIC_ACQUIRE, "agent");
            asm volatile("s_waitcnt vmcnt(0)" ::: "memory");
        }
    }
    __syncthreads();
}

#ifndef PROBE_MASK
#define PROBE_MASK 0
#endif
constexpr int LDS_BYTES = 147456;
constexpr int LDS_BARW_OFF = LDS_BYTES - 16;
__global__ void __launch_bounds__(512, 2) mega_fwd(Ctx c) {
    extern __shared__ __attribute__((aligned(16))) unsigned char lds_raw[];
    LAS unsigned char* lds = (LAS unsigned char*)lds_raw;
    if (threadIdx.x == 0) *(LAS u32x4*)(lds + LDS_BARW_OFF) = (u32x4){0u, 0u, 0u, 0u};
    __syncthreads();
    const XcdBarrier bar = xcd_barrier_post((unsigned*)(c.ws + WS_CTL) + CW_BAR, (volatile LAS unsigned*)(lds + LDS_BARW_OFF));
#define RUN(k, call) do { call; xcd_barrier(bar); if (PROBE_MASK & (1 << (k))) { call; xcd_barrier(bar); } } while (0)
    if (PROBE_MASK & (1 << 14)) { for (int i = 0; i < 8; ++i) xcd_barrier(bar); }
    RUN(0, ph_prologue(c, lds));
    RUN(1, ph_norm1(c));
    RUN(2, ph_inproj(c, lds));
    if (PROBE_MASK & (1 << 12)) gla::g0_phase(c, lds);
    if (PROBE_MASK & (1 << 13)) { da::attn_phase(c, lds); }
    RUN(3, (gla::g0_phase(c, lds), da::attn_phase(c, lds)));
    RUN(4, gla::g12_phase(c, lds));
    RUN(6, gla::g3_phase(c, lds));
    RUN(7, ph_outproj(c, lds));
    if (PROBE_MASK & (1 << 8)) { ph_router<true>(c, lds); xcd_barrier(bar); }
    ph_router<false>(c, lds); xcd_barrier(bar);
    RUN(9, ph_gateup(c, lds));
    RUN(10, ph_down(c, lds));
    if (PROBE_MASK & (1 << 11)) { ph_final(c, lds); xcd_barrier(bar); }
    ph_final(c, lds);
}

extern "C" void kernel_launch(void* const* d_in, const int* in_sizes, int n_in, void* d_out, int out_size, void* d_ws, size_t ws_size, hipStream_t stream) {
    static int grid = 0;
    if (grid == 0) {
        if (n_in != 23 || in_sizes[0] != NTOK * DM || out_size != NTOK * DM || ws_size < WS_END) { fprintf(stderr, "kernel_launch: unexpected problem shape (n_in %d, in0 %d, out %d, ws %zu)\n", n_in, n_in > 0 ? in_sizes[0] : -1, out_size, ws_size); grid = -1; return; }
        int dev = 0, cus = 0, per_cu = 0;
        if (hipGetDevice(&dev) != hipSuccess || hipDeviceGetAttribute(&cus, hipDeviceAttributeMultiprocessorCount, dev) != hipSuccess) { grid = -1; return; }
        if (hipFuncSetAttribute((const void*)mega_fwd, hipFuncAttributeMaxDynamicSharedMemorySize, LDS_BYTES) != hipSuccess) { fprintf(stderr, "kernel_launch: hipFuncSetAttribute failed\n"); grid = -1; return; }
        if (hipOccupancyMaxActiveBlocksPerMultiprocessor(&per_cu, (const void*)mega_fwd, 512, LDS_BYTES) != hipSuccess || per_cu < 1) fprintf(stderr, "kernel_launch: occupancy query reports %d workgroups per CU\n", per_cu);
        (void)hipGetLastError();
        grid = cus;
    }
    if (grid < 0) return;
    Ctx c{};
    const float** f = (const float**)&c;
    for (int i = 0; i < 23; ++i) f[i] = (const float*)d_in[i];
    c.out = (float*)d_out; c.ws = (unsigned char*)d_ws;
    if (hipMemsetAsync((unsigned char*)d_ws + WS_CTL, 0, CTL_ZERO_BYTES, stream) != hipSuccess) return;
    hipLaunchKernelGGL(mega_fwd, dim3(grid), dim3(512), LDS_BYTES, stream, c);
}
```
